# Optimizing an MI355X kernel written in HIP

```python
import math
import jax, jax.numpy as jnp
from jax import lax
import numpy as np

D_MODEL = 1024
BATCH = 1
SEQ = 16384
DEPTH = 2

N_MIXERS = 2
RET_HEADS = 4
RET_QK_DIM = D_MODEL // RET_HEADS
RET_V_DIM = 2 * D_MODEL // RET_HEADS
RET_CHUNK = 128
ROPE_BASE = 10000.0
MLSTM_HEADS = 4
MLSTM_INNER = 2 * D_MODEL
MLSTM_QK_DIM = D_MODEL // MLSTM_HEADS
MLSTM_V_DIM = MLSTM_INNER // MLSTM_HEADS
MLSTM_CONV = 4
MLSTM_CHUNK = 128
D_FF = 2816
FFN_CONV = 3
EPS = 1e-6

N_RET = (DEPTH + 1) // 2
N_MLSTM = DEPTH // 2
RET_IN = 2 * RET_HEADS * RET_QK_DIM + 2 * RET_HEADS * RET_V_DIM
MLSTM_IN = 2 * MLSTM_HEADS * MLSTM_QK_DIM + 2 * MLSTM_INNER + 2 * MLSTM_HEADS

kernel_name = "hybrid_retention_mlstm_convffn"


def rmsnorm(x, g):
    xf = x.astype(jnp.float32)
    xn = xf * lax.rsqrt(jnp.mean(xf * xf, axis=-1, keepdims=True) + EPS)
    return xn.astype(x.dtype) * g


def head_groupnorm(y, g):
    yf = y.astype(jnp.float32)
    mu = jnp.mean(yf, axis=-1, keepdims=True)
    var = jnp.mean((yf - mu) ** 2, axis=-1, keepdims=True)
    yn = (yf - mu) * lax.rsqrt(var + EPS)
    Bt, S = y.shape[0], y.shape[1]
    return yn.reshape(Bt, S, -1) * g


def causal_dwconv(x, w, b):
    K = w.shape[0]
    S = x.shape[1]
    xp = jnp.pad(x, ((0, 0), (K - 1, 0), (0, 0)))
    out = b + xp[:, 0:S] * w[0]
    for j in range(1, K):
        out = out + xp[:, j:j + S] * w[j]
    return out


def rope(t, positions):
    d = t.shape[-1]
    inv_freq = ROPE_BASE ** (-jnp.arange(0, d, 2, dtype=jnp.float32) / d)
    ang = positions.astype(jnp.float32)[..., None] * inv_freq
    cos = jnp.cos(ang)[:, :, None, :].astype(t.dtype)
    sin = jnp.sin(ang)[:, :, None, :].astype(t.dtype)
    t1, t2 = t[..., : d // 2], t[..., d // 2:]
    return jnp.concatenate([t1 * cos - t2 * sin, t1 * sin + t2 * cos], axis=-1)


def to_chunks(t, C):
    Bt, S, H, d = t.shape
    return t.reshape(Bt, S // C, C, H, d).transpose(1, 0, 3, 2, 4)


def gates_to_chunks(t, C):
    Bt, S, H = t.shape
    return t.reshape(Bt, S // C, C, H).transpose(1, 0, 3, 2)


def from_chunks(t):
    nC, Bt, H, C, d = t.shape
    return t.transpose(1, 0, 3, 2, 4).reshape(Bt, nC * C, H, d)


def retention_mixer(h, positions, w_in, gn_g, w_out):
    Bt, S, _ = h.shape
    H, dk, dv, C = RET_HEADS, RET_QK_DIM, RET_V_DIM, RET_CHUNK
    proj = h @ w_in
    q, k, v, g = jnp.split(proj, [H * dk, 2 * H * dk, 2 * H * dk + H * dv], axis=-1)
    q = rope(q.reshape(Bt, S, H, dk), positions)
    k = rope(k.reshape(Bt, S, H, dk), positions) * (dk ** -0.5)
    v = v.reshape(Bt, S, H, dv)
    log_gamma = jnp.log(1.0 - 2.0 ** (-5.0 - jnp.arange(H, dtype=jnp.float32)))
    idx = jnp.arange(C, dtype=jnp.float32)
    rel = idx[:, None] - idx[None, :]
    decay = jnp.where(rel >= 0, jnp.exp(rel[None] * log_gamma[:, None, None]), 0.0)
    xi = jnp.exp((idx + 1.0)[None] * log_gamma[:, None])
    zeta = jnp.exp((C - 1.0 - idx)[None] * log_gamma[:, None])
    gamma_C = jnp.exp(C * log_gamma)

    def step(R, inp):
        qc, kc, vc = inp
        s = jnp.einsum('bhid,bhjd->bhij', qc, kc) * decay
        intra = jnp.einsum('bhij,bhjv->bhiv', s, vc)
        cross = jnp.einsum('bhid,bhdv->bhiv', qc, R) * xi[:, :, None]
        R_new = R * gamma_C[:, None, None] + jnp.einsum('bhjd,bhjv->bhdv', kc * zeta[:, :, None], vc)
        return R_new, intra + cross

    R0 = jnp.zeros((Bt, H, dk, dv), jnp.float32)
    _, ys = lax.scan(step, R0, (to_chunks(q, C), to_chunks(k, C), to_chunks(v, C)))
    y = head_groupnorm(from_chunks(ys), gn_g).astype(h.dtype)
    return (jax.nn.silu(g) * y) @ w_out


def mlstm_mixer(h, w_in, b_gate, conv_w, conv_b, gn_g, w_out):
    Bt, S, _ = h.shape
    H, dk, dv, C = MLSTM_HEADS, MLSTM_QK_DIM, MLSTM_V_DIM, MLSTM_CHUNK
    proj = h @ w_in
    qk, v, o_pre, gate_pre = jnp.split(
        proj, [2 * H * dk, 2 * H * dk + MLSTM_INNER, 2 * H * dk + 2 * MLSTM_INNER], axis=-1)
    qk = jax.nn.silu(causal_dwconv(qk, conv_w, conv_b))
    q, k = jnp.split(qk, 2, axis=-1)
    q = q.reshape(Bt, S, H, dk)
    k = k.reshape(Bt, S, H, dk) * (dk ** -0.5)
    v = v.reshape(Bt, S, H, dv)
    gate_pre = gate_pre.astype(jnp.float32) + b_gate.astype(jnp.float32)
    log_i = gate_pre[..., :H]
    log_f = jax.nn.log_sigmoid(gate_pre[..., H:])
    g_cum = lax.cumsum(gates_to_chunks(log_f, C), axis=3)
    ic_all = gates_to_chunks(log_i, C)
    causal = jnp.tril(jnp.ones((C, C), dtype=bool))

    def step(carry, inp):
        Cm, n, m = carry
        qc, kc, vc, gc, ic = inp
        a = gc + m[..., None]
        dlog = gc[..., :, None] - gc[..., None, :] + ic[..., None, :]
        dlog = jnp.where(causal, dlog, -jnp.inf)
        m_row = jnp.maximum(a, jnp.max(dlog, axis=-1))
        w_intra = jnp.exp(dlog - m_row[..., None])
        w_inter = jnp.exp(a - m_row)
        s = jnp.einsum('bhid,bhjd->bhij', qc, kc) * w_intra
        num = jnp.einsum('bhij,bhjv->bhiv', s, vc) + w_inter[..., None] * jnp.einsum('bhid,bhdv->bhiv', qc, Cm)
        den = jnp.sum(s, axis=-1) + w_inter * jnp.einsum('bhid,bhd->bhi', qc, n)
        h_til = num / jnp.maximum(jnp.abs(den), jnp.exp(-m_row))[..., None]
        gL = gc[..., -1]
        dec_end = gL[..., None] - gc + ic
        m_new = jnp.maximum(gL + m, jnp.max(dec_end, axis=-1))
        w_state = jnp.exp(dec_end - m_new[..., None])
        scale_prev = jnp.exp(gL + m - m_new)
        Cm_new = scale_prev[..., None, None] * Cm + jnp.einsum('bhj,bhjd,bhjv->bhdv', w_state, kc, vc)
        n_new = scale_prev[..., None] * n + jnp.einsum('bhj,bhjd->bhd', w_state, kc)
        return (Cm_new, n_new, m_new), h_til

    carry0 = (jnp.zeros((Bt, H, dk, dv), jnp.float32),
              jnp.zeros((Bt, H, dk), jnp.float32),
              jnp.zeros((Bt, H), jnp.float32))
    _, hs = lax.scan(step, carry0, (to_chunks(q, C), to_chunks(k, C), to_chunks(v, C), g_cum, ic_all))
    h_til = from_chunks(hs)
    o = jax.nn.sigmoid(o_pre.astype(jnp.float32)).reshape(Bt, S, H, dv)
    y = head_groupnorm(o * h_til, gn_g).astype(h.dtype)
    return y @ w_out


def conv_ffn(h, w_up, conv_w, conv_b, w_down):
    u = causal_dwconv(h @ w_up, conv_w, conv_b)
    a, b = jnp.split(u, 2, axis=-1)
    return (jax.nn.silu(a) * b) @ w_down


def setup_inputs(seed: int = 0) -> dict:
    key = jax.random.key(seed)
    ks = jax.random.split(key, 24)
    f32 = jnp.float32
    nrm = lambda k, shape, s: jax.random.normal(k, shape, f32) * s
    D = D_MODEL
    x = nrm(ks[0], (BATCH, SEQ, D), 1.0)
    c = nrm(ks[1], (BATCH, D), 1.0)
    positions = jnp.broadcast_to(jnp.arange(SEQ, dtype=jnp.int32), (BATCH, SEQ))
    ada_w = nrm(ks[2], (DEPTH, D, 6 * D), 0.5 * D ** -0.5)
    ada_b = nrm(ks[3], (DEPTH, 6 * D), 0.02)
    norm_tok_g = 1.0 + nrm(ks[4], (DEPTH, D), 0.02)
    norm_ffn_g = 1.0 + nrm(ks[5], (DEPTH, D), 0.02)
    ret_w_in = nrm(ks[6], (N_RET, D, RET_IN), D ** -0.5)
    ret_gn_g = 1.0 + nrm(ks[7], (N_RET, RET_HEADS * RET_V_DIM), 0.02)
    ret_w_out = nrm(ks[8], (N_RET, RET_HEADS * RET_V_DIM, D), (RET_HEADS * RET_V_DIM) ** -0.5)
    ml_w_in = nrm(ks[9], (N_MLSTM, D, MLSTM_IN), D ** -0.5)
    i_bias = nrm(ks[10], (N_MLSTM, MLSTM_HEADS), 0.1)
    f_bias = jnp.linspace(3.0, 6.0, MLSTM_HEADS, dtype=f32)[None] + nrm(ks[11], (N_MLSTM, MLSTM_HEADS), 0.1)
    ml_b_gate = jnp.concatenate([i_bias, f_bias], axis=-1)
    qk_width = 2 * MLSTM_HEADS * MLSTM_QK_DIM
    ml_conv_w = nrm(ks[12], (N_MLSTM, MLSTM_CONV, qk_width), MLSTM_CONV ** -0.5)
    ml_conv_b = nrm(ks[13], (N_MLSTM, qk_width), 0.02)
    ml_gn_g = 1.0 + nrm(ks[14], (N_MLSTM, MLSTM_INNER), 0.02)
    ml_w_out = nrm(ks[15], (N_MLSTM, MLSTM_INNER, D), MLSTM_INNER ** -0.5)
    ffn_w_up = nrm(ks[16], (DEPTH, D, 2 * D_FF), D ** -0.5)
    ffn_conv_w = nrm(ks[17], (DEPTH, FFN_CONV, 2 * D_FF), FFN_CONV ** -0.5)
    ffn_conv_b = nrm(ks[18], (DEPTH, 2 * D_FF), 0.02)
    ffn_w_down = nrm(ks[19], (DEPTH, D_FF, D), D_FF ** -0.5)
    final_g = 1.0 + nrm(ks[20], (D,), 0.02)
    return {"x": x, "c": c, "positions": positions,
            "ada_w": ada_w, "ada_b": ada_b, "norm_tok_g": norm_tok_g, "norm_ffn_g": norm_ffn_g,
            "ret_w_in": ret_w_in, "ret_gn_g": ret_gn_g, "ret_w_out": ret_w_out,
            "ml_w_in": ml_w_in, "ml_b_gate": ml_b_gate, "ml_conv_w": ml_conv_w, "ml_conv_b": ml_conv_b,
            "ml_gn_g": ml_gn_g, "ml_w_out": ml_w_out,
            "ffn_w_up": ffn_w_up, "ffn_conv_w": ffn_conv_w, "ffn_conv_b": ffn_conv_b, "ffn_w_down": ffn_w_down,
            "final_g": final_g}


def reference(x, c, positions, ada_w, ada_b, norm_tok_g, norm_ffn_g,
              ret_w_in, ret_gn_g, ret_w_out,
              ml_w_in, ml_b_gate, ml_conv_w, ml_conv_b, ml_gn_g, ml_w_out,
              ffn_w_up, ffn_conv_w, ffn_conv_b, ffn_w_down, final_g):
    c_act = jax.nn.silu(c)
    for i in range(DEPTH):
        mod = c_act @ ada_w[i] + ada_b[i]
        sh_t, sc_t, gt_t, sh_f, sc_f, gt_f = [m[:, None, :] for m in jnp.split(mod, 6, axis=-1)]
        h = rmsnorm(x, norm_tok_g[i]) * (1.0 + sc_t) + sh_t
        j = i // N_MIXERS
        if i % N_MIXERS == 0:
            y = retention_mixer(h, positions, ret_w_in[j], ret_gn_g[j], ret_w_out[j])
        else:
            y = mlstm_mixer(h, ml_w_in[j], ml_b_gate[j], ml_conv_w[j], ml_conv_b[j], ml_gn_g[j], ml_w_out[j])
        x = x + gt_t * y
        h = rmsnorm(x, norm_ffn_g[i]) * (1.0 + sc_f) + sh_f
        x = x + gt_f * conv_ffn(h, ffn_w_up[i], ffn_conv_w[i], ffn_conv_b[i], ffn_w_down[i])
    return rmsnorm(x, final_g)
```

```cpp
#include <hip/hip_runtime.h>
#include <hip/hip_cooperative_groups.h>
#include <cstdio>
namespace cg = cooperative_groups;

#ifndef MULTI_LAUNCH
#define MULTI_LAUNCH 0
#endif

#define LAS __attribute__((address_space(3)))
typedef unsigned short bf16_t;
typedef short bf16x8 __attribute__((ext_vector_type(8)));
typedef float f32x4 __attribute__((ext_vector_type(4)));
typedef unsigned u32x4 __attribute__((ext_vector_type(4)));
typedef unsigned u32x2 __attribute__((ext_vector_type(2)));

constexpr int S_ = 16384, D_ = 1024, DFF = 2816;
constexpr float EPS = 1e-6f;

constexpr size_t OFF_W = 0;
constexpr size_t OFF_WIN = 0, OFF_WOUT = 12582912, OFF_WUP = 0, OFF_WDN = 11534336;
constexpr size_t OFF_H = 17301504;
constexpr size_t OFF_SM = OFF_H + 33554432;
constexpr size_t SM_MOD = 0;
constexpr size_t SM_IFQ = SM_MOD + 49152;
constexpr size_t SM_RB = SM_IFQ + 512;
constexpr size_t TBL = 262144;
constexpr size_t SM_CB = SM_RB + TBL, SM_XS = SM_CB + TBL, SM_WK = SM_XS + TBL, SM_EM = SM_WK + TBL, SM_GG = SM_EM + TBL, SM_PM = SM_GG + TBL;
constexpr size_t SM_GL = SM_PM + TBL;
constexpr size_t SM_ML = SM_GL + 1024, SM_SCP = SM_ML + 1024, SM_SCN = SM_SCP + 1024;
constexpr size_t SM_LI = SM_SCN + 1024;
constexpr size_t SM_LF = SM_LI + 262144;
constexpr size_t SM_PS = SM_LF + 262144;
constexpr size_t SM_DC = SM_PS + 1048576;
constexpr size_t SM_NLOC = SM_DC + 262144;
constexpr size_t SM_ST = SM_NLOC + 262144;
constexpr size_t SM_QKH = SM_ST + 4194304;
constexpr size_t SM_END = SM_QKH + 1572864;
constexpr size_t OFF_BIG = OFF_SM + 10485760;
static_assert(SM_END <= 10485760, "small region");
constexpr size_t OFF_Q = OFF_BIG, OFF_K = OFF_Q + 16777216, OFF_KWT = OFF_K + 16777216, OFF_VT = OFF_KWT + 16777216,
                 OFF_KVT = OFF_VT + 33554432, OFF_P = OFF_KVT + 33554432, OFF_Z = OFF_P + 16777216, WS_END = OFF_Z + 67108864;
constexpr size_t OFF_ACT = OFF_BIG, OFF_FH = OFF_ACT + 92274688;

struct Params {
    const float *x, *c; const int* pos; const float *ada_w, *ada_b, *ntg, *nfg, *ret_w_in, *ret_gn, *ret_w_out,
        *ml_w_in, *ml_bg, *ml_cw, *ml_cb, *ml_gn, *ml_w_out, *up_w, *fcw, *fcb, *dn_w, *fin_g;
    float* out; unsigned char* ws; int ph_lo, ph_hi;
};

__device__ __forceinline__ unsigned cvt_pk_bf16(float lo, float hi) { unsigned r; asm volatile("v_cvt_pk_bf16_f32 %0, %1, %2" : "=v"(r) : "v"(lo), "v"(hi)); return r; }
__device__ __forceinline__ float bf_lo(unsigned w) { return __uint_as_float(w << 16); }
__device__ __forceinline__ float bf_hi(unsigned w) { return __uint_as_float(w & 0xffff0000u); }
__device__ __forceinline__ float siluf(float v) { return v / (1.0f + __expf(-v)); }
__device__ __forceinline__ float sigmf(float v) { return 1.0f / (1.0f + __expf(-v)); }
__device__ __forceinline__ float wave_sum(float v) { for (int o = 32; o >= 1; o >>= 1) v += __shfl_xor(v, o); return v; }
__device__ __forceinline__ u32x4 pack8(const f32x4 a, const f32x4 b) { u32x4 w; w.x = cvt_pk_bf16(a[0], a[1]); w.y = cvt_pk_bf16(a[2], a[3]); w.z = cvt_pk_bf16(b[0], b[1]); w.w = cvt_pk_bf16(b[2], b[3]); return w; }
__device__ __forceinline__ void unpack8(const u32x4 w, float (&f)[8]) { f[0] = bf_lo(w.x); f[1] = bf_hi(w.x); f[2] = bf_lo(w.y); f[3] = bf_hi(w.y); f[4] = bf_lo(w.z); f[5] = bf_hi(w.z); f[6] = bf_lo(w.w); f[7] = bf_hi(w.w); }

namespace gm {
constexpr int BM = 256, BK = 64, HALF = 128, HTB = HALF * BK * 2, STAGE_BYTES = 8 * HTB, NXCD = 8, WGM = 8;
__device__ __forceinline__ int lds_byte(int r, int c) { const int st = (r >> 4) * 2 + (c >> 5), rr = r & 15, cc = c & 31, ob = rr * 64 + cc * 2; return st * 1024 + (ob ^ (((ob >> 9) & 1) << 5)); }
__device__ __forceinline__ void stage_rc(int b, int& R, int& C) { const int st = b / 1024, sb = b % 1024, swz = sb ^ (((sb >> 9) & 1) << 5); R = (st >> 1) * 16 + swz / 64; C = (st & 1) * 32 + (swz % 64) / 2; }
__device__ __forceinline__ int perm32(int rho) { const int n = rho >> 4, i = rho & 15; return 8 * (i >> 2) + 4 * n + (i & 3); }

struct U { const char *a1, *b1, *a2, *b2; long co; int i0, i1, i2, i3; };
struct GP { int lda, ldb, n1, nt; };

struct SchedPlain {
    const char* A; const char* B; const char* B2; int nM, nN, nsplit, G, c; size_t ta, tb; long ldc; int vt;
    __device__ __forceinline__ bool next(int i, U& u) const {
        const int nwg = nM * nN; const long L = (long)i * G + c; if (L >= nwg) return false;
        int wgid = (int)L; { const int q = nwg / NXCD, r = nwg % NXCD, xcd = wgid % NXCD, off = wgid / NXCD; wgid = (xcd < r ? xcd * (q + 1) : r * (q + 1) + (xcd - r) * q) + off; }
        const int nig = WGM * nN, gid = wgid / nig, fm = gid * WGM, gsz = (nM - fm) < WGM ? (nM - fm) : WGM;
        const int pm = fm + ((wgid % nig) % gsz), pn = (wgid % nig) / gsz;
        u.a1 = A + (size_t)pm * ta; u.b1 = pn < nsplit ? B + (size_t)pn * tb : B2 + (size_t)(pn - nsplit) * tb; u.a2 = u.a1; u.b2 = u.b1;
        u.co = vt ? ((long)((pm >> 1) * 64 + pn) * 512 + (pm & 1) * 256) * 256 : (long)pm * 256 * ldc + (long)pn * 256; u.i0 = pm; u.i1 = pn; u.i2 = 0; u.i3 = 0; return true;
    }
};

template <class Epi, class Sched, bool TWOSEG>
__device__ __forceinline__ void gemm_phase(LAS unsigned char* lds, const GP g, const Sched& S, const Epi& E) {
    int tid = threadIdx.x; asm volatile("" : "+v"(tid));
    const int wid = __builtin_amdgcn_readfirstlane(tid >> 6), lane = tid & 63, wr = wid >> 2, wc = wid & 3, fr = lane & 15, fq = lane >> 4;
    const int nt = g.nt;
    unsigned voffA[2], voffB[2];
#pragma unroll
    for (int i = 0; i < 2; ++i) { int R, C; stage_rc(tid * 16 + i * 8192, R, C); const int Rb = Epi::PERM ? ((R & ~31) + perm32(R & 31)) : R;
        voffA[i] = (unsigned)(R * g.lda + C) * 2u; voffB[i] = (unsigned)(Rb * g.ldb + C) * 2u; }
    const size_t hsA1 = (size_t)HALF * g.lda * 2, hsB1 = (size_t)HALF * g.ldb * 2;
    const unsigned ldsw = (unsigned)wid * 1024u;
    const int aoff = lds_byte(wr * 64 + fr, fq * 8), boff = lds_byte(wc * 32 + fr, fq * 8);
#define G_SA(b, h) (((b) * 2 + (h)) * HTB)
#define G_SB(b, h) ((4 + (b) * 2 + (h)) * HTB)
#define G_STAGE(bufoff, gbase, voff) do { _Pragma("unroll") for (int _i = 0; _i < 2; ++_i) \
        __builtin_amdgcn_global_load_lds((const unsigned*)((const char*)(gbase) + (voff)[_i]), (LAS unsigned*)(lds + (bufoff) + ldsw + _i * 8192), 16, 0, 0); } while (0)
#define G_LDA(dst, b, h) do { _Pragma("unroll") for (int m = 0; m < 4; ++m) _Pragma("unroll") for (int k = 0; k < 2; ++k) dst[m][k] = *(const LAS bf16x8*)(lds + G_SA(b, h) + aoff + m * 2048 + k * 1024); } while (0)
#define G_LDB(dst, b, h) do { _Pragma("unroll") for (int n = 0; n < 2; ++n) _Pragma("unroll") for (int k = 0; k < 2; ++k) dst[n][k] = *(const LAS bf16x8*)(lds + G_SB(b, h) + boff + n * 2048 + k * 1024); } while (0)
#define G_MMA(ai, bj, At, Bt) do { __builtin_amdgcn_s_setprio(1); _Pragma("unroll") for (int m = 0; m < 4; ++m) _Pragma("unroll") for (int n = 0; n < 2; ++n) _Pragma("unroll") for (int k = 0; k < 2; ++k) \
        acc[ai][bj][m][n] = __builtin_amdgcn_mfma_f32_16x16x32_bf16(Bt[n][k], At[m][k], acc[ai][bj][m][n], 0, 0, 0); __builtin_amdgcn_s_setprio(0); } while (0)
#define G_WAIT_V(n) asm volatile("s_waitcnt vmcnt(" #n ")" ::: "memory")
#define G_WAIT_L(n) asm volatile("s_waitcnt lgkmcnt(" #n ")" ::: "memory")
#define G_BAR __builtin_amdgcn_s_barrier()
#define G_SCHED __builtin_amdgcn_sched_barrier(0)
    U cur, nxt; int ui = 0;
    if (!S.next(0, cur)) return;
    f32x4 acc[2][2][4][2];
#pragma unroll
    for (int a = 0; a < 2; ++a)
#pragma unroll
        for (int b = 0; b < 2; ++b)
#pragma unroll
            for (int m = 0; m < 4; ++m)
#pragma unroll
                for (int n = 0; n < 2; ++n) acc[a][b][m][n] = (f32x4){0.f, 0.f, 0.f, 0.f};
    bf16x8 At[4][2], B0[2][2], B1[2][2];
    G_STAGE(G_SB(0, 0), cur.b1, voffB); G_STAGE(G_SA(0, 0), cur.a1, voffA); G_STAGE(G_SB(0, 1), cur.b1 + hsB1, voffB); G_STAGE(G_SA(0, 1), cur.a1 + hsA1, voffA);
    if (wr == 1) G_BAR;
    G_WAIT_V(4); G_BAR;
    G_STAGE(G_SB(1, 0), cur.b1 + 128, voffB); G_STAGE(G_SA(1, 0), cur.a1 + 128, voffA); G_STAGE(G_SB(1, 1), cur.b1 + hsB1 + 128, voffB);
    G_WAIT_V(6); G_BAR;
    for (;;) {
        const bool has_next = S.next(ui + 1, nxt);
        const char* nA = has_next ? nxt.a1 : cur.a1; const char* nB = has_next ? nxt.b1 : cur.b1;
        for (int t = 0; t < nt; t += 2) {
            const bool last = (t == nt - 2);
            const bool sg1 = TWOSEG && (t >= g.n1);
            const bool sg2 = TWOSEG && !last && (t + 2 >= g.n1);
            const char* a1 = sg1 ? cur.a2 + (size_t)(t + 1 - g.n1) * 128 : cur.a1 + (size_t)(t + 1) * 128;
            const char* a2 = last ? nA : (sg2 ? cur.a2 + (size_t)(t + 2 - g.n1) * 128 : cur.a1 + (size_t)(t + 2) * 128);
            const char* b2 = last ? nB : (sg2 ? cur.b2 + (size_t)(t + 2 - g.n1) * 128 : cur.b1 + (size_t)(t + 2) * 128);
            const char* a3 = a2 + 128; const char* b3 = b2 + 128;
            if (TWOSEG) { if (t == g.n1) E.mid(acc, cur, wr, wc, fr, fq); }
            G_LDB(B0, 0, 0); G_SCHED; G_LDA(At, 0, 0); G_STAGE(G_SA(1, 1), a1 + hsA1, voffA);
            G_WAIT_L(8); G_BAR; G_WAIT_L(0); G_MMA(0, 0, At, B0); G_BAR; G_SCHED;
            G_LDB(B1, 0, 1); G_STAGE(G_SB(0, 0), b2, voffB);
            G_BAR; G_WAIT_L(0); G_MMA(0, 1, At, B1); G_BAR;
            G_LDA(At, 0, 1); G_STAGE(G_SA(0, 0), a2, voffA);
            G_BAR; G_WAIT_L(0); G_MMA(1, 0, At, B0); G_BAR; G_SCHED;
            G_STAGE(G_SB(0, 1), b2 + hsB1, voffB);
            G_WAIT_V(6); G_BAR; G_MMA(1, 1, At, B1); G_BAR;
            G_LDB(B0, 1, 0); G_SCHED; G_LDA(At, 1, 0); G_STAGE(G_SA(0, 1), a2 + hsA1, voffA);
            G_WAIT_L(8); G_BAR; G_WAIT_L(0); G_MMA(0, 0, At, B0); G_BAR; G_SCHED;
            G_LDB(B1, 1, 1); G_STAGE(G_SB(1, 0), b3, voffB);
            G_BAR; G_WAIT_L(0); G_MMA(0, 1, At, B1); G_BAR;
            G_LDA(At, 1, 1); G_STAGE(G_SA(1, 0), a3, voffA);
            G_BAR; G_WAIT_L(0); G_MMA(1, 0, At, B0); G_BAR; G_SCHED;
            G_STAGE(G_SB(1, 1), b3 + hsB1, voffB);
            G_WAIT_V(6); G_BAR; G_MMA(1, 1, At, B1); G_BAR;
        }
        E(acc, cur, wr, wc, fr, fq);
        if (!has_next) break;
#pragma unroll
        for (int a = 0; a < 2; ++a)
#pragma unroll
            for (int b = 0; b < 2; ++b)
#pragma unroll
                for (int m = 0; m < 4; ++m)
#pragma unroll
                    for (int n = 0; n < 2; ++n) acc[a][b][m][n] = (f32x4){0.f, 0.f, 0.f, 0.f};
        cur = nxt; ++ui;
    }
    G_WAIT_V(0);
    if (wr == 0) G_BAR;
    G_BAR;
#undef G_SA
#undef G_SB
#undef G_STAGE
#undef G_LDA
#undef G_LDB
#undef G_MMA
#undef G_WAIT_V
#undef G_WAIT_L
#undef G_BAR
#undef G_SCHED
}
}

typedef f32x4 Acc[2][2][4][2];

struct EpiPlain {
    static constexpr bool PERM = true; bf16_t* base; long ldc;
    __device__ __forceinline__ void mid(Acc&, const gm::U&, int, int, int, int) const {}
    __device__ __forceinline__ void operator()(const Acc& acc, const gm::U& u, int wr, int wc, int fr_, int fq_) const {
        int fr = fr_, fq = fq_; asm volatile("" : "+v"(fr), "+v"(fq));
        bf16_t* d = base + u.co + (long)(wr * 64 + fr) * ldc + wc * 32 + 8 * fq;
#pragma unroll
        for (int ai = 0; ai < 2; ++ai)
#pragma unroll
            for (int m = 0; m < 4; ++m)
#pragma unroll
                for (int bj = 0; bj < 2; ++bj) *(u32x4*)(d + (long)(ai * 128 + m * 16) * ldc + bj * 128) = pack8(acc[ai][bj][m][0], acc[ai][bj][m][1]);
    }
};

template <int KIND> struct EpiQK {
    static constexpr bool PERM = true; bf16_t* Q; bf16_t* K; const int* pos; const float* ifq; bf16_t* qkh;
    __device__ __forceinline__ void mid(Acc&, const gm::U&, int, int, int, int) const {}
    __device__ __forceinline__ void operator()(const Acc& acc, const gm::U& u, int wr, int wc, int fr_, int fq_) const {
        int fr = fr_, fq = fq_; asm volatile("" : "+v"(fr), "+v"(fq));
        const int pm = u.i0, pn = u.i1, d0 = wc * 32 + 8 * fq;
        bf16_t* dst = (pn < 2 ? Q : K) + (size_t)(pn & 1) * S_ * 256 + d0;
        if (KIND == 0) {
            const float sc = pn < 2 ? 1.0f : 0.0625f;
            const f32x4 f0 = *(const f32x4*)(ifq + d0), f1 = *(const f32x4*)(ifq + d0 + 4);
#pragma unroll
            for (int ai = 0; ai < 2; ++ai)
#pragma unroll
                for (int m = 0; m < 4; ++m) {
                    const int t = pm * 256 + ai * 128 + wr * 64 + m * 16 + fr; const float pf = (float)pos[t];
                    f32x4 o1[2], o2[2];
#pragma unroll
                    for (int n = 0; n < 2; ++n)
#pragma unroll
                        for (int e = 0; e < 4; ++e) {
                            const float ang = pf * (n ? f1[e] : f0[e]);
                            const double rev = (double)ang * 0.15915494309189535; const float fx = (float)(rev - __builtin_rint(rev));
                            const float sn = __builtin_amdgcn_sinf(fx), cs = __builtin_amdgcn_cosf(fx);
                            const float t1 = acc[ai][0][m][n][e], t2 = acc[ai][1][m][n][e];
                            o1[n][e] = (t1 * cs - t2 * sn) * sc; o2[n][e] = (t1 * sn + t2 * cs) * sc; }
                    *(u32x4*)(dst + (size_t)t * 256) = pack8(o1[0], o1[1]); *(u32x4*)(dst + (size_t)t * 256 + 128) = pack8(o2[0], o2[1]); }
        } else {
#pragma unroll
            for (int ai = 0; ai < 2; ++ai)
#pragma unroll
                for (int m = 0; m < 4; ++m) {
                    const int t = pm * 256 + ai * 128 + wr * 64 + m * 16 + fr;
#pragma unroll
                    for (int bj = 0; bj < 2; ++bj) { const u32x4 w = pack8(acc[ai][bj][m][0], acc[ai][bj][m][1]);
                        *(u32x4*)(dst + (size_t)t * 256 + bj * 128) = w;
                        if (m == 3 && fr >= 13) { const int gq = pm * 4 + ai * 2 + wr; *(u32x4*)(qkh + ((size_t)gq * 3 + (fr - 13)) * 1024 + pn * 256 + bj * 128 + d0) = w; } } }
        }
    }
};

template <bool PSUM> struct EpiS {
    static constexpr bool PERM = true; bf16_t* P; const float* RB; const float* CB; float* PS; int pair;
    __device__ __forceinline__ void mid(Acc&, const gm::U&, int, int, int, int) const {}
    __device__ __forceinline__ void operator()(const Acc& acc, const gm::U& u, int wr, int wc, int fr_, int fq_) const {
        int fr = fr_, fq = fq_; asm volatile("" : "+v"(fr), "+v"(fq));
        const int ch = u.i0, h2 = u.i1, h = 2 * pair + h2, c0 = wc * 32 + 8 * fq;
        const float* rb = RB + (size_t)h * S_ + ch * 256 + wr * 64 + fr; const float* cb = CB + (size_t)h * S_ + ch * 256 + c0;
        bf16_t* d = P + ((size_t)(h2 * 64 + ch) * 256 + wr * 64 + fr) * 256 + c0;
        float rbv[2][4], rs[2][4];
#pragma unroll
        for (int ai = 0; ai < 2; ++ai)
#pragma unroll
            for (int m = 0; m < 4; ++m) { rbv[ai][m] = rb[ai * 128 + m * 16]; rs[ai][m] = 0.f; }
#pragma unroll
        for (int bj = 0; bj < 2; ++bj)
#pragma unroll
            for (int n = 0; n < 2; ++n) {
                const f32x4 cbv = *(const f32x4*)(cb + bj * 128 + 4 * n);
#pragma unroll
                for (int ai = 0; ai < 2; ++ai)
#pragma unroll
                    for (int m = 0; m < 4; ++m) {
                        const int dij = (ai * 128 + wr * 64 + m * 16 + fr) - (bj * 128 + c0 + 4 * n);
                        f32x4 v;
#pragma unroll
                        for (int e = 0; e < 4; ++e) { const float w = (dij - e >= 0) ? acc[ai][bj][m][n][e] * __builtin_amdgcn_exp2f((rbv[ai][m] + cbv[e]) * 1.44269504f) : 0.f; v[e] = w; rs[ai][m] += w; }
                        u32x2 pk; pk.x = cvt_pk_bf16(v[0], v[1]); pk.y = cvt_pk_bf16(v[2], v[3]);
                        *(u32x2*)(d + (size_t)(ai * 128 + m * 16) * 256 + bj * 128 + 4 * n) = pk; }
            }
        if (PSUM) {
#pragma unroll
            for (int ai = 0; ai < 2; ++ai)
#pragma unroll
                for (int m = 0; m < 4; ++m) { float r = rs[ai][m]; r += __shfl_xor(r, 16); r += __shfl_xor(r, 32);
                    if (fq == 0) PS[((size_t)(ch * 256 + ai * 128 + wr * 64 + m * 16 + fr) * 4 + h) * 4 + wc] = r; } }
    }
};

template <bool STATS> struct EpiO {
    static constexpr bool PERM = true; bf16_t* Z; const float* XS; float* ST; int pair;
    __device__ __forceinline__ void mid(Acc& acc, const gm::U& u, int wr, int wc, int fr, int fq) const {
        const int ch = u.i0, h = 2 * pair + u.i1; const float* xs = XS + (size_t)h * S_ + ch * 256 + wr * 64 + fr;
#pragma unroll
        for (int ai = 0; ai < 2; ++ai)
#pragma unroll
            for (int m = 0; m < 4; ++m) { const float x = xs[ai * 128 + m * 16];
#pragma unroll
                for (int bj = 0; bj < 2; ++bj)
#pragma unroll
                    for (int n = 0; n < 2; ++n) acc[ai][bj][m][n] *= x; }
    }
    __device__ __forceinline__ void operator()(const Acc& acc, const gm::U& u, int wr, int wc, int fr_, int fq_) const {
        int fr = fr_, fq = fq_; asm volatile("" : "+v"(fr), "+v"(fq));
        const int ch = u.i0, h = 2 * pair + u.i1, nt2 = u.i2, c0 = wc * 32 + 8 * fq;
        bf16_t* d = Z + (size_t)(ch * 256) * 2048 + h * 512 + nt2 * 256 + c0;
#pragma unroll
        for (int ai = 0; ai < 2; ++ai)
#pragma unroll
            for (int m = 0; m < 4; ++m) {
                const int i = ai * 128 + wr * 64 + m * 16 + fr; float s = 0.f, q = 0.f;
#pragma unroll
                for (int bj = 0; bj < 2; ++bj) { *(u32x4*)(d + (size_t)i * 2048 + bj * 128) = pack8(acc[ai][bj][m][0], acc[ai][bj][m][1]);
                    if (STATS) {
#pragma unroll
                        for (int n = 0; n < 2; ++n)
#pragma unroll
                            for (int e = 0; e < 4; ++e) { const float v = acc[ai][bj][m][n][e]; s += v; q += v * v; } } }
                if (STATS) { s += __shfl_xor(s, 16); s += __shfl_xor(s, 32); q += __shfl_xor(q, 16); q += __shfl_xor(q, 32);
                    if (fq == 0) { float* st = ST + (((size_t)(ch * 256 + i) * 4 + h) * 8 + nt2 * 4 + wc) * 2; st[0] = s; st[1] = q; } } }
    }
};

template <int KIND> struct EpiG {
    static constexpr bool PERM = true; bf16_t* Z; float* ST; const float* gng; const float* PS; const float* XS; const float* DC; const float* EM; int pair;
    __device__ __forceinline__ void mid(Acc&, const gm::U&, int, int, int, int) const {}
    __device__ __forceinline__ void operator()(const Acc& acc, const gm::U& u, int wr, int wc, int fr_, int fq_) const {
        int fr = fr_, fq = fq_; asm volatile("" : "+v"(fr), "+v"(fq));
        const int pm = u.i0, pn = u.i1, h = 2 * pair + (pn >> 1), nt2 = pn & 1, c0 = wc * 32 + 8 * fq;
        const int colb = pair * 1024 + pn * 256 + c0;
        f32x4 gv[2][2];
        if (KIND == 0) {
#pragma unroll
            for (int bj = 0; bj < 2; ++bj)
#pragma unroll
                for (int n = 0; n < 2; ++n) gv[bj][n] = *(const f32x4*)(gng + colb + bj * 128 + 4 * n);
        }
#pragma unroll
        for (int ai = 0; ai < 2; ++ai)
#pragma unroll
            for (int m = 0; m < 4; ++m) {
                const int t = pm * 256 + ai * 128 + wr * 64 + m * 16 + fr;
                bf16_t* zp = Z + (size_t)t * 2048 + colb;
                if (KIND == 0) {
                    const f32x4* st = (const f32x4*)(ST + ((size_t)t * 4 + h) * 16);
                    const f32x4 a = st[0], b = st[1], c = st[2], d = st[3];
                    const float s = (a[0] + a[2]) + (b[0] + b[2]) + (c[0] + c[2]) + (d[0] + d[2]);
                    const float q = (a[1] + a[3]) + (b[1] + b[3]) + (c[1] + c[3]) + (d[1] + d[3]);
                    const float mu = s * (1.0f / 512.0f); const float var = fmaxf(q * (1.0f / 512.0f) - mu * mu, 0.f); const float rstd = rsqrtf(var + EPS);
#pragma unroll
                    for (int bj = 0; bj < 2; ++bj) { float y[8]; unpack8(*(const u32x4*)(zp + bj * 128), y); f32x4 o[2];
#pragma unroll
                        for (int n = 0; n < 2; ++n)
#pragma unroll
                            for (int e = 0; e < 4; ++e) o[n][e] = siluf(acc[ai][bj][m][n][e]) * (y[4 * n + e] - mu) * rstd * gv[bj][n][e];
                        *(u32x4*)(zp + bj * 128) = pack8(o[0], o[1]); }
                } else {
                    const f32x4 ps = *(const f32x4*)(PS + ((size_t)t * 4 + h) * 4);
                    const float den = (ps[0] + ps[1]) + (ps[2] + ps[3]) + XS[(size_t)h * S_ + t] * DC[(size_t)t * 4 + h];
                    const float inv = 1.0f / fmaxf(fabsf(den), EM[(size_t)h * S_ + t]);
                    float s = 0.f, q = 0.f;
#pragma unroll
                    for (int bj = 0; bj < 2; ++bj) { float y[8]; unpack8(*(const u32x4*)(zp + bj * 128), y); f32x4 o[2];
#pragma unroll
                        for (int n = 0; n < 2; ++n)
#pragma unroll
                            for (int e = 0; e < 4; ++e) { const float v = sigmf(acc[ai][bj][m][n][e]) * y[4 * n + e] * inv; o[n][e] = v; s += v; q += v * v; }
                        *(u32x4*)(zp + bj * 128) = pack8(o[0], o[1]); }
                    s += __shfl_xor(s, 16); s += __shfl_xor(s, 32); q += __shfl_xor(q, 16); q += __shfl_xor(q, 32);
                    if (fq == 0) { float* st = ST + (((size_t)t * 4 + h) * 8 + nt2 * 4 + wc) * 2; st[0] = s; st[1] = q; }
                }
            }
    }
};

struct EpiRes {
    static constexpr bool PERM = false; const float* base; float* out; const float* gate;
    __device__ __forceinline__ void mid(Acc&, const gm::U&, int, int, int, int) const {}
    __device__ __forceinline__ void operator()(const Acc& acc, const gm::U& u, int wr, int wc, int fr_, int fq_) const {
        int fr = fr_, fq = fq_; asm volatile("" : "+v"(fr), "+v"(fq));
        const int row0 = u.i0 * 256 + wr * 64 + fr, col0 = u.i1 * 256 + wc * 32 + 4 * fq;
        f32x4 gv[2][2];
#pragma unroll
        for (int bj = 0; bj < 2; ++bj)
#pragma unroll
            for (int n = 0; n < 2; ++n) gv[bj][n] = *(const f32x4*)(gate + col0 + bj * 128 + n * 16);
#pragma unroll
        for (int ai = 0; ai < 2; ++ai)
#pragma unroll
            for (int m = 0; m < 4; ++m) { const size_t ro = (size_t)(row0 + ai * 128 + m * 16) * 1024 + col0;
#pragma unroll
                for (int bj = 0; bj < 2; ++bj)
#pragma unroll
                    for (int n = 0; n < 2; ++n) { const size_t o = ro + bj * 128 + n * 16; const f32x4 b = *(const f32x4*)(base + o); *(f32x4*)(out + o) = b + gv[bj][n] * acc[ai][bj][m][n]; } }
    }
};

struct EpiUp {
    static constexpr bool PERM = true; bf16_t* act; bf16_t* fh; const float* cw; const float* cb;
    __device__ __forceinline__ void mid(Acc&, const gm::U&, int, int, int, int) const {}
    __device__ __forceinline__ void operator()(const Acc& acc, const gm::U& u, int wr, int wc, int fr_, int fq_) const {
        int fr = fr_, fq = fq_; asm volatile("" : "+v"(fr), "+v"(fq));
        const int pm = u.i0, pn = u.i1, c0 = wc * 32 + 8 * fq, lane = fq * 16 + fr;
        const int src1 = (lane & 48) | ((fr + 15) & 15), src2 = (lane & 48) | ((fr + 14) & 15);
        u32x2 pk0[2][4];
#pragma unroll
        for (int n = 0; n < 2; ++n) {
            f32x4 w0[2], w1[2], w2[2], bb[2];
#pragma unroll
            for (int bj = 0; bj < 2; ++bj) { const int chn = bj * DFF + pn * 128 + c0 + 4 * n;
                w0[bj] = *(const f32x4*)(cw + chn); w1[bj] = *(const f32x4*)(cw + 2 * DFF + chn); w2[bj] = *(const f32x4*)(cw + 4 * DFF + chn); bb[bj] = *(const f32x4*)(cb + chn); }
#pragma unroll
            for (int ai = 0; ai < 2; ++ai)
#pragma unroll
                for (int m = 0; m < 4; ++m) {
                    f32x4 uu[2];
#pragma unroll
                    for (int bj = 0; bj < 2; ++bj)
#pragma unroll
                        for (int e = 0; e < 4; ++e) {
                            const float cur = acc[ai][bj][m][n][e]; const float prv = m > 0 ? acc[ai][bj][m > 0 ? m - 1 : 0][n][e] : 0.f;
                            const float p1 = __shfl((fr == 15) ? prv : cur, src1), p2 = __shfl((fr >= 14) ? prv : cur, src2);
                            uu[bj][e] = bb[bj][e] + w0[bj][e] * p2 + w1[bj][e] * p1 + w2[bj][e] * cur; }
                    u32x2 pk; pk.x = cvt_pk_bf16(siluf(uu[0][0]) * uu[1][0], siluf(uu[0][1]) * uu[1][1]); pk.y = cvt_pk_bf16(siluf(uu[0][2]) * uu[1][2], siluf(uu[0][3]) * uu[1][3]);
                    if (n == 0) pk0[ai][m] = pk;
                    else { const int t = pm * 256 + ai * 128 + wr * 64 + m * 16 + fr; u32x4 w; w.x = pk0[ai][m].x; w.y = pk0[ai][m].y; w.z = pk.x; w.w = pk.y;
                        *(u32x4*)(act + (size_t)t * DFF + pn * 128 + c0) = w; }
                }
        }
#pragma unroll
        for (int ai = 0; ai < 2; ++ai) {
            const int gq = pm * 4 + ai * 2 + wr;
            if (fr >= 14) {
#pragma unroll
                for (int bj = 0; bj < 2; ++bj) *(u32x4*)(fh + ((size_t)gq * 4 + (fr - 14)) * (2 * DFF) + pn * 256 + bj * 128 + c0) = pack8(acc[ai][bj][3][0], acc[ai][bj][3][1]);
            }
            if (fr < 2) {
#pragma unroll
                for (int bj = 0; bj < 2; ++bj) *(u32x4*)(fh + ((size_t)gq * 4 + 2 + fr) * (2 * DFF) + pn * 256 + bj * 128 + c0) = pack8(acc[ai][bj][0][0], acc[ai][bj][0][1]);
            }
        }
    }
};

struct SchedS { const char* Q; const char* K; int G, c;
    __device__ __forceinline__ bool next(int i, gm::U& u) const { const int L = i * G + c; if (L >= 128) return false; const int h2 = L & 1, ch = L >> 1;
        const size_t o = ((size_t)h2 * S_ + ch * 256) * 256 * 2; u.a1 = Q + o; u.b1 = K + o; u.a2 = u.a1; u.b2 = u.b1; u.co = 0; u.i0 = ch; u.i1 = h2; u.i2 = 0; u.i3 = 0; return true; } };
struct SchedKV { const char* VT; const char* KWT; int G, c;
    __device__ __forceinline__ bool next(int i, gm::U& u) const { const int L = i * G + c; if (L >= 256) return false; const int mt = L & 1, h2 = (L >> 1) & 1, ch = L >> 2;
        u.a1 = VT + ((size_t)(h2 * 64 + ch) * 512 + mt * 256) * 256 * 2; u.b1 = KWT + ((size_t)(h2 * 64 + ch) * 256) * 256 * 2; u.a2 = u.a1; u.b2 = u.b1;
        u.co = ((long)(h2 * 64 + ch) * 512 + mt * 256) * 256; u.i0 = ch; u.i1 = h2; u.i2 = mt; u.i3 = 0; return true; } };
struct SchedO { const char* Q; const char* KVT; const char* P; const char* VT; int G, c;
    __device__ __forceinline__ bool next(int i, gm::U& u) const { const int L = i * G + c; if (L >= 256) return false; const int nt2 = L & 1, h2 = (L >> 1) & 1, ch = L >> 2;
        u.a1 = Q + ((size_t)h2 * S_ + ch * 256) * 256 * 2; u.b1 = KVT + ((size_t)(h2 * 64 + ch) * 512 + nt2 * 256) * 256 * 2;
        u.a2 = P + ((size_t)(h2 * 64 + ch) * 65536) * 2; u.b2 = VT + ((size_t)(h2 * 64 + ch) * 512 + nt2 * 256) * 256 * 2;
        u.co = 0; u.i0 = ch; u.i1 = h2; u.i2 = nt2; u.i3 = 0; return true; } };

struct Frame { LAS unsigned char* lds; int G, bid, tid, wid, lane; };
__device__ __forceinline__ Frame fresh(const Frame& f) { Frame r = f; asm volatile("" : "+v"(r.tid)); r.lane = r.tid & 63; r.wid = __builtin_amdgcn_readfirstlane(r.tid >> 6); return r; }

__device__ __forceinline__ void wt_tile(const Frame& F, const float* src, int ldsrc, int k0, int c0, bf16_t* dst, int lddst, int r0) {
    LAS float* tile = (LAS float*)F.lds;
    const int tx = F.tid & 63, ty = F.tid >> 6;
#pragma unroll
    for (int i = 0; i < 8; ++i) tile[(ty + 8 * i) * 65 + tx] = src[(size_t)(k0 + ty + 8 * i) * ldsrc + c0 + tx];
    __syncthreads();
    const int n = F.tid >> 3, kk = (F.tid & 7) * 8;
    u32x4 w; w.x = cvt_pk_bf16(tile[(kk + 0) * 65 + n], tile[(kk + 1) * 65 + n]); w.y = cvt_pk_bf16(tile[(kk + 2) * 65 + n], tile[(kk + 3) * 65 + n]);
    w.z = cvt_pk_bf16(tile[(kk + 4) * 65 + n], tile[(kk + 5) * 65 + n]); w.w = cvt_pk_bf16(tile[(kk + 6) * 65 + n], tile[(kk + 7) * 65 + n]);
    *(u32x4*)(dst + (size_t)(r0 + n) * lddst + k0 + kk) = w;
    __syncthreads();
}
__device__ __forceinline__ void convert_mixer_weights(const Frame& F, const Params& p, int layer) {
    const float* win = layer == 0 ? p.ret_w_in : p.ml_w_in; const int ldin = layer == 0 ? 6144 : 6152;
    const float* wout = layer == 0 ? p.ret_w_out : p.ml_w_out;
    bf16_t* WIN = (bf16_t*)(p.ws + OFF_WIN); bf16_t* WOUT = (bf16_t*)(p.ws + OFF_WOUT);
    for (int u = F.bid; u < 2048; u += F.G) {
        if (u < 1536) { const int kt = u & 15, ct = u >> 4; wt_tile(F, win, ldin, kt * 64, ct * 64, WIN, 1024, ct * 64); }
        else { const int v = u - 1536, kt = v & 31, ct = v >> 5; wt_tile(F, wout, 1024, kt * 64, ct * 64, WOUT, 2048, ct * 64); }
    }
}
__device__ __forceinline__ void convert_ffn_weights(const Frame& F, const Params& p, int layer) {
    const float* wup = p.up_w + (size_t)layer * 1024 * 5632; const float* wdn = p.dn_w + (size_t)layer * 2816 * 1024;
    bf16_t* WUP = (bf16_t*)(p.ws + OFF_WUP); bf16_t* WDN = (bf16_t*)(p.ws + OFF_WDN);
    for (int u = F.bid; u < 2112; u += F.G) {
        if (u < 1408) { const int kt = u & 15, ct = u >> 4, c0 = ct * 64;
            const int cc = c0 < DFF ? c0 : c0 - DFF; const int r0 = (cc >> 7) * 256 + (c0 < DFF ? 0 : 128) + (cc & 127);
            wt_tile(F, wup, 5632, kt * 64, c0, WUP, 1024, r0); }
        else { const int v = u - 1408, kt = v % 44, ct = v / 44; wt_tile(F, wdn, 1024, kt * 64, ct * 64, WDN, 2816, ct * 64); }
    }
}

__device__ __forceinline__ void prologue_phase(const Frame& F, const Params& p) {
    float* MOD = (float*)(p.ws + OFF_SM + SM_MOD);
    LAS float* red = (LAS float*)F.lds;
    for (int u = F.bid; u < 192; u += F.G) {
        const int l = u / 96, cgp = u % 96, cq = F.tid & 15, kg = F.tid >> 4;
        const float* w = p.ada_w + (size_t)l * 1024 * 6144 + cgp * 64 + cq * 4;
        f32x4 a = {0.f, 0.f, 0.f, 0.f};
#pragma unroll 8
        for (int k = kg * 32; k < kg * 32 + 32; ++k) { const float cv = p.c[k]; const float ca = siluf(cv); a += ca * *(const f32x4*)(w + (size_t)k * 6144); }
        __syncthreads();
#pragma unroll
        for (int e = 0; e < 4; ++e) red[kg * 64 + cq * 4 + e] = a[e];
        __syncthreads();
        if (F.tid < 64) { float s = 0.f; for (int k = 0; k < 32; ++k) s += red[k * 64 + F.tid]; MOD[l * 6144 + cgp * 64 + F.tid] = s + p.ada_b[l * 6144 + cgp * 64 + F.tid]; }
    }
    const int gt = F.bid * 512 + F.tid, gn = F.G * 512;
    if (gt < 128) ((float*)(p.ws + OFF_SM + SM_IFQ))[gt] = powf(10000.0f, -(float)(2 * gt) / 256.0f);
    float* RB = (float*)(p.ws + OFF_SM + SM_RB); float* CB = (float*)(p.ws + OFF_SM + SM_CB); float* XS = (float*)(p.ws + OFF_SM + SM_XS); float* WK = (float*)(p.ws + OFF_SM + SM_WK);
    for (int e = gt; e < 4 * S_; e += gn) { const int h = e >> 14, t = e & (S_ - 1), i = t & 255; const float lg = logf(1.0f - exp2f(-5.0f - (float)h));
        RB[e] = (float)i * lg; CB[e] = -(float)i * lg; XS[e] = expf((float)(i + 1) * lg); WK[e] = expf((float)(255 - i) * lg); }
    if (gt < 256) { const int h = gt >> 6; const float lg = logf(1.0f - exp2f(-5.0f - (float)h)); ((float*)(p.ws + OFF_SM + SM_SCP))[gt] = expf(256.0f * lg); ((float*)(p.ws + OFF_SM + SM_SCN))[gt] = 1.0f; }
}

template <bool GATES> __device__ __forceinline__ void norm_phase(const Frame& F, const Params& p, const float* xin, const float* g, const float* sh, const float* sc) {
    bf16_t* H = (bf16_t*)(p.ws + OFF_H);
    LAS float* wg = (LAS float*)F.lds;
    if (GATES) { __syncthreads(); for (int e = F.tid; e < 8192; e += 512) wg[e] = p.ml_w_in[(size_t)(e >> 3) * 6152 + 6144 + (e & 7)]; __syncthreads(); }
    float* LI = (float*)(p.ws + OFF_SM + SM_LI); float* LF = (float*)(p.ws + OFF_SM + SM_LF);
    f32x4 gv[4], scv[4], shv[4];
#pragma unroll
    for (int j = 0; j < 4; ++j) { const int c = F.lane * 4 + 256 * j; gv[j] = *(const f32x4*)(g + c); scv[j] = *(const f32x4*)(sc + c); shv[j] = *(const f32x4*)(sh + c); }
    for (int row = F.bid * 8 + F.wid; row < S_; row += F.G * 8) {
        f32x4 xv[4]; float ss = 0.f;
#pragma unroll
        for (int j = 0; j < 4; ++j) { xv[j] = *(const f32x4*)(xin + (size_t)row * 1024 + F.lane * 4 + 256 * j); ss += xv[j][0] * xv[j][0] + xv[j][1] * xv[j][1] + xv[j][2] * xv[j][2] + xv[j][3] * xv[j][3]; }
        ss = wave_sum(ss); const float rstd = rsqrtf(ss * (1.0f / 1024.0f) + EPS);
        float gp[8];
        if (GATES) {
#pragma unroll
            for (int k = 0; k < 8; ++k) gp[k] = 0.f; }
#pragma unroll
        for (int j = 0; j < 4; ++j) { f32x4 hv;
#pragma unroll
            for (int e = 0; e < 4; ++e) hv[e] = xv[j][e] * rstd * gv[j][e] * (1.0f + scv[j][e]) + shv[j][e];
            u32x2 w; w.x = cvt_pk_bf16(hv[0], hv[1]); w.y = cvt_pk_bf16(hv[2], hv[3]);
            *(u32x2*)(H + (size_t)row * 1024 + F.lane * 4 + 256 * j) = w;
            if (GATES) {
#pragma unroll
                for (int e = 0; e < 4; ++e) { const LAS float* wr_ = wg + (F.lane * 4 + 256 * j + e) * 8;
#pragma unroll
                    for (int k = 0; k < 8; ++k) gp[k] += hv[e] * wr_[k]; } } }
        if (GATES) {
#pragma unroll
            for (int k = 0; k < 8; ++k) gp[k] = wave_sum(gp[k]);
            if (F.lane == 0) {
#pragma unroll
                for (int k = 0; k < 4; ++k) { LI[(size_t)row * 4 + k] = gp[k] + p.ml_bg[k]; const float v = gp[4 + k] + p.ml_bg[4 + k]; LF[(size_t)row * 4 + k] = fminf(v, 0.f) - log1pf(expf(-fabsf(v))); } } }
    }
}

__device__ __forceinline__ void prep_a(const Frame& F, const Params& p) {
    const float* LI = (const float*)(p.ws + OFF_SM + SM_LI); const float* LF = (const float*)(p.ws + OFF_SM + SM_LF);
    float* GG = (float*)(p.ws + OFF_SM + SM_GG); float* CB = (float*)(p.ws + OFF_SM + SM_CB); float* PM = (float*)(p.ws + OFF_SM + SM_PM); float* WK = (float*)(p.ws + OFF_SM + SM_WK);
    float* GL = (float*)(p.ws + OFF_SM + SM_GL); float* ML = (float*)(p.ws + OFF_SM + SM_ML);
    for (int u = F.bid; u < 256 && F.wid == 0; u += F.G) {
        const int h = u >> 6, ch = u & 63, t0 = ch * 256 + F.lane * 4;
        float g[4], cb[4], pm[4]; float run = 0.f;
#pragma unroll
        for (int e = 0; e < 4; ++e) { run += LF[(size_t)(t0 + e) * 4 + h]; g[e] = run; }
        float incl = run;
        for (int o = 1; o < 64; o <<= 1) { const float v = __shfl_up(incl, o); if (F.lane >= o) incl += v; }
        const float excl = incl - run;
        float lm = -INFINITY;
#pragma unroll
        for (int e = 0; e < 4; ++e) { g[e] += excl; cb[e] = LI[(size_t)(t0 + e) * 4 + h] - g[e]; lm = fmaxf(lm, cb[e]); pm[e] = lm; }
        float im = lm;
        for (int o = 1; o < 64; o <<= 1) { const float v = __shfl_up(im, o); if (F.lane >= o) im = fmaxf(im, v); }
        float em = __shfl_up(im, 1); if (F.lane == 0) em = -INFINITY;
#pragma unroll
        for (int e = 0; e < 4; ++e) pm[e] = fmaxf(pm[e], em);
        const float gL = __shfl(g[3], 63), pml = __shfl(pm[3], 63);
#pragma unroll
        for (int e = 0; e < 4; ++e) { const size_t o = (size_t)h * S_ + t0 + e; GG[o] = g[e]; CB[o] = cb[e]; PM[o] = pm[e]; WK[o] = expf(cb[e] - pml); }
        if (F.lane == 0) { GL[u] = gL; ML[u] = gL + pml; }
    }
}
__device__ __forceinline__ void prep_b(const Frame& F, const Params& p) {
    const float* GG = (const float*)(p.ws + OFF_SM + SM_GG); const float* PM = (const float*)(p.ws + OFF_SM + SM_PM);
    const float* GL = (const float*)(p.ws + OFF_SM + SM_GL); const float* ML = (const float*)(p.ws + OFF_SM + SM_ML);
    float* RB = (float*)(p.ws + OFF_SM + SM_RB); float* XS = (float*)(p.ws + OFF_SM + SM_XS); float* EM = (float*)(p.ws + OFF_SM + SM_EM);
    float* SCP = (float*)(p.ws + OFF_SM + SM_SCP); float* SCN = (float*)(p.ws + OFF_SM + SM_SCN);
    for (int u = F.bid; u < 256 && F.wid == 0; u += F.G) {
        const int h = u >> 6, ch = u & 63;
        float m = 0.f; for (int c2 = 0; c2 < ch; ++c2) m = fmaxf(GL[h * 64 + c2] + m, ML[h * 64 + c2]);
#pragma unroll
        for (int e = 0; e < 4; ++e) { const size_t o = (size_t)h * S_ + ch * 256 + F.lane * 4 + e; const float mx = fmaxf(m, PM[o]); RB[o] = -mx; XS[o] = expf(m - mx); EM[o] = expf(-(GG[o] + mx)); }
        if (F.lane == 0) { const float mn = fmaxf(GL[u] + m, ML[u]); SCP[u] = expf(GL[u] + m - mn); SCN[u] = expf(ML[u] - mn); }
    }
}

template <int KIND> __device__ __forceinline__ void r3_pass(const Frame& F, const Params& p, int pair) {
    bf16_t* Qb = (bf16_t*)(p.ws + OFF_Q); bf16_t* Kb = (bf16_t*)(p.ws + OFF_K); bf16_t* KWT = (bf16_t*)(p.ws + OFF_KWT);
    const bf16_t* QKH = (const bf16_t*)(p.ws + OFF_SM + SM_QKH); const float* WK = (const float*)(p.ws + OFF_SM + SM_WK); float* NLOC = (float*)(p.ws + OFF_SM + SM_NLOC);
    LAS bf16_t* T = (LAS bf16_t*)F.lds;
    const int tr = F.tid >> 3, tc = (F.tid & 7) * 8;
    for (int u = F.bid; u < 1024; u += F.G) {
        const int ch = u >> 4, pc0 = (u & 15) * 64; const bool isk = pc0 >= 512;
        if (KIND == 0 && !isk) continue;
        const int bc0 = pc0 & 511, h2 = bc0 >> 8, h = 2 * pair + h2;
        bf16_t* buf = (isk ? Kb : Qb) + (size_t)h2 * S_ * 256 + (bc0 & 255) + tc;
        float cw[4][8], cbias[8];
        if (KIND == 1) { const int gc = (isk ? 1024 : 0) + pair * 512 + bc0 + tc;
#pragma unroll
            for (int j = 0; j < 4; ++j) { const f32x4 a = *(const f32x4*)(p.ml_cw + j * 2048 + gc), b = *(const f32x4*)(p.ml_cw + j * 2048 + gc + 4);
#pragma unroll
                for (int e = 0; e < 4; ++e) { cw[j][e] = a[e]; cw[j][4 + e] = b[e]; } }
            const f32x4 a = *(const f32x4*)(p.ml_cb + gc), b = *(const f32x4*)(p.ml_cb + gc + 4);
#pragma unroll
            for (int e = 0; e < 4; ++e) { cbias[e] = a[e]; cbias[4 + e] = b[e]; } }
        float nsum = 0.f;
        for (int s = 0; s < 4; ++s) {
            const int t = ch * 256 + s * 64 + tr;
            float v[8]; unpack8(*(const u32x4*)(buf + (size_t)t * 256), v);
            if (KIND == 1) {
                float o[8];
#pragma unroll
                for (int e = 0; e < 8; ++e) o[e] = cbias[e] + cw[3][e] * v[e];
#pragma unroll
                for (int d = 1; d <= 3; ++d) { const int tt = t - d; u32x4 w = {0u, 0u, 0u, 0u};
                    if (tr - d >= 0) w = *(const u32x4*)(buf + (size_t)tt * 256);
                    else if (tt >= 0) w = *(const u32x4*)(QKH + ((size_t)(tt >> 6) * 3 + ((tt & 63) - 61)) * 1024 + pc0 + tc);
                    float x[8]; unpack8(w, x);
#pragma unroll
                    for (int e = 0; e < 8; ++e) o[e] += cw[3 - d][e] * x[e]; }
#pragma unroll
                for (int e = 0; e < 8; ++e) { v[e] = siluf(o[e]); if (isk) v[e] *= 0.0625f; }
                __syncthreads();
                u32x4 w; w.x = cvt_pk_bf16(v[0], v[1]); w.y = cvt_pk_bf16(v[2], v[3]); w.z = cvt_pk_bf16(v[4], v[5]); w.w = cvt_pk_bf16(v[6], v[7]);
                *(u32x4*)(buf + (size_t)t * 256) = w;
            }
            if (isk) {
                const float wk = WK[(size_t)h * S_ + t];
#pragma unroll
                for (int e = 0; e < 8; e += 2) { const unsigned w = cvt_pk_bf16(v[e] * wk, v[e + 1] * wk); T[(tc + e) * 72 + tr] = (bf16_t)(w & 0xffffu); T[(tc + e + 1) * 72 + tr] = (bf16_t)(w >> 16); }
                __syncthreads();
                const int col = F.tid >> 3, seg = F.tid & 7;
                const u32x4 w = *(const LAS u32x4*)(T + col * 72 + seg * 8);
                *(u32x4*)(KWT + ((size_t)(h2 * 64 + ch) * 256 + (bc0 & 255) + col) * 256 + s * 64 + seg * 8) = w;
                float x[8]; unpack8(w, x); nsum += ((x[0] + x[1]) + (x[2] + x[3])) + ((x[4] + x[5]) + (x[6] + x[7]));
                __syncthreads();
            }
        }
        if (KIND == 1 && isk) { nsum += __shfl_xor(nsum, 1); nsum += __shfl_xor(nsum, 2); nsum += __shfl_xor(nsum, 4);
            if ((F.tid & 7) == 0) NLOC[((size_t)h * 64 + ch) * 256 + (bc0 & 255) + (F.tid >> 3)] = nsum; }
    }
}

template <int KIND> __device__ __forceinline__ void scan_phase(const Frame& F, const Params& p, int pair) {
    unsigned* KV = (unsigned*)(p.ws + OFF_KVT);
    const float* SCP = (const float*)(p.ws + OFF_SM + SM_SCP); const float* SCN = (const float*)(p.ws + OFF_SM + SM_SCN);
    for (int e0 = F.bid * 512; e0 < 131072; e0 += F.G * 512) {
        const int h2 = e0 >> 16, h = 2 * pair + h2; unsigned* base = KV + (size_t)h2 * 64 * 65536 + (e0 & 65535) + F.tid;
        float s0 = 0.f, s1 = 0.f;
#pragma unroll 1
        for (int cb = 0; cb < 64; cb += 16) {
            unsigned v[16];
#pragma unroll
            for (int c = 0; c < 16; ++c) v[c] = base[(size_t)(cb + c) * 65536];
#pragma unroll
            for (int c = 0; c < 16; ++c) { base[(size_t)(cb + c) * 65536] = cvt_pk_bf16(s0, s1); const float a = SCP[h * 64 + cb + c], b = SCN[h * 64 + cb + c]; s0 = a * s0 + b * bf_lo(v[c]); s1 = a * s1 + b * bf_hi(v[c]); }
        }
    }
    if (KIND == 1) {
        const float* NLOC = (const float*)(p.ws + OFF_SM + SM_NLOC); const bf16_t* Qb = (const bf16_t*)(p.ws + OFF_Q); float* DC = (float*)(p.ws + OFF_SM + SM_DC);
        LAS float* nv = (LAS float*)F.lds;
        for (int u = F.bid; u < 128; u += F.G) {
            const int h2 = u & 1, ch = u >> 1, h = 2 * pair + h2;
            __syncthreads();
            if (F.tid < 256) { float n = 0.f; for (int c2 = 0; c2 < ch; ++c2) n = SCP[h * 64 + c2] * n + SCN[h * 64 + c2] * NLOC[((size_t)h * 64 + c2) * 256 + F.tid]; nv[F.tid] = n; }
            __syncthreads();
            const f32x4 nn = *(const LAS f32x4*)(nv + F.lane * 4);
            for (int r = 0; r < 32; ++r) { const int t = ch * 256 + F.wid * 32 + r;
                const u32x2 w = *(const u32x2*)(Qb + ((size_t)h2 * S_ + t) * 256 + F.lane * 4);
                float d = bf_lo(w.x) * nn[0] + bf_hi(w.x) * nn[1] + bf_lo(w.y) * nn[2] + bf_hi(w.y) * nn[3];
                d = wave_sum(d); if (F.lane == 0) DC[(size_t)t * 4 + h] = d; }
        }
    }
}

__device__ __forceinline__ void gn_pass(const Frame& F, const Params& p) {
    bf16_t* Z = (bf16_t*)(p.ws + OFF_Z); const float* ST = (const float*)(p.ws + OFF_SM + SM_ST);
    for (int u = F.bid * 8 + F.wid; u < S_ * 4; u += F.G * 8) {
        const int t = u >> 2, h = u & 3;
        const f32x4* st = (const f32x4*)(ST + (size_t)u * 16); const f32x4 a = st[0], b = st[1], c = st[2], d = st[3];
        const float s = (a[0] + a[2]) + (b[0] + b[2]) + (c[0] + c[2]) + (d[0] + d[2]), q = (a[1] + a[3]) + (b[1] + b[3]) + (c[1] + c[3]) + (d[1] + d[3]);
        const float mu = s * (1.0f / 512.0f), rstd = rsqrtf(fmaxf(q * (1.0f / 512.0f) - mu * mu, 0.f) + EPS);
        bf16_t* zp = Z + (size_t)t * 2048 + h * 512 + F.lane * 8; float y[8]; unpack8(*(const u32x4*)zp, y);
        const f32x4 g0 = *(const f32x4*)(p.ml_gn + h * 512 + F.lane * 8), g1 = *(const f32x4*)(p.ml_gn + h * 512 + F.lane * 8 + 4);
        f32x4 o0, o1;
#pragma unroll
        for (int e = 0; e < 4; ++e) { o0[e] = (y[e] - mu) * rstd * g0[e]; o1[e] = (y[4 + e] - mu) * rstd * g1[e]; }
        *(u32x4*)zp = pack8(o0, o1);
    }
}

__device__ __forceinline__ void ffn_fix(const Frame& F, const Params& p, int layer) {
    const bf16_t* FH = (const bf16_t*)(p.ws + OFF_FH); bf16_t* ACT = (bf16_t*)(p.ws + OFF_ACT);
    const float* cw = p.fcw + (size_t)layer * 3 * 5632; const float* cb = p.fcb + (size_t)layer * 5632;
    for (int it = F.bid * 512 + F.tid; it < 256 * 2 * 352; it += F.G * 512) {
        const int c8 = it % 352, r = (it / 352) & 1, gq = it / 704; const int chn = c8 * 8, pn = chn >> 7, cc = chn & 127;
        float ua[8], ub[8];
#pragma unroll
        for (int bj = 0; bj < 2; ++bj) {
            float* uo = bj ? ub : ua; const int col = pn * 256 + bj * 128 + cc, wch = bj * DFF + chn;
            float x0[8], x1[8], x2[8];
            const u32x4 z = {0u, 0u, 0u, 0u};
            u32x4 w0 = z, w1 = z, w2;
            if (r == 0) { if (gq > 0) { w0 = *(const u32x4*)(FH + ((size_t)(gq - 1) * 4 + 0) * 5632 + col); w1 = *(const u32x4*)(FH + ((size_t)(gq - 1) * 4 + 1) * 5632 + col); } w2 = *(const u32x4*)(FH + ((size_t)gq * 4 + 2) * 5632 + col); }
            else { if (gq > 0) w0 = *(const u32x4*)(FH + ((size_t)(gq - 1) * 4 + 1) * 5632 + col); w1 = *(const u32x4*)(FH + ((size_t)gq * 4 + 2) * 5632 + col); w2 = *(const u32x4*)(FH + ((size_t)gq * 4 + 3) * 5632 + col); }
            unpack8(w0, x0); unpack8(w1, x1); unpack8(w2, x2);
#pragma unroll
            for (int e = 0; e < 8; ++e) uo[e] = cb[wch + e] + cw[wch + e] * x0[e] + cw[5632 + wch + e] * x1[e] + cw[2 * 5632 + wch + e] * x2[e];
        }
        f32x4 o0, o1;
#pragma unroll
        for (int e = 0; e < 4; ++e) { o0[e] = siluf(ua[e]) * ub[e]; o1[e] = siluf(ua[4 + e]) * ub[4 + e]; }
        *(u32x4*)(ACT + (size_t)(gq * 64 + r) * DFF + chn) = pack8(o0, o1);
    }
}

__device__ __forceinline__ void final_norm(const Frame& F, const Params& p) {
    for (int row = F.bid * 8 + F.wid; row < S_; row += F.G * 8) {
        f32x4 xv[4]; float ss = 0.f;
#pragma unroll
        for (int j = 0; j < 4; ++j) { xv[j] = *(const f32x4*)(p.out + (size_t)row * 1024 + F.lane * 4 + 256 * j); ss += xv[j][0] * xv[j][0] + xv[j][1] * xv[j][1] + xv[j][2] * xv[j][2] + xv[j][3] * xv[j][3]; }
        ss = wave_sum(ss); const float rstd = rsqrtf(ss * (1.0f / 1024.0f) + EPS);
#pragma unroll
        for (int j = 0; j < 4; ++j) { const f32x4 g = *(const f32x4*)(p.fin_g + F.lane * 4 + 256 * j); *(f32x4*)(p.out + (size_t)row * 1024 + F.lane * 4 + 256 * j) = xv[j] * rstd * g; }
    }
}

constexpr int N_PHASES = 39;
#ifdef ONLY_PH
#define PH_ON(k) ((k) == ONLY_PH)
#else
#define PH_ON(k) (p.ph_lo <= (k) && (k) < p.ph_hi)
#endif
#define PH_END(k) do { if ((k) + 1 < p.ph_hi) { __syncthreads(); grid.sync(); } } while (0)

template <int KIND, int PAIR> __device__ __forceinline__ void pair_program(const Frame& F0, const Params& p, cg::grid_group& grid, int base) {
    unsigned char* ws = p.ws;
    const char* H = (const char*)(ws + OFF_H); const char* WIN = (const char*)(ws + OFF_WIN);
    constexpr int pair = PAIR;
    if (PH_ON(base + 0)) { const Frame F = fresh(F0);
        { gm::SchedPlain S{H, WIN + (size_t)(pair * 512) * 2048, WIN + (size_t)(1024 + pair * 512) * 2048, 64, 4, 2, F.G, F.bid, (size_t)256 * 2048, (size_t)256 * 2048, 256, 0};
          EpiQK<KIND> E{(bf16_t*)(ws + OFF_Q), (bf16_t*)(ws + OFF_K), p.pos, (const float*)(ws + OFF_SM + SM_IFQ), (bf16_t*)(ws + OFF_SM + SM_QKH)};
          gm::gemm_phase<EpiQK<KIND>, gm::SchedPlain, false>(F.lds, gm::GP{1024, 1024, 16, 16}, S, E); }
        { gm::SchedPlain S{WIN + (size_t)(2048 + pair * 1024) * 2048, H, H, 4, 64, 64, F.G, F.bid, (size_t)256 * 2048, (size_t)256 * 2048, 256, 1};
          EpiPlain E{(bf16_t*)(ws + OFF_VT), 256};
          gm::gemm_phase<EpiPlain, gm::SchedPlain, false>(F.lds, gm::GP{1024, 1024, 16, 16}, S, E); }
        if (KIND == 1 && pair == 0) prep_a(F, p);
        PH_END(base + 0); }
    if (PH_ON(base + 1)) { const Frame F = fresh(F0);
        if (KIND == 1 && pair == 0) prep_b(F, p);
        r3_pass<KIND>(F, p, pair);
        PH_END(base + 1); }
    if (PH_ON(base + 2)) { const Frame F = fresh(F0);
        { SchedKV S{(const char*)(ws + OFF_VT), (const char*)(ws + OFF_KWT), F.G, F.bid}; EpiPlain E{(bf16_t*)(ws + OFF_KVT), 256};
          gm::gemm_phase<EpiPlain, SchedKV, false>(F.lds, gm::GP{256, 256, 4, 4}, S, E); }
        { SchedS S{(const char*)(ws + OFF_Q), (const char*)(ws + OFF_K), F.G, (F.bid + 128) % F.G};
          EpiS<KIND == 1> E{(bf16_t*)(ws + OFF_P), (const float*)(ws + OFF_SM + SM_RB), (const float*)(ws + OFF_SM + SM_CB), (float*)(ws + OFF_SM + SM_PS), pair};
          gm::gemm_phase<EpiS<KIND == 1>, SchedS, false>(F.lds, gm::GP{256, 256, 4, 4}, S, E); }
        PH_END(base + 2); }
    if (PH_ON(base + 3)) { const Frame F = fresh(F0); scan_phase<KIND>(F, p, pair); PH_END(base + 3); }
    if (PH_ON(base + 4)) { const Frame F = fresh(F0);
        SchedO S{(const char*)(ws + OFF_Q), (const char*)(ws + OFF_KVT), (const char*)(ws + OFF_P), (const char*)(ws + OFF_VT), F.G, F.bid};
        EpiO<KIND == 0> E{(bf16_t*)(ws + OFF_Z), (const float*)(ws + OFF_SM + SM_XS), (float*)(ws + OFF_SM + SM_ST), pair};
        gm::gemm_phase<EpiO<KIND == 0>, SchedO, true>(F.lds, gm::GP{256, 256, 4, 8}, S, E);
        PH_END(base + 4); }
    if (PH_ON(base + 5)) { const Frame F = fresh(F0);
        gm::SchedPlain S{H, WIN + (size_t)(4096 + pair * 1024) * 2048, WIN, 64, 4, 4, F.G, F.bid, (size_t)256 * 2048, (size_t)256 * 2048, 2048, 0};
        EpiG<KIND> E{(bf16_t*)(ws + OFF_Z), (float*)(ws + OFF_SM + SM_ST), KIND == 0 ? p.ret_gn : p.ml_gn, (const float*)(ws + OFF_SM + SM_PS), (const float*)(ws + OFF_SM + SM_XS),
                     (const float*)(ws + OFF_SM + SM_DC), (const float*)(ws + OFF_SM + SM_EM), pair};
        gm::gemm_phase<EpiG<KIND>, gm::SchedPlain, false>(F.lds, gm::GP{1024, 1024, 16, 16}, S, E);
        PH_END(base + 5); }
}

template <int KIND> __device__ __forceinline__ void layer_program(const Frame& F0, const Params& p, cg::grid_group& grid, int base) {
    constexpr int layer = KIND;
    unsigned char* ws = p.ws; const float* MOD = (const float*)(ws + OFF_SM + SM_MOD) + layer * 6144;
    const char* H = (const char*)(ws + OFF_H);
    if (PH_ON(base)) { const Frame F = fresh(F0);
        convert_mixer_weights(F, p, layer);
        norm_phase<KIND == 1>(F, p, layer == 0 ? p.x : p.out, p.ntg + layer * 1024, MOD, MOD + 1024);
        PH_END(base); }
    pair_program<KIND, 0>(F0, p, grid, base + 1);
    pair_program<KIND, 1>(F0, p, grid, base + 7);
    int k = base + 13;
    if (KIND == 1) { if (PH_ON(k)) { const Frame F = fresh(F0); gn_pass(F, p); PH_END(k); } ++k; }
    if (PH_ON(k)) { const Frame F = fresh(F0);
        gm::SchedPlain S{(const char*)(ws + OFF_Z), (const char*)(ws + OFF_WOUT), (const char*)(ws + OFF_WOUT), 64, 4, 4, F.G, F.bid, (size_t)256 * 4096, (size_t)256 * 4096, 1024, 0};
        EpiRes E{layer == 0 ? p.x : p.out, p.out, MOD + 2048};
        gm::gemm_phase<EpiRes, gm::SchedPlain, false>(F.lds, gm::GP{2048, 2048, 32, 32}, S, E);
        PH_END(k); }
    ++k;
    if (PH_ON(k)) { const Frame F = fresh(F0); convert_ffn_weights(F, p, layer); norm_phase<false>(F, p, p.out, p.nfg + layer * 1024, MOD + 3072, MOD + 4096); PH_END(k); }
    ++k;
    if (PH_ON(k)) { const Frame F = fresh(F0);
        gm::SchedPlain S{H, (const char*)(ws + OFF_WUP), (const char*)(ws + OFF_WUP), 64, 22, 22, F.G, F.bid, (size_t)256 * 2048, (size_t)256 * 2048, DFF, 0};
        EpiUp E{(bf16_t*)(ws + OFF_ACT), (bf16_t*)(ws + OFF_FH), p.fcw + (size_t)layer * 3 * 5632, p.fcb + (size_t)layer * 5632};
        gm::gemm_phase<EpiUp, gm::SchedPlain, false>(F.lds, gm::GP{1024, 1024, 16, 16}, S, E);
        PH_END(k); }
    ++k;
    if (PH_ON(k)) { const Frame F = fresh(F0); ffn_fix(F, p, layer); PH_END(k); }
    ++k;
    if (PH_ON(k)) { const Frame F = fresh(F0);
        gm::SchedPlain S{(const char*)(ws + OFF_ACT), (const char*)(ws + OFF_WDN), (const char*)(ws + OFF_WDN), 64, 4, 4, F.G, F.bid, (size_t)256 * DFF * 2, (size_t)256 * DFF * 2, 1024, 0};
        EpiRes E{p.out, p.out, MOD + 5120};
        gm::gemm_phase<EpiRes, gm::SchedPlain, false>(F.lds, gm::GP{DFF, DFF, 44, 44}, S, E);
        PH_END(k); }
}

__global__ void __launch_bounds__(512, 2) fwd_kernel(Params p) {
    extern __shared__ __attribute__((aligned(16))) unsigned char smem[];
    Frame F0; F0.lds = (LAS unsigned char*)smem; F0.G = gridDim.x; F0.bid = blockIdx.x; F0.tid = threadIdx.x; F0.wid = 0; F0.lane = 0;
    cg::grid_group grid = cg::this_grid();
    if (PH_ON(0)) { const Frame F = fresh(F0); prologue_phase(F, p); PH_END(0); }
    layer_program<0>(F0, p, grid, 1);
    layer_program<1>(F0, p, grid, 19);
    if (PH_ON(38)) { const Frame F = fresh(F0); final_norm(F, p); }
}

extern "C" void kernel_launch(void* const* d_in, const int* in_sizes, int n_in, void* d_out, int out_size, void* d_ws, size_t ws_size, hipStream_t stream) {
    static int grid_blocks = 0;
    constexpr int LDS_BYTES = gm::STAGE_BYTES;
    if (!grid_blocks) {
        int dev = 0, cus = 0, per_cu = 0;
        (void)hipGetDevice(&dev); (void)hipDeviceGetAttribute(&cus, hipDeviceAttributeMultiprocessorCount, dev);
        (void)hipFuncSetAttribute((const void*)fwd_kernel, hipFuncAttributeMaxDynamicSharedMemorySize, LDS_BYTES);
        (void)hipOccupancyMaxActiveBlocksPerMultiprocessor(&per_cu, (const void*)fwd_kernel, 512, LDS_BYTES);
        if (per_cu < 1) per_cu = 1;
        grid_blocks = cus;
        if (ws_size < WS_END) fprintf(stderr, "kernel_launch: workspace too small: %zu < %zu\n", ws_size, (size_t)WS_END);
        (void)hipGetLastError();
    }
    Params p{};
    p.x = (const float*)d_in[0]; p.c = (const float*)d_in[1]; p.pos = (const int*)d_in[2]; p.ada_w = (const float*)d_in[3]; p.ada_b = (const float*)d_in[4];
    p.ntg = (const float*)d_in[5]; p.nfg = (const float*)d_in[6]; p.ret_w_in = (const float*)d_in[7]; p.ret_gn = (const float*)d_in[8]; p.ret_w_out = (const float*)d_in[9];
    p.ml_w_in = (const float*)d_in[10]; p.ml_bg = (const float*)d_in[11]; p.ml_cw = (const float*)d_in[12]; p.ml_cb = (const float*)d_in[13]; p.ml_gn = (const float*)d_in[14];
    p.ml_w_out = (const float*)d_in[15]; p.up_w = (const float*)d_in[16]; p.fcw = (const float*)d_in[17]; p.fcb = (const float*)d_in[18]; p.dn_w = (const float*)d_in[19];
    p.fin_g = (const float*)d_in[20]; p.out = (float*)d_out; p.ws = (unsigned char*)d_ws;
#if MULTI_LAUNCH
    for (int ph = 0; ph < N_PHASES; ++ph) { p.ph_lo = ph; p.ph_hi = ph + 1; hipLaunchKernelGGL(fwd_kernel, dim3(grid_blocks), dim3(512), LDS_BYTES, stream, p); }
#else
    p.ph_lo = 0; p.ph_hi = N_PHASES;
    void* args[] = {&p};
    hipError_t e = hipLaunchCooperativeKernel((void*)fwd_kernel, dim3(grid_blocks), dim3(512), args, LDS_BYTES, stream);
    if (e != hipSuccess) fprintf(stderr, "cooperative launch failed: %s (grid %d)\n", hipGetErrorString(e), grid_blocks);
#endif
}
```

```cpp
#include <hip/hip_runtime.h>
#include <hip/hip_cooperative_groups.h>
#include <cstdio>
namespace cg = cooperative_groups;

#ifndef MULTI_LAUNCH
#define MULTI_LAUNCH 0
#endif

#define LAS __attribute__((address_space(3)))
typedef unsigned short bf16_t;
typedef short bf16x8 __attribute__((ext_vector_type(8)));
typedef float f32x4 __attribute__((ext_vector_type(4)));
typedef unsigned u32x4 __attribute__((ext_vector_type(4)));
typedef unsigned u32x2 __attribute__((ext_vector_type(2)));

constexpr int S_ = 16384, D_ = 1024, DFF = 2816;
constexpr float EPS = 1e-6f;

constexpr size_t OFF_W = 0;
constexpr size_t OFF_WIN = 0, OFF_WOUT = 12582912, OFF_WUP = 0, OFF_WDN = 11534336;
constexpr size_t OFF_H = 17301504;
constexpr size_t OFF_SM = OFF_H + 33554432;
constexpr size_t SM_MOD = 0;
constexpr size_t SM_IFQ = SM_MOD + 49152;
constexpr size_t SM_RB = SM_IFQ + 512;
constexpr size_t TBL = 262144;
constexpr size_t SM_CB = SM_RB + TBL, SM_XS = SM_CB + TBL, SM_WK = SM_XS + TBL, SM_EM = SM_WK + TBL, SM_GG = SM_EM + TBL, SM_PM = SM_GG + TBL;
constexpr size_t SM_GL = SM_PM + TBL;
constexpr size_t SM_ML = SM_GL + 1024, SM_SCP = SM_ML + 1024, SM_SCN = SM_SCP + 1024;
constexpr size_t SM_LI = SM_SCN + 1024;
constexpr size_t SM_LF = SM_LI + 262144;
constexpr size_t SM_PS = SM_LF + 262144;
constexpr size_t SM_DC = SM_PS + 1048576;
constexpr size_t SM_NLOC = SM_DC + 262144;
constexpr size_t SM_ST = SM_NLOC + 262144;
constexpr size_t SM_QKH = SM_ST + 4194304;
constexpr size_t SM_BAR = SM_QKH + 1572864;
constexpr size_t SM_END = SM_BAR + 16384;
constexpr size_t OFF_BIG = OFF_SM + 10485760;
static_assert(SM_END <= 10485760, "small region");
constexpr size_t OFF_Q = OFF_BIG, OFF_K = OFF_Q + 16777216, OFF_KWT = OFF_K + 16777216, OFF_VT = OFF_KWT + 16777216,
                 OFF_KVT = OFF_VT + 33554432, OFF_P = OFF_KVT + 33554432, OFF_Z = OFF_P + 16777216, WS_END = OFF_Z + 67108864;
constexpr size_t OFF_ACT = OFF_BIG, OFF_FH = OFF_ACT + 92274688;

struct Params {
    const float *x, *c; const int* pos; const float *ada_w, *ada_b, *ntg, *nfg, *ret_w_in, *ret_gn, *ret_w_out,
        *ml_w_in, *ml_bg, *ml_cw, *ml_cb, *ml_gn, *ml_w_out, *up_w, *fcw, *fcb, *dn_w, *fin_g;
    float* out; unsigned char* ws; int ph_lo, ph_hi;
};

__device__ __forceinline__ unsigned cvt_pk_bf16(float lo, float hi) { unsigned r; asm volatile("v_cvt_pk_bf16_f32 %0, %1, %2" : "=v"(r) : "v"(lo), "v"(hi)); return r; }
__device__ __forceinline__ float bf_lo(unsigned w) { return __uint_as_float(w << 16); }
__device__ __forceinline__ float bf_hi(unsigned w) { return __uint_as_float(w & 0xffff0000u); }
__device__ __forceinline__ float siluf(float v) { return v * __builtin_amdgcn_rcpf(1.0f + __expf(-v)); }
__device__ __forceinline__ float sigmf(float v) { return __builtin_amdgcn_rcpf(1.0f + __expf(-v)); }
__device__ __forceinline__ float dpp_shr1(float old, float x) { return __builtin_bit_cast(float, __builtin_amdgcn_update_dpp(__builtin_bit_cast(int, old), __builtin_bit_cast(int, x), 0x111, 0xf, 0xf, false)); }
__device__ __forceinline__ float dpp_shr2(float old, float x) { return __builtin_bit_cast(float, __builtin_amdgcn_update_dpp(__builtin_bit_cast(int, old), __builtin_bit_cast(int, x), 0x112, 0xf, 0xf, false)); }
__device__ __forceinline__ float dpp_ror1(float x) { return __builtin_bit_cast(float, __builtin_amdgcn_update_dpp(0, __builtin_bit_cast(int, x), 0x121, 0xf, 0xf, true)); }
__device__ __forceinline__ float dpp_ror2(float x) { return __builtin_bit_cast(float, __builtin_amdgcn_update_dpp(0, __builtin_bit_cast(int, x), 0x122, 0xf, 0xf, true)); }
__device__ __forceinline__ float dpp_mirror(float x) { return __builtin_bit_cast(float, __builtin_amdgcn_update_dpp(0, __builtin_bit_cast(int, x), 0x140, 0xf, 0xf, true)); }
__device__ __forceinline__ float dpp_swap01(float x) { return __builtin_bit_cast(float, __builtin_amdgcn_update_dpp(0, __builtin_bit_cast(int, x), 0xB1, 0xf, 0xf, true)); }
__device__ __forceinline__ float wave_sum(float v) { for (int o = 32; o >= 1; o >>= 1) v += __shfl_xor(v, o); return v; }
__device__ __forceinline__ u32x4 pack8(const f32x4 a, const f32x4 b) { u32x4 w; w.x = cvt_pk_bf16(a[0], a[1]); w.y = cvt_pk_bf16(a[2], a[3]); w.z = cvt_pk_bf16(b[0], b[1]); w.w = cvt_pk_bf16(b[2], b[3]); return w; }
__device__ __forceinline__ void unpack8(const u32x4 w, float (&f)[8]) { f[0] = bf_lo(w.x); f[1] = bf_hi(w.x); f[2] = bf_lo(w.y); f[3] = bf_hi(w.y); f[4] = bf_lo(w.z); f[5] = bf_hi(w.z); f[6] = bf_lo(w.w); f[7] = bf_hi(w.w); }

namespace gm {
constexpr int BM = 256, BK = 64, HALF = 128, HTB = HALF * BK * 2, STAGE_BYTES = 8 * HTB, NXCD = 8, WGM = 8;
__device__ __forceinline__ int lds_byte(int r, int c) { const int st = (r >> 4) * 2 + (c >> 5), rr = r & 15, cc = c & 31, ob = rr * 64 + cc * 2; return st * 1024 + (ob ^ (((ob >> 9) & 1) << 5)); }
__device__ __forceinline__ void stage_rc(int b, int& R, int& C) { const int st = b / 1024, sb = b % 1024, swz = sb ^ (((sb >> 9) & 1) << 5); R = (st >> 1) * 16 + swz / 64; C = (st & 1) * 32 + (swz % 64) / 2; }
__device__ __forceinline__ int perm32(int rho) { const int n = rho >> 4, i = rho & 15; return 8 * (i >> 2) + 4 * n + (i & 3); }

struct U { const char *a1, *b1, *a2, *b2; long co; int i0, i1, i2, i3; };
struct GP { int lda, ldb, n1, nt; };

struct SchedPlain {
    const char* A; const char* B; const char* B2; int nM, nN, nsplit, G, c; size_t ta, tb; long ldc; int vt;
    __device__ __forceinline__ bool next(int i, U& u) const { return at((long)i * G + c, u); }
    __device__ __forceinline__ bool at(long L, U& u) const {
        const int nwg = nM * nN; if (L >= nwg) return false;
        int wgid = (int)L; { const int q = nwg / NXCD, r = nwg % NXCD, xcd = wgid % NXCD, off = wgid / NXCD; wgid = (xcd < r ? xcd * (q + 1) : r * (q + 1) + (xcd - r) * q) + off; }
        const int nig = WGM * nN, gid = wgid / nig, fm = gid * WGM, gsz = (nM - fm) < WGM ? (nM - fm) : WGM;
        const int pm = fm + ((wgid % nig) % gsz), pn = (wgid % nig) / gsz;
        u.a1 = A + (size_t)pm * ta; u.b1 = pn < nsplit ? B + (size_t)pn * tb : B2 + (size_t)(pn - nsplit) * tb; u.a2 = u.a1; u.b2 = u.b1;
        u.co = vt ? ((long)((pm >> 1) * 64 + pn) * 512 + (pm & 1) * 256) * 256 : (long)pm * 256 * ldc + (long)pn * 256; u.i0 = pm; u.i1 = pn; u.i2 = 0; u.i3 = 0; return true;
    }
};

struct SchedMulti {
    SchedPlain s0, s1, s2; int n0, n1, n2, G, c;
    __device__ __forceinline__ bool next(int i, U& u) const {
        const long L = (long)i * G + c; bool ok; int w;
        if (L < n0) { ok = s0.at(L, u); w = 0; } else if (L < n0 + n1) { ok = s1.at(L - n0, u); w = 1; } else if (L < n0 + n1 + n2) { ok = s2.at(L - n0 - n1, u); w = 2; } else return false;
        u.i3 = w; return ok;
    }
};

template <class Epi, class Sched, bool TWOSEG>
__device__ __forceinline__ void gemm_phase(LAS unsigned char* lds, const GP g, const Sched& S, const Epi& E) {
    int tid = threadIdx.x; asm volatile("" : "+v"(tid));
    const int wid = __builtin_amdgcn_readfirstlane(tid >> 6), lane = tid & 63, wr = wid >> 2, wc = wid & 3, fr = lane & 15, fq = lane >> 4;
    const int nt = g.nt;
    unsigned voffA[2], voffB[2];
#pragma unroll
    for (int i = 0; i < 2; ++i) { int R, C; stage_rc(tid * 16 + i * 8192, R, C); const int Rb = Epi::PERM ? ((R & ~31) + perm32(R & 31)) : R;
        voffA[i] = (unsigned)(R * g.lda + C) * 2u; voffB[i] = (unsigned)(Rb * g.ldb + C) * 2u; }
    const size_t hsA1 = (size_t)HALF * g.lda * 2, hsB1 = (size_t)HALF * g.ldb * 2;
    const unsigned ldsw = (unsigned)wid * 1024u;
    const int aoff = lds_byte(wr * 64 + fr, fq * 8), boff = lds_byte(wc * 32 + fr, fq * 8);
#define G_SA(b, h) (((b) * 2 + (h)) * HTB)
#define G_SB(b, h) ((4 + (b) * 2 + (h)) * HTB)
#define G_STAGE(bufoff, gbase, voff) do { _Pragma("unroll") for (int _i = 0; _i < 2; ++_i) \
        __builtin_amdgcn_global_load_lds((const unsigned*)((const char*)(gbase) + (voff)[_i]), (LAS unsigned*)(lds + (bufoff) + ldsw + _i * 8192), 16, 0, 0); } while (0)
#define G_LDA(dst, b, h) do { _Pragma("unroll") for (int m = 0; m < 4; ++m) _Pragma("unroll") for (int k = 0; k < 2; ++k) dst[m][k] = *(const LAS bf16x8*)(lds + G_SA(b, h) + aoff + m * 2048 + k * 1024); } while (0)
#define G_LDB(dst, b, h) do { _Pragma("unroll") for (int n = 0; n < 2; ++n) _Pragma("unroll") for (int k = 0; k < 2; ++k) dst[n][k] = *(const LAS bf16x8*)(lds + G_SB(b, h) + boff + n * 2048 + k * 1024); } while (0)
#define G_MMA(ai, bj, At, Bt) do { __builtin_amdgcn_s_setprio(1); _Pragma("unroll") for (int m = 0; m < 4; ++m) _Pragma("unroll") for (int n = 0; n < 2; ++n) _Pragma("unroll") for (int k = 0; k < 2; ++k) \
        acc[ai][bj][m][n] = __builtin_amdgcn_mfma_f32_16x16x32_bf16(Bt[n][k], At[m][k], acc[ai][bj][m][n], 0, 0, 0); __builtin_amdgcn_s_setprio(0); } while (0)
#define G_WAIT_V(n) asm volatile("s_waitcnt vmcnt(" #n ")" ::: "memory")
#define G_WAIT_L(n) asm volatile("s_waitcnt lgkmcnt(" #n ")" ::: "memory")
#define G_BAR __builtin_amdgcn_s_barrier()
#define G_SCHED __builtin_amdgcn_sched_barrier(0)
    U cur, nxt; int ui = 0;
    if (!S.next(0, cur)) return;
    f32x4 acc[2][2][4][2];
#pragma unroll
    for (int a = 0; a < 2; ++a)
#pragma unroll
        for (int b = 0; b < 2; ++b)
#pragma unroll
            for (int m = 0; m < 4; ++m)
#pragma unroll
                for (int n = 0; n < 2; ++n) acc[a][b][m][n] = (f32x4){0.f, 0.f, 0.f, 0.f};
    bf16x8 At[4][2], B0[2][2], B1[2][2];
    G_STAGE(G_SB(0, 0), cur.b1, voffB); G_STAGE(G_SA(0, 0), cur.a1, voffA); G_STAGE(G_SB(0, 1), cur.b1 + hsB1, voffB); G_STAGE(G_SA(0, 1), cur.a1 + hsA1, voffA);
    if (wr == 1) G_BAR;
    G_WAIT_V(4); G_BAR;
    G_STAGE(G_SB(1, 0), cur.b1 + 128, voffB); G_STAGE(G_SA(1, 0), cur.a1 + 128, voffA); G_STAGE(G_SB(1, 1), cur.b1 + hsB1 + 128, voffB);
    G_WAIT_V(6); G_BAR;
    for (;;) {
        const bool has_next = S.next(ui + 1, nxt);
        const char* nA = has_next ? nxt.a1 : cur.a1; const char* nB = has_next ? nxt.b1 : cur.b1;
        for (int t = 0; t < nt; t += 2) {
            const bool last = (t == nt - 2);
            const bool sg1 = TWOSEG && (t >= g.n1);
            const bool sg2 = TWOSEG && !last && (t + 2 >= g.n1);
            const char* a1 = sg1 ? cur.a2 + (size_t)(t + 1 - g.n1) * 128 : cur.a1 + (size_t)(t + 1) * 128;
            const char* a2 = last ? nA : (sg2 ? cur.a2 + (size_t)(t + 2 - g.n1) * 128 : cur.a1 + (size_t)(t + 2) * 128);
            const char* b2 = last ? nB : (sg2 ? cur.b2 + (size_t)(t + 2 - g.n1) * 128 : cur.b1 + (size_t)(t + 2) * 128);
            const char* a3 = a2 + 128; const char* b3 = b2 + 128;
            if (TWOSEG) { if (t == g.n1) E.mid(acc, cur, wr, wc, fr, fq); }
            G_LDB(B0, 0, 0); G_SCHED; G_LDA(At, 0, 0); G_STAGE(G_SA(1, 1), a1 + hsA1, voffA);
            G_WAIT_L(8); G_BAR; G_WAIT_L(0); G_MMA(0, 0, At, B0); G_BAR; G_SCHED;
            G_LDB(B1, 0, 1); G_STAGE(G_SB(0, 0), b2, voffB);
            G_BAR; G_WAIT_L(0); G_MMA(0, 1, At, B1); G_BAR;
            G_LDA(At, 0, 1); G_STAGE(G_SA(0, 0), a2, voffA);
            G_BAR; G_WAIT_L(0); G_MMA(1, 0, At, B0); G_BAR; G_SCHED;
            G_STAGE(G_SB(0, 1), b2 + hsB1, voffB);
            G_WAIT_V(6); G_BAR; G_MMA(1, 1, At, B1); G_BAR;
            G_LDB(B0, 1, 0); G_SCHED; G_LDA(At, 1, 0); G_STAGE(G_SA(0, 1), a2 + hsA1, voffA);
            G_WAIT_L(8); G_BAR; G_WAIT_L(0); G_MMA(0, 0, At, B0); G_BAR; G_SCHED;
            G_LDB(B1, 1, 1); G_STAGE(G_SB(1, 0), b3, voffB);
            G_BAR; G_WAIT_L(0); G_MMA(0, 1, At, B1); G_BAR;
            G_LDA(At, 1, 1); G_STAGE(G_SA(1, 0), a3, voffA);
            G_BAR; G_WAIT_L(0); G_MMA(1, 0, At, B0); G_BAR; G_SCHED;
            G_STAGE(G_SB(1, 1), b3 + hsB1, voffB);
            G_WAIT_V(6); G_BAR; G_MMA(1, 1, At, B1); G_BAR;
        }
        E(acc, cur, wr, wc, fr, fq);
        if (!has_next) break;
#pragma unroll
        for (int a = 0; a < 2; ++a)
#pragma unroll
            for (int b = 0; b < 2; ++b)
#pragma unroll
                for (int m = 0; m < 4; ++m)
#pragma unroll
                    for (int n = 0; n < 2; ++n) acc[a][b][m][n] = (f32x4){0.f, 0.f, 0.f, 0.f};
        cur = nxt; ++ui;
    }
    G_WAIT_V(0);
    if (wr == 0) G_BAR;
    G_BAR;
#undef G_SA
#undef G_SB
#undef G_STAGE
#undef G_LDA
#undef G_LDB
#undef G_MMA
#undef G_WAIT_V
#undef G_WAIT_L
#undef G_BAR
#undef G_SCHED
}
}

typedef f32x4 Acc[2][2][4][2];

struct EpiPlain {
    static constexpr bool PERM = true; bf16_t* base; long ldc;
    __device__ __forceinline__ void mid(Acc&, const gm::U&, int, int, int, int) const {}
    __device__ __forceinline__ void operator()(const Acc& acc, const gm::U& u, int wr, int wc, int fr_, int fq_) const {
        int fr = fr_, fq = fq_; asm volatile("" : "+v"(fr), "+v"(fq));
        bf16_t* d = base + u.co + (long)(wr * 64 + fr) * ldc + wc * 32 + 8 * fq;
#pragma unroll
        for (int ai = 0; ai < 2; ++ai)
#pragma unroll
            for (int m = 0; m < 4; ++m)
#pragma unroll
                for (int bj = 0; bj < 2; ++bj) *(u32x4*)(d + (long)(ai * 128 + m * 16) * ldc + bj * 128) = pack8(acc[ai][bj][m][0], acc[ai][bj][m][1]);
    }
};

template <int KIND> struct EpiQK {
    static constexpr bool PERM = true; bf16_t* Q; bf16_t* K; const int* pos; const float* ifq; bf16_t* qkh; bf16_t* kwt; const float* wkt; int pair;
    __device__ __forceinline__ void mid(Acc&, const gm::U&, int, int, int, int) const {}
    __device__ __forceinline__ void operator()(const Acc& acc, const gm::U& u, int wr, int wc, int fr_, int fq_) const {
        int fr = fr_, fq = fq_; asm volatile("" : "+v"(fr), "+v"(fq));
        const int pm = u.i0, pn = u.i1, d0 = wc * 32 + 8 * fq;
        bf16_t* dst = (pn < 2 ? Q : K) + (size_t)(pn & 1) * S_ * 256 + d0;
        if (KIND == 0) {
            const float sc = pn < 2 ? 1.0f : 0.0625f;
            const f32x4 f0 = *(const f32x4*)(ifq + d0), f1 = *(const f32x4*)(ifq + d0 + 4);
#pragma unroll
            for (int ai = 0; ai < 2; ++ai)
#pragma unroll
                for (int m = 0; m < 4; ++m) {
                    const int t = pm * 256 + ai * 128 + wr * 64 + m * 16 + fr; const float pf = (float)pos[t];
                    f32x4 o1[2], o2[2];
#pragma unroll
                    for (int n = 0; n < 2; ++n)
#pragma unroll
                        for (int e = 0; e < 4; ++e) {
                            const float ang = pf * (n ? f1[e] : f0[e]);
                            const double rev = (double)ang * 0.15915494309189535; const float fx = (float)(rev - __builtin_rint(rev));
                            const float sn = __builtin_amdgcn_sinf(fx), cs = __builtin_amdgcn_cosf(fx);
                            const float t1 = acc[ai][0][m][n][e], t2 = acc[ai][1][m][n][e];
                            o1[n][e] = (t1 * cs - t2 * sn) * sc; o2[n][e] = (t1 * sn + t2 * cs) * sc; }
                    *(u32x4*)(dst + (size_t)t * 256) = pack8(o1[0], o1[1]); *(u32x4*)(dst + (size_t)t * 256 + 128) = pack8(o2[0], o2[1]);
                    if (pn >= 2) {
                        const int h2 = pn & 1, tl = ai * 128 + wr * 64 + m * 16 + fr; const float wk = wkt[(size_t)(2 * pair + h2) * S_ + t];
                        bf16_t* kp = kwt + ((size_t)(h2 * 64 + pm) * 256 + d0) * 256 + tl;
#pragma unroll
                        for (int n = 0; n < 2; ++n)
#pragma unroll
                            for (int e = 0; e < 4; e += 2) { const unsigned w1 = cvt_pk_bf16(o1[n][e] * wk, o1[n][e + 1] * wk), w2 = cvt_pk_bf16(o2[n][e] * wk, o2[n][e + 1] * wk);
                                kp[(size_t)(4 * n + e) * 256] = (bf16_t)(w1 & 0xffffu); kp[(size_t)(4 * n + e + 1) * 256] = (bf16_t)(w1 >> 16);
                                kp[(size_t)(128 + 4 * n + e) * 256] = (bf16_t)(w2 & 0xffffu); kp[(size_t)(128 + 4 * n + e + 1) * 256] = (bf16_t)(w2 >> 16); } } }
        } else {
#pragma unroll
            for (int ai = 0; ai < 2; ++ai)
#pragma unroll
                for (int m = 0; m < 4; ++m) {
                    const int t = pm * 256 + ai * 128 + wr * 64 + m * 16 + fr;
#pragma unroll
                    for (int bj = 0; bj < 2; ++bj) { const u32x4 w = pack8(acc[ai][bj][m][0], acc[ai][bj][m][1]);
                        *(u32x4*)(dst + (size_t)t * 256 + bj * 128) = w;
                        if (m == 3 && fr >= 13) { const int gq = pm * 4 + ai * 2 + wr; *(u32x4*)(qkh + ((size_t)gq * 3 + (fr - 13)) * 1024 + pn * 256 + bj * 128 + d0) = w; } } }
        }
    }
};

template <bool PSUM> struct EpiS {
    static constexpr bool PERM = true; bf16_t* P; const float* RB; const float* CB; float* PS; int pair;
    __device__ __forceinline__ void mid(Acc&, const gm::U&, int, int, int, int) const {}
    __device__ __forceinline__ void operator()(const Acc& acc, const gm::U& u, int wr, int wc, int fr_, int fq_) const {
        int fr = fr_, fq = fq_; asm volatile("" : "+v"(fr), "+v"(fq));
        const int ch = u.i0, h2 = u.i1, h = 2 * pair + h2, c0 = wc * 32 + 8 * fq;
        const float* rb = RB + (size_t)h * S_ + ch * 256 + wr * 64 + fr; const float* cb = CB + (size_t)h * S_ + ch * 256 + c0;
        bf16_t* d = P + ((size_t)(h2 * 64 + ch) * 256 + wr * 64 + fr) * 256 + c0;
        float rbv[2][4], rs[2][4];
#pragma unroll
        for (int ai = 0; ai < 2; ++ai)
#pragma unroll
            for (int m = 0; m < 4; ++m) { rbv[ai][m] = rb[ai * 128 + m * 16]; rs[ai][m] = 0.f; }
#pragma unroll
        for (int bj = 0; bj < 2; ++bj)
#pragma unroll
            for (int n = 0; n < 2; ++n) {
                const f32x4 cbv = *(const f32x4*)(cb + bj * 128 + 4 * n);
#pragma unroll
                for (int ai = 0; ai < 2; ++ai)
#pragma unroll
                    for (int m = 0; m < 4; ++m) {
                        const int dij = (ai * 128 + wr * 64 + m * 16 + fr) - (bj * 128 + c0 + 4 * n);
                        f32x4 v;
#pragma unroll
                        for (int e = 0; e < 4; ++e) { const float w = (dij - e >= 0) ? acc[ai][bj][m][n][e] * __builtin_amdgcn_exp2f((rbv[ai][m] + cbv[e]) * 1.44269504f) : 0.f; v[e] = w; rs[ai][m] += w; }
                        u32x2 pk; pk.x = cvt_pk_bf16(v[0], v[1]); pk.y = cvt_pk_bf16(v[2], v[3]);
                        *(u32x2*)(d + (size_t)(ai * 128 + m * 16) * 256 + bj * 128 + 4 * n) = pk; }
            }
        if (PSUM) {
#pragma unroll
            for (int ai = 0; ai < 2; ++ai)
#pragma unroll
                for (int m = 0; m < 4; ++m) { float r = rs[ai][m]; r += __shfl_xor(r, 16); r += __shfl_xor(r, 32);
                    if (fq == 0) PS[((size_t)(ch * 256 + ai * 128 + wr * 64 + m * 16 + fr) * 4 + h) * 4 + wc] = r; } }
    }
};

template <bool STATS> struct EpiO {
    static constexpr bool PERM = true; bf16_t* Z; const float* XS; float* ST; int pair;
    __device__ __forceinline__ void mid(Acc& acc, const gm::U& u, int wr, int wc, int fr, int fq) const {
        const int ch = u.i0, h = 2 * pair + u.i1; const float* xs = XS + (size_t)h * S_ + ch * 256 + wr * 64 + fr;
#pragma unroll
        for (int ai = 0; ai < 2; ++ai)
#pragma unroll
            for (int m = 0; m < 4; ++m) { const float x = xs[ai * 128 + m * 16];
#pragma unroll
                for (int bj = 0; bj < 2; ++bj)
#pragma unroll
                    for (int n = 0; n < 2; ++n) acc[ai][bj][m][n] *= x; }
    }
    __device__ __forceinline__ void operator()(const Acc& acc, const gm::U& u, int wr, int wc, int fr_, int fq_) const {
        int fr = fr_, fq = fq_; asm volatile("" : "+v"(fr), "+v"(fq));
        const int ch = u.i0, h = 2 * pair + u.i1, nt2 = u.i2, c0 = wc * 32 + 8 * fq;
        bf16_t* d = Z + (size_t)(ch * 256) * 2048 + h * 512 + nt2 * 256 + c0;
#pragma unroll
        for (int ai = 0; ai < 2; ++ai)
#pragma unroll
            for (int m = 0; m < 4; ++m) {
                const int i = ai * 128 + wr * 64 + m * 16 + fr; float s = 0.f, q = 0.f;
#pragma unroll
                for (int bj = 0; bj < 2; ++bj) { *(u32x4*)(d + (size_t)i * 2048 + bj * 128) = pack8(acc[ai][bj][m][0], acc[ai][bj][m][1]);
                    if (STATS) {
#pragma unroll
                        for (int n = 0; n < 2; ++n)
#pragma unroll
                            for (int e = 0; e < 4; ++e) { const float v = acc[ai][bj][m][n][e]; s += v; q += v * v; } } }
                if (STATS) { s += __shfl_xor(s, 16); s += __shfl_xor(s, 32); q += __shfl_xor(q, 16); q += __shfl_xor(q, 32);
                    if (fq == 0) { float* st = ST + (((size_t)(ch * 256 + i) * 4 + h) * 8 + nt2 * 4 + wc) * 2; st[0] = s; st[1] = q; } } }
    }
};

template <int KIND> struct EpiG {
    static constexpr bool PERM = true; bf16_t* Z; float* ST; const float* gng; const float* PS; const float* XS; const float* DC; const float* EM; int pair;
    __device__ __forceinline__ void mid(Acc&, const gm::U&, int, int, int, int) const {}
    __device__ __forceinline__ void operator()(const Acc& acc, const gm::U& u, int wr, int wc, int fr_, int fq_) const {
        int fr = fr_, fq = fq_; asm volatile("" : "+v"(fr), "+v"(fq));
        const int pm = u.i0, pn = u.i1, h = 2 * pair + (pn >> 1), nt2 = pn & 1, c0 = wc * 32 + 8 * fq;
        const int colb = pair * 1024 + pn * 256 + c0;
        f32x4 gv[2][2];
        if (KIND == 0) {
#pragma unroll
            for (int bj = 0; bj < 2; ++bj)
#pragma unroll
                for (int n = 0; n < 2; ++n) gv[bj][n] = *(const f32x4*)(gng + colb + bj * 128 + 4 * n);
        }
#pragma unroll
        for (int ai = 0; ai < 2; ++ai)
#pragma unroll
            for (int m = 0; m < 4; ++m) {
                const int t = pm * 256 + ai * 128 + wr * 64 + m * 16 + fr;
                bf16_t* zp = Z + (size_t)t * 2048 + colb;
                if (KIND == 0) {
                    const f32x4* st = (const f32x4*)(ST + ((size_t)t * 4 + h) * 16);
                    const f32x4 a = st[0], b = st[1], c = st[2], d = st[3];
                    const float s = (a[0] + a[2]) + (b[0] + b[2]) + (c[0] + c[2]) + (d[0] + d[2]);
                    const float q = (a[1] + a[3]) + (b[1] + b[3]) + (c[1] + c[3]) + (d[1] + d[3]);
                    const float mu = s * (1.0f / 512.0f); const float var = fmaxf(q * (1.0f / 512.0f) - mu * mu, 0.f); const float rstd = rsqrtf(var + EPS);
#pragma unroll
                    for (int bj = 0; bj < 2; ++bj) { float y[8]; unpack8(*(const u32x4*)(zp + bj * 128), y); f32x4 o[2];
#pragma unroll
                        for (int n = 0; n < 2; ++n)
#pragma unroll
                            for (int e = 0; e < 4; ++e) o[n][e] = siluf(acc[ai][bj][m][n][e]) * (y[4 * n + e] - mu) * rstd * gv[bj][n][e];
                        *(u32x4*)(zp + bj * 128) = pack8(o[0], o[1]); }
                } else {
                    const f32x4 ps = *(const f32x4*)(PS + ((size_t)t * 4 + h) * 4);
                    const float den = (ps[0] + ps[1]) + (ps[2] + ps[3]) + XS[(size_t)h * S_ + t] * DC[(size_t)t * 4 + h];
                    const float inv = __builtin_amdgcn_rcpf(fmaxf(fabsf(den), EM[(size_t)h * S_ + t]));
                    float s = 0.f, q = 0.f;
#pragma unroll
                    for (int bj = 0; bj < 2; ++bj) { float y[8]; unpack8(*(const u32x4*)(zp + bj * 128), y); f32x4 o[2];
#pragma unroll
                        for (int n = 0; n < 2; ++n)
#pragma unroll
                            for (int e = 0; e < 4; ++e) { const float v = sigmf(acc[ai][bj][m][n][e]) * y[4 * n + e] * inv; o[n][e] = v; s += v; q += v * v; }
                        *(u32x4*)(zp + bj * 128) = pack8(o[0], o[1]); }
                    s += __shfl_xor(s, 16); s += __shfl_xor(s, 32); q += __shfl_xor(q, 16); q += __shfl_xor(q, 32);
                    if (fq == 0) { float* st = ST + (((size_t)t * 4 + h) * 8 + nt2 * 4 + wc) * 2; st[0] = s; st[1] = q; }
                }
            }
    }
};

struct EpiRes {
    static constexpr bool PERM = false; const float* base; float* out; const float* gate;
    __device__ __forceinline__ void mid(Acc&, const gm::U&, int, int, int, int) const {}
    __device__ __forceinline__ void operator()(const Acc& acc, const gm::U& u, int wr, int wc, int fr_, int fq_) const {
        int fr = fr_, fq = fq_; asm volatile("" : "+v"(fr), "+v"(fq));
        const int row0 = u.i0 * 256 + wr * 64 + fr, col0 = u.i1 * 256 + wc * 32 + 4 * fq;
        f32x4 gv[2][2];
#pragma unroll
        for (int bj = 0; bj < 2; ++bj)
#pragma unroll
            for (int n = 0; n < 2; ++n) gv[bj][n] = *(const f32x4*)(gate + col0 + bj * 128 + n * 16);
#pragma unroll
        for (int ai = 0; ai < 2; ++ai)
#pragma unroll
            for (int m = 0; m < 4; ++m) { const size_t ro = (size_t)(row0 + ai * 128 + m * 16) * 1024 + col0;
#pragma unroll
                for (int bj = 0; bj < 2; ++bj)
#pragma unroll
                    for (int n = 0; n < 2; ++n) { const size_t o = ro + bj * 128 + n * 16; const f32x4 b = *(const f32x4*)(base + o); *(f32x4*)(out + o) = b + gv[bj][n] * acc[ai][bj][m][n]; } }
    }
};

struct EpiUp {
    static constexpr bool PERM = true; bf16_t* act; bf16_t* fh; const float* cw; const float* cb;
    __device__ __forceinline__ void mid(Acc&, const gm::U&, int, int, int, int) const {}
    __device__ __forceinline__ void operator()(const Acc& acc, const gm::U& u, int wr, int wc, int fr_, int fq_) const {
        int fr = fr_, fq = fq_; asm volatile("" : "+v"(fr), "+v"(fq));
        const int pm = u.i0, pn = u.i1, c0 = wc * 32 + 8 * fq, lane = fq * 16 + fr;
        u32x2 pk0[2][4];
#pragma unroll
        for (int n = 0; n < 2; ++n) {
            f32x4 w0[2], w1[2], w2[2], bb[2];
#pragma unroll
            for (int bj = 0; bj < 2; ++bj) { const int chn = bj * DFF + pn * 128 + c0 + 4 * n;
                w0[bj] = *(const f32x4*)(cw + chn); w1[bj] = *(const f32x4*)(cw + 2 * DFF + chn); w2[bj] = *(const f32x4*)(cw + 4 * DFF + chn); bb[bj] = *(const f32x4*)(cb + chn); }
#pragma unroll
            for (int ai = 0; ai < 2; ++ai)
#pragma unroll
                for (int m = 0; m < 4; ++m) {
                    f32x4 uu[2];
#pragma unroll
                    for (int bj = 0; bj < 2; ++bj)
#pragma unroll
                        for (int e = 0; e < 4; ++e) {
                            const float cur = acc[ai][bj][m][n][e]; const float prv = acc[ai][bj][m > 0 ? m - 1 : 0][n][e];
                            const float mr = dpp_mirror(prv), mr2 = dpp_swap01(mr);
                            const float p1 = dpp_shr1(mr, cur), p2 = dpp_shr2(mr2, cur);
                            uu[bj][e] = bb[bj][e] + w0[bj][e] * p2 + w1[bj][e] * p1 + w2[bj][e] * cur; }
                    u32x2 pk; pk.x = cvt_pk_bf16(siluf(uu[0][0]) * uu[1][0], siluf(uu[0][1]) * uu[1][1]); pk.y = cvt_pk_bf16(siluf(uu[0][2]) * uu[1][2], siluf(uu[0][3]) * uu[1][3]);
                    if (n == 0) pk0[ai][m] = pk;
                    else { const int t = pm * 256 + ai * 128 + wr * 64 + m * 16 + fr; u32x4 w; w.x = pk0[ai][m].x; w.y = pk0[ai][m].y; w.z = pk.x; w.w = pk.y;
                        *(u32x4*)(act + (size_t)t * DFF + pn * 128 + c0) = w; }
                }
        }
#pragma unroll
        for (int ai = 0; ai < 2; ++ai) {
            const int gq = pm * 4 + ai * 2 + wr;
            if (fr >= 14) {
#pragma unroll
                for (int bj = 0; bj < 2; ++bj) *(u32x4*)(fh + ((size_t)gq * 4 + (fr - 14)) * (2 * DFF) + pn * 256 + bj * 128 + c0) = pack8(acc[ai][bj][3][0], acc[ai][bj][3][1]);
            }
            if (fr < 2) {
#pragma unroll
                for (int bj = 0; bj < 2; ++bj) *(u32x4*)(fh + ((size_t)gq * 4 + 2 + fr) * (2 * DFF) + pn * 256 + bj * 128 + c0) = pack8(acc[ai][bj][0][0], acc[ai][bj][0][1]);
            }
        }
    }
};

template <class E0, class E1, class E2> struct EpiMulti {
    static constexpr bool PERM = true; E0 e0; E1 e1; E2 e2;
    static_assert(E0::PERM && E1::PERM && E2::PERM, "mixed staging orders");
    __device__ __forceinline__ void mid(Acc&, const gm::U&, int, int, int, int) const {}
    __device__ __forceinline__ void operator()(const Acc& acc, const gm::U& u, int wr, int wc, int fr, int fq) const {
        if (u.i3 == 0) e0(acc, u, wr, wc, fr, fq); else if (u.i3 == 1) e1(acc, u, wr, wc, fr, fq); else e2(acc, u, wr, wc, fr, fq);
    }
};

struct SchedS { const char* Q; const char* K; int G, c;
    __device__ __forceinline__ bool next(int i, gm::U& u) const { const int L = i * G + c; if (L >= 128) return false; const int h2 = L & 1, ch = L >> 1;
        const size_t o = ((size_t)h2 * S_ + ch * 256) * 256 * 2; u.a1 = Q + o; u.b1 = K + o; u.a2 = u.a1; u.b2 = u.b1; u.co = 0; u.i0 = ch; u.i1 = h2; u.i2 = 0; u.i3 = 0; return true; } };
struct SchedKV { const char* VT; const char* KWT; int G, c;
    __device__ __forceinline__ bool next(int i, gm::U& u) const { const int L = i * G + c; if (L >= 256) return false; const int mt = L & 1, h2 = (L >> 1) & 1, ch = L >> 2;
        u.a1 = VT + ((size_t)(h2 * 64 + ch) * 512 + mt * 256) * 256 * 2; u.b1 = KWT + ((size_t)(h2 * 64 + ch) * 256) * 256 * 2; u.a2 = u.a1; u.b2 = u.b1;
        u.co = ((long)(h2 * 64 + ch) * 512 + mt * 256) * 256; u.i0 = ch; u.i1 = h2; u.i2 = mt; u.i3 = 0; return true; } };
struct SchedO { const char* Q; const char* KVT; const char* P; const char* VT; int G, c;
    __device__ __forceinline__ bool next(int i, gm::U& u) const { const int L = i * G + c; if (L >= 256) return false; const int nt2 = L & 1, h2 = (L >> 1) & 1, ch = L >> 2;
        u.a1 = Q + ((size_t)h2 * S_ + ch * 256) * 256 * 2; u.b1 = KVT + ((size_t)(h2 * 64 + ch) * 512 + nt2 * 256) * 256 * 2;
        u.a2 = P + ((size_t)(h2 * 64 + ch) * 65536) * 2; u.b2 = VT + ((size_t)(h2 * 64 + ch) * 512 + nt2 * 256) * 256 * 2;
        u.co = 0; u.i0 = ch; u.i1 = h2; u.i2 = nt2; u.i3 = 0; return true; } };

struct Frame { LAS unsigned char* lds; int G, bid, tid, wid, lane; };
__device__ __forceinline__ Frame fresh(const Frame& f) { Frame r = f; asm volatile("" : "+v"(r.tid)); r.lane = r.tid & 63; r.wid = __builtin_amdgcn_readfirstlane(r.tid >> 6); return r; }

struct TileD { const float* src; bf16_t* dst; int lds_, ldd; };
struct MixerTiles { const float* win; const float* wout; bf16_t* WIN; bf16_t* WOUT; int ldin;
    __device__ __forceinline__ TileD operator()(int u) const {
        if (u < 1536) { const int kt = u & 15, ct = u >> 4; return TileD{win + (size_t)kt * 64 * ldin + ct * 64, WIN + (size_t)ct * 64 * 1024 + kt * 64, ldin, 1024}; }
        const int v = u - 1536, kt = v & 31, ct = v >> 5; return TileD{wout + (size_t)kt * 64 * 1024 + ct * 64, WOUT + (size_t)ct * 64 * 2048 + kt * 64, 1024, 2048}; } };
struct FfnTiles { const float* wup; const float* wdn; bf16_t* WUP; bf16_t* WDN;
    __device__ __forceinline__ TileD operator()(int u) const {
        if (u < 1408) { const int kt = u & 15, ct = u >> 4, c0 = ct * 64;
            const int cc = c0 < DFF ? c0 : c0 - DFF; const int r0 = (cc >> 7) * 256 + (c0 < DFF ? 0 : 128) + (cc & 127);
            return TileD{wup + (size_t)kt * 64 * 5632 + c0, WUP + (size_t)r0 * 1024 + kt * 64, 5632, 1024}; }
        const int v = u - 1408, kt = v % 44, ct = v / 44; return TileD{wdn + (size_t)kt * 64 * 1024 + ct * 64, WDN + (size_t)ct * 64 * DFF + kt * 64, 1024, DFF}; } };
template <class TD> __device__ __forceinline__ void convert_tiles(const Frame& F, int ntiles, const TD& td) {
    LAS float* tile = (LAS float*)F.lds;
    const int tx = F.tid & 63, ty = F.tid >> 6, n = F.tid >> 3, kk = (F.tid & 7) * 8;
    for (int u0 = F.bid; u0 < ntiles; u0 += 4 * F.G) {
        float v[4][8];
#pragma unroll
        for (int j = 0; j < 4; ++j) { const int u = u0 + j * F.G; if (u < ntiles) { const TileD d = td(u);
#pragma unroll
                for (int i = 0; i < 8; ++i) v[j][i] = d.src[(size_t)(ty + 8 * i) * d.lds_ + tx]; } }
#pragma unroll
        for (int j = 0; j < 4; ++j) { if (u0 + j * F.G < ntiles) {
#pragma unroll
                for (int i = 0; i < 8; ++i) tile[j * 4160 + (ty + 8 * i) * 65 + tx] = v[j][i]; } }
        __syncthreads();
#pragma unroll
        for (int j = 0; j < 4; ++j) { const int u = u0 + j * F.G; if (u < ntiles) { const TileD d = td(u); const LAS float* t = tile + j * 4160;
                u32x4 w; w.x = cvt_pk_bf16(t[(kk + 0) * 65 + n], t[(kk + 1) * 65 + n]); w.y = cvt_pk_bf16(t[(kk + 2) * 65 + n], t[(kk + 3) * 65 + n]);
                w.z = cvt_pk_bf16(t[(kk + 4) * 65 + n], t[(kk + 5) * 65 + n]); w.w = cvt_pk_bf16(t[(kk + 6) * 65 + n], t[(kk + 7) * 65 + n]);
                *(u32x4*)(d.dst + (size_t)n * d.ldd + kk) = w; } }
        __syncthreads();
    }
}
__device__ __forceinline__ void convert_mixer_weights(const Frame& F, const Params& p, int layer) {
    const MixerTiles td{layer == 0 ? p.ret_w_in : p.ml_w_in, layer == 0 ? p.ret_w_out : p.ml_w_out, (bf16_t*)(p.ws + OFF_WIN), (bf16_t*)(p.ws + OFF_WOUT), layer == 0 ? 6144 : 6152};
    convert_tiles(F, 2048, td);
}
__device__ __forceinline__ void convert_ffn_weights(const Frame& F, const Params& p, int layer) {
    const FfnTiles td{p.up_w + (size_t)layer * 1024 * 5632, p.dn_w + (size_t)layer * 2816 * 1024, (bf16_t*)(p.ws + OFF_WUP), (bf16_t*)(p.ws + OFF_WDN)};
    convert_tiles(F, 2112, td);
}

__device__ __forceinline__ void prologue_phase(const Frame& F, const Params& p) {
    float* MOD = (float*)(p.ws + OFF_SM + SM_MOD);
    LAS float* red = (LAS float*)F.lds;
    for (int u = F.bid; u < 192; u += F.G) {
        const int l = u / 96, cgp = u % 96, cq = F.tid & 15, kg = F.tid >> 4;
        const float* w = p.ada_w + (size_t)l * 1024 * 6144 + cgp * 64 + cq * 4;
        f32x4 a = {0.f, 0.f, 0.f, 0.f};
#pragma unroll 8
        for (int k = kg * 32; k < kg * 32 + 32; ++k) { const float cv = p.c[k]; const float ca = siluf(cv); a += ca * *(const f32x4*)(w + (size_t)k * 6144); }
        __syncthreads();
#pragma unroll
        for (int e = 0; e < 4; ++e) red[kg * 64 + cq * 4 + e] = a[e];
        __syncthreads();
        if (F.tid < 64) { float s = 0.f; for (int k = 0; k < 32; ++k) s += red[k * 64 + F.tid]; MOD[l * 6144 + cgp * 64 + F.tid] = s + p.ada_b[l * 6144 + cgp * 64 + F.tid]; }
    }
    const int gt = F.bid * 512 + F.tid, gn = F.G * 512;
    if (gt < 128) ((float*)(p.ws + OFF_SM + SM_IFQ))[gt] = powf(10000.0f, -(float)(2 * gt) / 256.0f);
    float* RB = (float*)(p.ws + OFF_SM + SM_RB); float* CB = (float*)(p.ws + OFF_SM + SM_CB); float* XS = (float*)(p.ws + OFF_SM + SM_XS); float* WK = (float*)(p.ws + OFF_SM + SM_WK);
    for (int e = gt; e < 4 * S_; e += gn) { const int h = e >> 14, t = e & (S_ - 1), i = t & 255; const float lg = logf(1.0f - exp2f(-5.0f - (float)h));
        RB[e] = (float)i * lg; CB[e] = -(float)i * lg; XS[e] = expf((float)(i + 1) * lg); WK[e] = expf((float)(255 - i) * lg); }
    if (gt < 256) { const int h = gt >> 6; const float lg = logf(1.0f - exp2f(-5.0f - (float)h)); ((float*)(p.ws + OFF_SM + SM_SCP))[gt] = expf(256.0f * lg); ((float*)(p.ws + OFF_SM + SM_SCN))[gt] = 1.0f; }
}

template <bool GATES> __device__ __forceinline__ void norm_phase(const Frame& F, const Params& p, const float* xin, const float* g, const float* sh, const float* sc) {
    bf16_t* H = (bf16_t*)(p.ws + OFF_H);
    LAS float* wg = (LAS float*)F.lds;
    if (GATES) { __syncthreads(); for (int e = F.tid; e < 8192; e += 512) wg[e] = p.ml_w_in[(size_t)(e >> 3) * 6152 + 6144 + (e & 7)]; __syncthreads(); }
    float* LI = (float*)(p.ws + OFF_SM + SM_LI); float* LF = (float*)(p.ws + OFF_SM + SM_LF);
    f32x4 gv[4], scv[4], shv[4];
#pragma unroll
    for (int j = 0; j < 4; ++j) { const int c = F.lane * 4 + 256 * j; gv[j] = *(const f32x4*)(g + c); scv[j] = *(const f32x4*)(sc + c); shv[j] = *(const f32x4*)(sh + c); }
    for (int row0 = (F.bid * 8 + F.wid) * 4; row0 < S_; row0 += F.G * 8 * 4) {
        f32x4 xa[4][4];
#pragma unroll
        for (int rr = 0; rr < 4; ++rr)
#pragma unroll
            for (int j = 0; j < 4; ++j) xa[rr][j] = *(const f32x4*)(xin + (size_t)(row0 + rr) * 1024 + F.lane * 4 + 256 * j);
#pragma unroll
        for (int rr = 0; rr < 4; ++rr) {
        const int row = row0 + rr; f32x4 xv[4]; float ss = 0.f;
#pragma unroll
        for (int j = 0; j < 4; ++j) { xv[j] = xa[rr][j]; ss += xv[j][0] * xv[j][0] + xv[j][1] * xv[j][1] + xv[j][2] * xv[j][2] + xv[j][3] * xv[j][3]; }
        ss = wave_sum(ss); const float rstd = rsqrtf(ss * (1.0f / 1024.0f) + EPS);
        float gp[8];
        if (GATES) {
#pragma unroll
            for (int k = 0; k < 8; ++k) gp[k] = 0.f; }
#pragma unroll
        for (int j = 0; j < 4; ++j) { f32x4 hv;
#pragma unroll
            for (int e = 0; e < 4; ++e) hv[e] = xv[j][e] * rstd * gv[j][e] * (1.0f + scv[j][e]) + shv[j][e];
            u32x2 w; w.x = cvt_pk_bf16(hv[0], hv[1]); w.y = cvt_pk_bf16(hv[2], hv[3]);
            *(u32x2*)(H + (size_t)row * 1024 + F.lane * 4 + 256 * j) = w;
            if (GATES) {
#pragma unroll
                for (int e = 0; e < 4; ++e) { const LAS float* wr_ = wg + (F.lane * 4 + 256 * j + e) * 8;
#pragma unroll
                    for (int k = 0; k < 8; ++k) gp[k] += hv[e] * wr_[k]; } } }
        if (GATES) {
#pragma unroll
            for (int k = 0; k < 8; ++k) gp[k] = wave_sum(gp[k]);
            if (F.lane == 0) {
#pragma unroll
                for (int k = 0; k < 4; ++k) { LI[(size_t)row * 4 + k] = gp[k] + p.ml_bg[k]; const float v = gp[4 + k] + p.ml_bg[4 + k]; LF[(size_t)row * 4 + k] = fminf(v, 0.f) - log1pf(expf(-fabsf(v))); } } }
        }
    }
}

__device__ __forceinline__ void prep_a(const Frame& F, const Params& p) {
    const float* LI = (const float*)(p.ws + OFF_SM + SM_LI); const float* LF = (const float*)(p.ws + OFF_SM + SM_LF);
    float* GG = (float*)(p.ws + OFF_SM + SM_GG); float* CB = (float*)(p.ws + OFF_SM + SM_CB); float* PM = (float*)(p.ws + OFF_SM + SM_PM); float* WK = (float*)(p.ws + OFF_SM + SM_WK);
    float* GL = (float*)(p.ws + OFF_SM + SM_GL); float* ML = (float*)(p.ws + OFF_SM + SM_ML);
    for (int u = F.bid; u < 256 && F.wid == 0; u += F.G) {
        const int h = u >> 6, ch = u & 63, t0 = ch * 256 + F.lane * 4;
        float g[4], cb[4], pm[4]; float run = 0.f;
#pragma unroll
        for (int e = 0; e < 4; ++e) { run += LF[(size_t)(t0 + e) * 4 + h]; g[e] = run; }
        float incl = run;
        for (int o = 1; o < 64; o <<= 1) { const float v = __shfl_up(incl, o); if (F.lane >= o) incl += v; }
        const float excl = incl - run;
        float lm = -INFINITY;
#pragma unroll
        for (int e = 0; e < 4; ++e) { g[e] += excl; cb[e] = LI[(size_t)(t0 + e) * 4 + h] - g[e]; lm = fmaxf(lm, cb[e]); pm[e] = lm; }
        float im = lm;
        for (int o = 1; o < 64; o <<= 1) { const float v = __shfl_up(im, o); if (F.lane >= o) im = fmaxf(im, v); }
        float em = __shfl_up(im, 1); if (F.lane == 0) em = -INFINITY;
#pragma unroll
        for (int e = 0; e < 4; ++e) pm[e] = fmaxf(pm[e], em);
        const float gL = __shfl(g[3], 63), pml = __shfl(pm[3], 63);
#pragma unroll
        for (int e = 0; e < 4; ++e) { const size_t o = (size_t)h * S_ + t0 + e; GG[o] = g[e]; CB[o] = cb[e]; PM[o] = pm[e]; WK[o] = expf(cb[e] - pml); }
        if (F.lane == 0) { GL[u] = gL; ML[u] = gL + pml; }
    }
}
__device__ __forceinline__ void prep_b(const Frame& F, const Params& p) {
    const float* GG = (const float*)(p.ws + OFF_SM + SM_GG); const float* PM = (const float*)(p.ws + OFF_SM + SM_PM);
    const float* GL = (const float*)(p.ws + OFF_SM + SM_GL); const float* ML = (const float*)(p.ws + OFF_SM + SM_ML);
    float* RB = (float*)(p.ws + OFF_SM + SM_RB); float* XS = (float*)(p.ws + OFF_SM + SM_XS); float* EM = (float*)(p.ws + OFF_SM + SM_EM);
    float* SCP = (float*)(p.ws + OFF_SM + SM_SCP); float* SCN = (float*)(p.ws + OFF_SM + SM_SCN);
    for (int u = F.bid; u < 256 && F.wid == 0; u += F.G) {
        const int h = u >> 6, ch = u & 63;
        const float glv = GL[h * 64 + F.lane], mlv = ML[h * 64 + F.lane];
        float m = 0.f;
#pragma unroll 8
        for (int c2 = 0; c2 < 64; ++c2) { const float gl = __shfl(glv, c2), ml = __shfl(mlv, c2); if (c2 < ch) m = fmaxf(gl + m, ml); }
#pragma unroll
        for (int e = 0; e < 4; ++e) { const size_t o = (size_t)h * S_ + ch * 256 + F.lane * 4 + e; const float mx = fmaxf(m, PM[o]); RB[o] = -mx; XS[o] = expf(m - mx); EM[o] = expf(-(GG[o] + mx)); }
        if (F.lane == 0) { const float mn = fmaxf(GL[u] + m, ML[u]); SCP[u] = expf(GL[u] + m - mn); SCN[u] = expf(ML[u] - mn); }
    }
}

template <int KIND> __device__ __forceinline__ void r3_pass(const Frame& F, const Params& p, int pair) {
    bf16_t* Qb = (bf16_t*)(p.ws + OFF_Q); bf16_t* Kb = (bf16_t*)(p.ws + OFF_K); bf16_t* KWT = (bf16_t*)(p.ws + OFF_KWT);
    const bf16_t* QKH = (const bf16_t*)(p.ws + OFF_SM + SM_QKH); const float* WK = (const float*)(p.ws + OFF_SM + SM_WK); float* NLOC = (float*)(p.ws + OFF_SM + SM_NLOC);
    LAS bf16_t* T = (LAS bf16_t*)F.lds;
    const int tr = F.tid >> 3, tc = (F.tid & 7) * 8;
    for (int u = F.bid; u < 1024; u += F.G) {
        const int ch = u >> 4, pc0 = (u & 15) * 64; const bool isk = pc0 >= 512;
        if (KIND == 0 && !isk) continue;
        const int bc0 = pc0 & 511, h2 = bc0 >> 8, h = 2 * pair + h2;
        bf16_t* buf = (isk ? Kb : Qb) + (size_t)h2 * S_ * 256 + (bc0 & 255) + tc;
        float cw[4][8], cbias[8];
        if (KIND == 1) { const int gc = (isk ? 1024 : 0) + pair * 512 + bc0 + tc;
#pragma unroll
            for (int j = 0; j < 4; ++j) { const f32x4 a = *(const f32x4*)(p.ml_cw + j * 2048 + gc), b = *(const f32x4*)(p.ml_cw + j * 2048 + gc + 4);
#pragma unroll
                for (int e = 0; e < 4; ++e) { cw[j][e] = a[e]; cw[j][4 + e] = b[e]; } }
            const f32x4 a = *(const f32x4*)(p.ml_cb + gc), b = *(const f32x4*)(p.ml_cb + gc + 4);
#pragma unroll
            for (int e = 0; e < 4; ++e) { cbias[e] = a[e]; cbias[4 + e] = b[e]; } }
        float nsum = 0.f;
        u32x4 nx[4]; float wkn = 0.f;
#define R3_LOAD(dst, s_) do { const int t_ = ch * 256 + (s_) * 64 + tr; dst[0] = *(const u32x4*)(buf + (size_t)t_ * 256); \
            if (KIND == 1) { _Pragma("unroll") for (int d = 1; d <= 3; ++d) { const int tt = t_ - d; u32x4 w_ = {0u, 0u, 0u, 0u}; \
                if (tr - d >= 0) w_ = *(const u32x4*)(buf + (size_t)tt * 256); \
                else if (tt >= 0) w_ = *(const u32x4*)(QKH + ((size_t)(tt >> 6) * 3 + ((tt & 63) - 61)) * 1024 + pc0 + tc); \
                dst[d] = w_; } } } while (0)
        R3_LOAD(nx, 0); if (isk) wkn = WK[(size_t)h * S_ + ch * 256 + tr];
        for (int s = 0; s < 4; ++s) {
            const int t = ch * 256 + s * 64 + tr;
            u32x4 cu[4];
#pragma unroll
            for (int d = 0; d < 4; ++d) cu[d] = nx[d];
            const float wk = wkn;
            if (s < 3) { R3_LOAD(nx, s + 1); if (isk) wkn = WK[(size_t)h * S_ + t + 64]; }
            float v[8]; unpack8(cu[0], v);
            if (KIND == 1) {
                float o[8];
#pragma unroll
                for (int e = 0; e < 8; ++e) o[e] = cbias[e] + cw[3][e] * v[e];
#pragma unroll
                for (int d = 1; d <= 3; ++d) { float x[8]; unpack8(cu[d], x);
#pragma unroll
                    for (int e = 0; e < 8; ++e) o[e] += cw[3 - d][e] * x[e]; }
#pragma unroll
                for (int e = 0; e < 8; ++e) { v[e] = siluf(o[e]); if (isk) v[e] *= 0.0625f; }
                __syncthreads();
                u32x4 w; w.x = cvt_pk_bf16(v[0], v[1]); w.y = cvt_pk_bf16(v[2], v[3]); w.z = cvt_pk_bf16(v[4], v[5]); w.w = cvt_pk_bf16(v[6], v[7]);
                *(u32x4*)(buf + (size_t)t * 256) = w;
            }
            if (isk) {
#pragma unroll
                for (int e = 0; e < 8; e += 2) { const unsigned w = cvt_pk_bf16(v[e] * wk, v[e + 1] * wk); T[(tc + e) * 66 + tr] = (bf16_t)(w & 0xffffu); T[(tc + e + 1) * 66 + tr] = (bf16_t)(w >> 16); }
                __syncthreads();
                const int col = F.tid >> 3, seg = F.tid & 7;
                const LAS unsigned* tp = (const LAS unsigned*)(T + col * 66 + seg * 8); u32x4 w; w.x = tp[0]; w.y = tp[1]; w.z = tp[2]; w.w = tp[3];
                *(u32x4*)(KWT + ((size_t)(h2 * 64 + ch) * 256 + (bc0 & 255) + col) * 256 + s * 64 + seg * 8) = w;
                float x[8]; unpack8(w, x); nsum += ((x[0] + x[1]) + (x[2] + x[3])) + ((x[4] + x[5]) + (x[6] + x[7]));
                __syncthreads();
            }
        }
#undef R3_LOAD
        if (KIND == 1 && isk) { nsum += __shfl_xor(nsum, 1); nsum += __shfl_xor(nsum, 2); nsum += __shfl_xor(nsum, 4);
            if ((F.tid & 7) == 0) NLOC[((size_t)h * 64 + ch) * 256 + (bc0 & 255) + (F.tid >> 3)] = nsum; }
    }
}

template <int KIND> __device__ __forceinline__ void scan_phase(const Frame& F, const Params& p, int pair) {
    unsigned* KV = (unsigned*)(p.ws + OFF_KVT);
    const float* SCP = (const float*)(p.ws + OFF_SM + SM_SCP); const float* SCN = (const float*)(p.ws + OFF_SM + SM_SCN);
    for (int e0 = F.bid * 512; e0 < 131072; e0 += F.G * 512) {
        const int h2 = e0 >> 16, h = 2 * pair + h2; unsigned* base = KV + (size_t)h2 * 64 * 65536 + (e0 & 65535) + F.tid;
        float s0 = 0.f, s1 = 0.f;
#pragma unroll 1
        for (int cb = 0; cb < 64; cb += 64) {
            unsigned v[64];
#pragma unroll
            for (int c = 0; c < 64; ++c) v[c] = base[(size_t)(cb + c) * 65536];
#pragma unroll
            for (int c = 0; c < 64; ++c) { base[(size_t)(cb + c) * 65536] = cvt_pk_bf16(s0, s1); const float a = SCP[h * 64 + cb + c], b = SCN[h * 64 + cb + c]; s0 = a * s0 + b * bf_lo(v[c]); s1 = a * s1 + b * bf_hi(v[c]); }
        }
    }
    if (KIND == 1) {
        const float* NLOC = (const float*)(p.ws + OFF_SM + SM_NLOC); const bf16_t* Qb = (const bf16_t*)(p.ws + OFF_Q); float* DC = (float*)(p.ws + OFF_SM + SM_DC);
        LAS float* nv = (LAS float*)F.lds;
        for (int u = F.bid; u < 256; u += F.G) {
            const int h2 = u & 1, hv = (u >> 1) & 1, ch = u >> 2, h = 2 * pair + h2;
            __syncthreads();
            if (F.tid < 256) { float n = 0.f;
#pragma unroll 1
                for (int cb = 0; cb < 64; cb += 16) { if (cb >= ch) break; float x[16];
#pragma unroll
                    for (int c = 0; c < 16; ++c) x[c] = (cb + c < ch) ? NLOC[((size_t)h * 64 + cb + c) * 256 + F.tid] : 0.f;
#pragma unroll
                    for (int c = 0; c < 16; ++c) if (cb + c < ch) n = SCP[h * 64 + cb + c] * n + SCN[h * 64 + cb + c] * x[c]; }
                nv[F.tid] = n; }
            __syncthreads();
            const f32x4 nn = *(const LAS f32x4*)(nv + F.lane * 4);
#pragma unroll 1
            for (int r0 = 0; r0 < 16; r0 += 8) { const int t0 = ch * 256 + hv * 128 + F.wid * 16 + r0; u32x2 w[8];
#pragma unroll
                for (int r = 0; r < 8; ++r) w[r] = *(const u32x2*)(Qb + ((size_t)h2 * S_ + t0 + r) * 256 + F.lane * 4);
#pragma unroll
                for (int r = 0; r < 8; ++r) { float d = bf_lo(w[r].x) * nn[0] + bf_hi(w[r].x) * nn[1] + bf_lo(w[r].y) * nn[2] + bf_hi(w[r].y) * nn[3];
                    d = wave_sum(d); if (F.lane == 0) DC[(size_t)(t0 + r) * 4 + h] = d; } }
        }
    }
}

__device__ __forceinline__ void gn_pass(const Frame& F, const Params& p) {
    bf16_t* Z = (bf16_t*)(p.ws + OFF_Z); const float* ST = (const float*)(p.ws + OFF_SM + SM_ST);
    for (int u0 = (F.bid * 8 + F.wid) * 4; u0 < S_ * 4; u0 += F.G * 8 * 4) {
        f32x4 st[4][4]; u32x4 zz[4]; f32x4 g0[4], g1[4];
#pragma unroll
        for (int j = 0; j < 4; ++j) { const int u = u0 + j; const f32x4* sp = (const f32x4*)(ST + (size_t)u * 16);
            st[j][0] = sp[0]; st[j][1] = sp[1]; st[j][2] = sp[2]; st[j][3] = sp[3];
            zz[j] = *(const u32x4*)(Z + (size_t)(u >> 2) * 2048 + (u & 3) * 512 + F.lane * 8);
            g0[j] = *(const f32x4*)(p.ml_gn + (u & 3) * 512 + F.lane * 8); g1[j] = *(const f32x4*)(p.ml_gn + (u & 3) * 512 + F.lane * 8 + 4); }
#pragma unroll
        for (int j = 0; j < 4; ++j) { const int u = u0 + j; const f32x4 a = st[j][0], b = st[j][1], c = st[j][2], d = st[j][3];
            const float s = (a[0] + a[2]) + (b[0] + b[2]) + (c[0] + c[2]) + (d[0] + d[2]), q = (a[1] + a[3]) + (b[1] + b[3]) + (c[1] + c[3]) + (d[1] + d[3]);
            const float mu = s * (1.0f / 512.0f), rstd = rsqrtf(fmaxf(q * (1.0f / 512.0f) - mu * mu, 0.f) + EPS);
            float y[8]; unpack8(zz[j], y); f32x4 o0, o1;
#pragma unroll
            for (int e = 0; e < 4; ++e) { o0[e] = (y[e] - mu) * rstd * g0[j][e]; o1[e] = (y[4 + e] - mu) * rstd * g1[j][e]; }
            *(u32x4*)(Z + (size_t)(u >> 2) * 2048 + (u & 3) * 512 + F.lane * 8) = pack8(o0, o1); }
    }
}

__device__ __forceinline__ void ffn_fix_panel(const Frame& F, const Params& p, int layer, int pm) {
    const bf16_t* FH = (const bf16_t*)(p.ws + OFF_FH); bf16_t* ACT = (bf16_t*)(p.ws + OFF_ACT);
    const float* cw = p.fcw + (size_t)layer * 3 * 5632; const float* cb = p.fcb + (size_t)layer * 5632;
    if (F.tid < 352) {
        const int chn = F.tid * 8, pn = chn >> 7, cc = chn & 127;
        f32x4 bq[2][2], a0[2][2], a1[2][2], a2[2][2];
#pragma unroll
        for (int bj = 0; bj < 2; ++bj)
#pragma unroll
            for (int v = 0; v < 2; ++v) { const int wch = bj * DFF + chn + 4 * v;
                bq[bj][v] = *(const f32x4*)(cb + wch); a0[bj][v] = *(const f32x4*)(cw + wch); a1[bj][v] = *(const f32x4*)(cw + 5632 + wch); a2[bj][v] = *(const f32x4*)(cw + 2 * 5632 + wch); }
#pragma unroll 1
        for (int gb = 0; gb < 2; ++gb) {
            u32x4 h[2][2][4];
#pragma unroll
            for (int gi = 0; gi < 2; ++gi) { const int gq = pm * 4 + gb * 2 + gi;
#pragma unroll
                for (int bj = 0; bj < 2; ++bj) { const int col = pn * 256 + bj * 128 + cc; const u32x4 z = {0u, 0u, 0u, 0u};
                    h[gi][bj][0] = gq > 0 ? *(const u32x4*)(FH + ((size_t)(gq - 1) * 4 + 0) * 5632 + col) : z;
                    h[gi][bj][1] = gq > 0 ? *(const u32x4*)(FH + ((size_t)(gq - 1) * 4 + 1) * 5632 + col) : z;
                    h[gi][bj][2] = *(const u32x4*)(FH + ((size_t)gq * 4 + 2) * 5632 + col);
                    h[gi][bj][3] = *(const u32x4*)(FH + ((size_t)gq * 4 + 3) * 5632 + col); } }
#pragma unroll
            for (int gi = 0; gi < 2; ++gi) { const int gq = pm * 4 + gb * 2 + gi;
#pragma unroll
                for (int r = 0; r < 2; ++r) {
                    float ua[8], ub[8];
#pragma unroll
                    for (int bj = 0; bj < 2; ++bj) { float* uo = bj ? ub : ua; float x0[8], x1[8], x2[8];
                        unpack8(h[gi][bj][r], x0); unpack8(h[gi][bj][r + 1], x1); unpack8(h[gi][bj][r + 2], x2);
#pragma unroll
                        for (int v = 0; v < 2; ++v)
#pragma unroll
                            for (int e = 0; e < 4; ++e) uo[4 * v + e] = bq[bj][v][e] + a0[bj][v][e] * x0[4 * v + e] + a1[bj][v][e] * x1[4 * v + e] + a2[bj][v][e] * x2[4 * v + e]; }
                    f32x4 o0, o1;
#pragma unroll
                    for (int e = 0; e < 4; ++e) { o0[e] = siluf(ua[e]) * ub[e]; o1[e] = siluf(ua[4 + e]) * ub[4 + e]; }
                    *(u32x4*)(ACT + (size_t)(gq * 64 + r) * DFF + chn) = pack8(o0, o1); } }
        }
    }
}

__device__ __forceinline__ void final_norm(const Frame& F, const Params& p) {
    f32x4 g[4];
#pragma unroll
    for (int j = 0; j < 4; ++j) g[j] = *(const f32x4*)(p.fin_g + F.lane * 4 + 256 * j);
    for (int row0 = (F.bid * 8 + F.wid) * 8; row0 < S_; row0 += F.G * 8 * 8) {
        f32x4 xa[8][4];
#pragma unroll
        for (int rr = 0; rr < 8; ++rr)
#pragma unroll
            for (int j = 0; j < 4; ++j) xa[rr][j] = *(const f32x4*)(p.out + (size_t)(row0 + rr) * 1024 + F.lane * 4 + 256 * j);
#pragma unroll
        for (int rr = 0; rr < 8; ++rr) { float ss = 0.f;
#pragma unroll
            for (int j = 0; j < 4; ++j) ss += xa[rr][j][0] * xa[rr][j][0] + xa[rr][j][1] * xa[rr][j][1] + xa[rr][j][2] * xa[rr][j][2] + xa[rr][j][3] * xa[rr][j][3];
            ss = wave_sum(ss); const float rstd = rsqrtf(ss * (1.0f / 1024.0f) + EPS);
#pragma unroll
            for (int j = 0; j < 4; ++j) *(f32x4*)(p.out + (size_t)(row0 + rr) * 1024 + F.lane * 4 + 256 * j) = xa[rr][j] * rstd * g[j]; }
    }
}

#define XB_TMO      128
#define XB_XCNT(j)  (256  + 64 * (j))
#define XB_XSUB(j)  (1280 + 64 * (j))
#define XB_XGEN(j)  (2304 + 64 * (j))
#define XB_TOP      3328
#define XB_TOPGEN   3392
#define XCD_BAR_WORDS 3456
#define XB_SPIN_CAP (1u << 18)
__device__ __forceinline__ unsigned xb_ld(unsigned* p)              { return __hip_atomic_load(p, __ATOMIC_RELAXED, __HIP_MEMORY_SCOPE_AGENT); }
__device__ __forceinline__ unsigned xb_add(unsigned* p, unsigned v) { return __hip_atomic_fetch_add(p, v, __ATOMIC_RELAXED, __HIP_MEMORY_SCOPE_AGENT); }
__device__ __forceinline__ unsigned xb_xcc_id() { return (unsigned)__builtin_amdgcn_s_getreg((3 << 11) | 20) & 0xFu; }
#define XB_SPIN(cond, bar) do { unsigned _sp = 0; while (cond) { __builtin_amdgcn_s_sleep(1); \
    if ((++_sp & 255u) == 0u) { if (xb_ld(&(bar)[XB_TMO])) break; if (_sp > XB_SPIN_CAP) { atomicAdd(&(bar)[XB_TMO], 1u); break; } } } } while (0)
struct XcdBarrier { unsigned* bar; unsigned x; volatile LAS unsigned* st; };
__device__ __forceinline__ XcdBarrier xcd_barrier_post(unsigned* bar, volatile LAS unsigned* st) {
    XcdBarrier b; b.bar = bar; b.x = xb_xcc_id(); b.st = st;
    if (threadIdx.x == 0) (void)xb_add(&bar[XB_XCNT(b.x)], 1u);
    return b;
}
__device__ __forceinline__ void xcd_barrier_complete(unsigned* bar, unsigned x, unsigned& nloc, unsigned& nx) {
    const unsigned G = gridDim.x * gridDim.y * gridDim.z;
    unsigned sum, cnt, mine, sp = 0u;
    for (;;) {
        sum = 0u; cnt = 0u; mine = 0u;
#pragma unroll
        for (unsigned j = 0; j < 16; ++j) { const unsigned c = xb_ld(&bar[XB_XCNT(j)]); sum += c; cnt += (c > 0u) ? 1u : 0u; mine = (j == x) ? c : mine; }
        if (sum == G) break;
        __builtin_amdgcn_s_sleep(1);
        if ((++sp & 255u) == 0u) { if (xb_ld(&bar[XB_TMO])) break; if (sp > XB_SPIN_CAP) { atomicAdd(&bar[XB_TMO], 1u); break; } }
    }
    nloc = mine > 0u ? mine : 1u; nx = cnt > 0u ? cnt : 1u;
}
__device__ __forceinline__ void xcd_barrier(const XcdBarrier& b) {
    asm volatile("s_waitcnt vmcnt(0)" ::: "memory");
    __syncthreads();
    if (threadIdx.x == 0) {
        unsigned* bar = b.bar;
        __builtin_amdgcn_s_waitcnt(0);
        unsigned nloc = b.st[0], nx = b.st[1];
        if (nloc == 0u) { xcd_barrier_complete(bar, b.x, nloc, nx); b.st[0] = nloc; b.st[1] = nx; }
        const unsigned old = xb_add(&bar[XB_XSUB(b.x)], 1u);
        const unsigned gen = old / nloc;
        if (old + 1u == (gen + 1u) * nloc) {
            __builtin_amdgcn_fence(__ATOMIC_RELEASE, "agent");
            asm volatile("s_waitcnt vmcnt(0)" ::: "memory");
            const unsigned og = xb_add(&bar[XB_TOP], 1u);
            const unsigned tg = og / nx;
            if (og + 1u == (tg + 1u) * nx) xb_add(&bar[XB_TOPGEN], 1u);
            else XB_SPIN(xb_ld(&bar[XB_TOPGEN]) == tg, bar);
            __builtin_amdgcn_fence(__ATOMIC_ACQUIRE, "agent");
            xb_add(&bar[XB_XGEN(b.x)], 1u);
            asm volatile("s_waitcnt vmcnt(0)" ::: "memory");
        } else {
            XB_SPIN(xb_ld(&bar[XB_XGEN(b.x)]) == gen, bar);
            __builtin_amdgcn_fence(__ATOMIC_ACQUIRE, "agent");
            asm volatile("s_waitcnt vmcnt(0)" ::: "memory");
        }
    }
    __syncthreads();
}

constexpr int N_PHASES = 33;
#ifdef ONLY_PH
#define PH_ON(k) ((k) == ONLY_PH)
#else
#define PH_ON(k) (p.ph_lo <= (k) && (k) < p.ph_hi)
#endif
#ifndef PROBE_CAT
#define PROBE_CAT 0
#endif
#if PROBE_CAT
#define RT() __builtin_amdgcn_s_memrealtime()
#define PH_END(k) do { if ((k) + 1 < p.ph_hi) { __syncthreads(); const unsigned long long t0_ = RT(); xcd_barrier(xbar); if (PROBE_CAT == 2) tprobe += RT() - t0_; } } while (0)
#define GT0 const unsigned long long tg0_ = RT();
#define GT1(c) if (PROBE_CAT == 1 || PROBE_CAT == (c)) tprobe += RT() - tg0_;
#else
#define PH_END(k) do { if ((k) + 1 < p.ph_hi) xcd_barrier(xbar); } while (0)
#define GT0
#define GT1(c)
#endif

typedef gm::SchedPlain SP;
template <int KIND> __device__ __forceinline__ SP sched_qk(const Frame& F, const Params& p, int pair) {
    const char* H = (const char*)(p.ws + OFF_H); const char* WIN = (const char*)(p.ws + OFF_WIN);
    return SP{H, WIN + (size_t)(pair * 512) * 2048, WIN + (size_t)(1024 + pair * 512) * 2048, 64, 4, 2, F.G, F.bid, (size_t)256 * 2048, (size_t)256 * 2048, 256, 0}; }
__device__ __forceinline__ SP sched_vt(const Frame& F, const Params& p, int pair) {
    const char* H = (const char*)(p.ws + OFF_H); const char* WIN = (const char*)(p.ws + OFF_WIN);
    return SP{WIN + (size_t)(2048 + pair * 1024) * 2048, H, H, 4, 64, 64, F.G, F.bid, (size_t)256 * 2048, (size_t)256 * 2048, 256, 1}; }
__device__ __forceinline__ SP sched_g(const Frame& F, const Params& p, int pair) {
    const char* H = (const char*)(p.ws + OFF_H); const char* WIN = (const char*)(p.ws + OFF_WIN);
    return SP{H, WIN + (size_t)(4096 + pair * 1024) * 2048, WIN, 64, 4, 4, F.G, F.bid, (size_t)256 * 2048, (size_t)256 * 2048, 2048, 0}; }
template <int KIND> __device__ __forceinline__ EpiQK<KIND> epi_qk(const Params& p, int pair) {
    return EpiQK<KIND>{(bf16_t*)(p.ws + OFF_Q), (bf16_t*)(p.ws + OFF_K), p.pos, (const float*)(p.ws + OFF_SM + SM_IFQ), (bf16_t*)(p.ws + OFF_SM + SM_QKH), (bf16_t*)(p.ws + OFF_KWT), (const float*)(p.ws + OFF_SM + SM_WK), pair}; }
template <int KIND> __device__ __forceinline__ EpiG<KIND> epi_g(const Params& p, int pair) {
    return EpiG<KIND>{(bf16_t*)(p.ws + OFF_Z), (float*)(p.ws + OFF_SM + SM_ST), KIND == 0 ? p.ret_gn : p.ml_gn, (const float*)(p.ws + OFF_SM + SM_PS), (const float*)(p.ws + OFF_SM + SM_XS),
                      (const float*)(p.ws + OFF_SM + SM_DC), (const float*)(p.ws + OFF_SM + SM_EM), pair}; }

template <int KIND, int PAIR> __device__ __forceinline__ void pair_core(const Frame& F0, const Params& p, const XcdBarrier& xbar, int base, unsigned long long& tprobe) {
    unsigned char* ws = p.ws; constexpr int pair = PAIR; constexpr int R = (KIND == 1) ? 1 : 0;
    if (KIND == 1) { if (PH_ON(base + 0)) { const Frame F = fresh(F0);
        if (pair == 0) prep_b(F, p);
        { GT0 r3_pass<KIND>(F, p, pair); GT1(9) }
        PH_END(base + 0); } }
    if (PH_ON(base + R)) { const Frame F = fresh(F0);
        { SchedKV S{(const char*)(ws + OFF_VT), (const char*)(ws + OFF_KWT), F.G, F.bid}; EpiPlain E{(bf16_t*)(ws + OFF_KVT), 256};
          { GT0 gm::gemm_phase<EpiPlain, SchedKV, false>(F.lds, gm::GP{256, 256, 4, 4}, S, E); GT1(5) } }
        { SchedS S{(const char*)(ws + OFF_Q), (const char*)(ws + OFF_K), F.G, (F.bid + 128) % F.G};
          EpiS<KIND == 1> E{(bf16_t*)(ws + OFF_P), (const float*)(ws + OFF_SM + SM_RB), (const float*)(ws + OFF_SM + SM_CB), (float*)(ws + OFF_SM + SM_PS), pair};
          { GT0 gm::gemm_phase<EpiS<KIND == 1>, SchedS, false>(F.lds, gm::GP{256, 256, 4, 4}, S, E); GT1(5) } }
        PH_END(base + R); }
    if (PH_ON(base + R + 1)) { const Frame F = fresh(F0); { GT0 scan_phase<KIND>(F, p, pair); GT1(10) } PH_END(base + R + 1); }
    if (PH_ON(base + R + 2)) { const Frame F = fresh(F0);
        SchedO S{(const char*)(ws + OFF_Q), (const char*)(ws + OFF_KVT), (const char*)(ws + OFF_P), (const char*)(ws + OFF_VT), F.G, F.bid};
        EpiO<KIND == 0> E{(bf16_t*)(ws + OFF_Z), (const float*)(ws + OFF_SM + SM_XS), (float*)(ws + OFF_SM + SM_ST), pair};
        { GT0 gm::gemm_phase<EpiO<KIND == 0>, SchedO, true>(F.lds, gm::GP{256, 256, 4, 8}, S, E); GT1(5) }
        PH_END(base + R + 2); }
}

template <int KIND> __device__ __forceinline__ void layer_program(const Frame& F0, const Params& p, const XcdBarrier& xbar, int base, unsigned long long& tprobe) {
    constexpr int layer = KIND;
    unsigned char* ws = p.ws; const float* MOD = (const float*)(ws + OFF_SM + SM_MOD) + layer * 6144;
    const char* H = (const char*)(ws + OFF_H);
    if (PH_ON(base)) { const Frame F = fresh(F0);
        { GT0 convert_mixer_weights(F, p, layer); GT1(7) }
        { GT0 norm_phase<KIND == 1>(F, p, layer == 0 ? p.x : p.out, p.ntg + layer * 1024, MOD, MOD + 1024); GT1(8) }
        PH_END(base); }
    if (PH_ON(base + 1)) { const Frame F = fresh(F0);
        gm::SchedMulti S{sched_qk<KIND>(F, p, 0), sched_vt(F, p, 0), sched_vt(F, p, 0), 256, 256, 0, F.G, F.bid};
        EpiMulti<EpiQK<KIND>, EpiPlain, EpiPlain> E{epi_qk<KIND>(p, 0), EpiPlain{(bf16_t*)(ws + OFF_VT), 256}, EpiPlain{(bf16_t*)(ws + OFF_VT), 256}};
        { GT0 gm::gemm_phase<EpiMulti<EpiQK<KIND>, EpiPlain, EpiPlain>, gm::SchedMulti, false>(F.lds, gm::GP{1024, 1024, 16, 16}, S, E); GT1(4) }
        if (KIND == 1) prep_a(F, p);
        PH_END(base + 1); }
    constexpr int PC = (KIND == 1) ? 4 : 3;
    pair_core<KIND, 0>(F0, p, xbar, base + 2, tprobe);
    if (PH_ON(base + 2 + PC)) { const Frame F = fresh(F0);
        gm::SchedMulti S{sched_g(F, p, 0), sched_qk<KIND>(F, p, 1), sched_vt(F, p, 1), 256, 256, 256, F.G, F.bid};
        EpiMulti<EpiG<KIND>, EpiQK<KIND>, EpiPlain> E{epi_g<KIND>(p, 0), epi_qk<KIND>(p, 1), EpiPlain{(bf16_t*)(ws + OFF_VT), 256}};
        { GT0 gm::gemm_phase<EpiMulti<EpiG<KIND>, EpiQK<KIND>, EpiPlain>, gm::SchedMulti, false>(F.lds, gm::GP{1024, 1024, 16, 16}, S, E); GT1(4) }
        PH_END(base + 2 + PC); }
    pair_core<KIND, 1>(F0, p, xbar, base + 3 + PC, tprobe);
    if (PH_ON(base + 3 + 2 * PC)) { const Frame F = fresh(F0);
        SP S = sched_g(F, p, 1); EpiG<KIND> E = epi_g<KIND>(p, 1);
        { GT0 gm::gemm_phase<EpiG<KIND>, SP, false>(F.lds, gm::GP{1024, 1024, 16, 16}, S, E); GT1(4) }
        PH_END(base + 3 + 2 * PC); }
    int k = base + 4 + 2 * PC;
    if (KIND == 1) { if (PH_ON(k)) { const Frame F = fresh(F0); { GT0 gn_pass(F, p); GT1(11) } PH_END(k); } ++k; }
    if (PH_ON(k)) { const Frame F = fresh(F0);
        SP S{(const char*)(ws + OFF_Z), (const char*)(ws + OFF_WOUT), (const char*)(ws + OFF_WOUT), 64, 4, 4, F.G, F.bid, (size_t)256 * 4096, (size_t)256 * 4096, 1024, 0};
        EpiRes E{layer == 0 ? p.x : p.out, p.out, MOD + 2048};
        { GT0 gm::gemm_phase<EpiRes, SP, false>(F.lds, gm::GP{2048, 2048, 32, 32}, S, E); GT1(6) }
        PH_END(k); }
    ++k;
    if (PH_ON(k)) { const Frame F = fresh(F0); { GT0 convert_ffn_weights(F, p, layer); GT1(7) } { GT0 norm_phase<false>(F, p, p.out, p.nfg + layer * 1024, MOD + 3072, MOD + 4096); GT1(8) } PH_END(k); }
    ++k;
    if (PH_ON(k)) { const Frame F = fresh(F0);
        SP S{H, (const char*)(ws + OFF_WUP), (const char*)(ws + OFF_WUP), 64, 22, 22, F.G, F.bid, (size_t)256 * 2048, (size_t)256 * 2048, DFF, 0};
        EpiUp E{(bf16_t*)(ws + OFF_ACT), (bf16_t*)(ws + OFF_FH), p.fcw + (size_t)layer * 3 * 5632, p.fcb + (size_t)layer * 5632};
        { GT0 gm::gemm_phase<EpiUp, SP, false>(F.lds, gm::GP{1024, 1024, 16, 16}, S, E); GT1(3) }
        PH_END(k); }
    ++k;
    if (PH_ON(k)) { const Frame F = fresh(F0);
        SP S{(const char*)(ws + OFF_ACT), (const char*)(ws + OFF_WDN), (const char*)(ws + OFF_WDN), 64, 4, 4, F.G, F.bid, (size_t)256 * DFF * 2, (size_t)256 * DFF * 2, 1024, 0};
        { GT0 gm::U u; for (int i = 0; S.next(i, u); ++i) ffn_fix_panel(F, p, layer, u.i0);
          asm volatile("s_waitcnt vmcnt(0)" ::: "memory"); __syncthreads(); GT1(11) }
        EpiRes E{p.out, p.out, MOD + 5120};
        { GT0 gm::gemm_phase<EpiRes, SP, false>(F.lds, gm::GP{DFF, DFF, 44, 44}, S, E); GT1(6) }
        PH_END(k); }
}

__global__ void __launch_bounds__(512, 2) fwd_kernel(Params p) {
    extern __shared__ __attribute__((aligned(16))) unsigned char smem[];
    Frame F0; F0.lds = (LAS unsigned char*)smem; F0.G = gridDim.x; F0.bid = blockIdx.x; F0.tid = threadIdx.x; F0.wid = 0; F0.lane = 0;
    cg::grid_group grid = cg::this_grid();
    if (p.ph_hi < 0) grid.sync();
    unsigned long long tprobe = 0;
    volatile LAS unsigned* xst = (volatile LAS unsigned*)(smem + gm::STAGE_BYTES);
    if (threadIdx.x < 4) xst[threadIdx.x] = 0u;
    __syncthreads();
    const XcdBarrier xbar = xcd_barrier_post((unsigned*)(p.ws + OFF_SM + SM_BAR), xst);
    if (PH_ON(0)) { const Frame F = fresh(F0); { GT0 prologue_phase(F, p); GT1(11) } PH_END(0); }
    layer_program<0>(F0, p, xbar, 1, tprobe);
    layer_program<1>(F0, p, xbar, 15, tprobe);
    if (PH_ON(32)) { const Frame F = fresh(F0); { GT0 final_norm(F, p); GT1(11) } }
#if PROBE_CAT
    if (blockIdx.x == 0) { const unsigned long long t0 = RT(); while (RT() - t0 < tprobe) __builtin_amdgcn_s_sleep(8); }
#endif
}

extern "C" void kernel_launch(void* const* d_in, const int* in_sizes, int n_in, void* d_out, int out_size, void* d_ws, size_t ws_size, hipStream_t stream) {
    static int grid_blocks = 0;
    constexpr int LDS_BYTES = gm::STAGE_BYTES + 16;
    if (!grid_blocks) {
        int dev = 0, cus = 0, per_cu = 0;
        (void)hipGetDevice(&dev); (void)hipDeviceGetAttribute(&cus, hipDeviceAttributeMultiprocessorCount, dev);
        (void)hipFuncSetAttribute((const void*)fwd_kernel, hipFuncAttributeMaxDynamicSharedMemorySize, LDS_BYTES);
        (void)hipOccupancyMaxActiveBlocksPerMultiprocessor(&per_cu, (const void*)fwd_kernel, 512, LDS_BYTES);
        if (per_cu < 1) per_cu = 1;
        grid_blocks = cus;
        if (ws_size < WS_END) fprintf(stderr, "kernel_launch: workspace too small: %zu < %zu\n", ws_size, (size_t)WS_END);
        (void)hipGetLastError();
    }
    Params p{};
    p.x = (const float*)d_in[0]; p.c = (const float*)d_in[1]; p.pos = (const int*)d_in[2]; p.ada_w = (const float*)d_in[3]; p.ada_b = (const float*)d_in[4];
    p.ntg = (const float*)d_in[5]; p.nfg = (const float*)d_in[6]; p.ret_w_in = (const float*)d_in[7]; p.ret_gn = (const float*)d_in[8]; p.ret_w_out = (const float*)d_in[9];
    p.ml_w_in = (const float*)d_in[10]; p.ml_bg = (const float*)d_in[11]; p.ml_cw = (const float*)d_in[12]; p.ml_cb = (const float*)d_in[13]; p.ml_gn = (const float*)d_in[14];
    p.ml_w_out = (const float*)d_in[15]; p.up_w = (const float*)d_in[16]; p.fcw = (const float*)d_in[17]; p.fcb = (const float*)d_in[18]; p.dn_w = (const float*)d_in[19];
    p.fin_g = (const float*)d_in[20]; p.out = (float*)d_out; p.ws = (unsigned char*)d_ws;
#if MULTI_LAUNCH
    for (int ph = 0; ph < N_PHASES; ++ph) { p.ph_lo = ph; p.ph_hi = ph + 1; hipLaunchKernelGGL(fwd_kernel, dim3(grid_blocks), dim3(512), LDS_BYTES, stream, p); }
#else
    p.ph_lo = 0; p.ph_hi = N_PHASES;
    (void)hipMemsetAsync((unsigned char*)d_ws + OFF_SM + SM_BAR, 0, XCD_BAR_WORDS * 4, stream);
    void* args[] = {&p};
    hipError_t e = hipLaunchCooperativeKernel((void*)fwd_kernel, dim3(grid_blocks), dim3(512), args, LDS_BYTES, stream);
    if (e != hipSuccess) fprintf(stderr, "cooperative launch failed: %s (grid %d)\n", hipGetErrorString(e), grid_blocks);
#endif
}
```

```cpp
#include <hip/hip_runtime.h>
#include <hip/hip_cooperative_groups.h>
#include <cstdio>
namespace cg = cooperative_groups;

#ifndef MULTI_LAUNCH
#define MULTI_LAUNCH 0
#endif

#define LAS __attribute__((address_space(3)))
typedef unsigned short bf16_t;
typedef short bf16x8 __attribute__((ext_vector_type(8)));
typedef float f32x4 __attribute__((ext_vector_type(4)));
typedef unsigned u32x4 __attribute__((ext_vector_type(4)));
typedef unsigned u32x2 __attribute__((ext_vector_type(2)));

constexpr int S_ = 16384, D_ = 1024, DFF = 2816;
constexpr float EPS = 1e-6f;

constexpr size_t OFF_W = 0;
constexpr size_t OFF_WIN = 0, OFF_WOUT = 12582912, OFF_WUP = 0, OFF_WDN = 11534336;
constexpr size_t OFF_H = 17301504;
constexpr size_t OFF_SM = OFF_H + 33554432;
constexpr size_t SM_MOD = 0;
constexpr size_t SM_IFQ = SM_MOD + 49152;
constexpr size_t SM_RB = SM_IFQ + 512;
constexpr size_t TBL = 262144;
constexpr size_t SM_CB = SM_RB + TBL, SM_XS = SM_CB + TBL, SM_WK = SM_XS + TBL, SM_EM = SM_WK + TBL, SM_GG = SM_EM + TBL, SM_PM = SM_GG + TBL;
constexpr size_t SM_GL = SM_PM + TBL;
constexpr size_t SM_ML = SM_GL + 1024, SM_SCP = SM_ML + 1024, SM_SCN = SM_SCP + 1024;
constexpr size_t SM_LI = SM_SCN + 1024;
constexpr size_t SM_LF = SM_LI + 262144;
constexpr size_t SM_PS = SM_LF + 262144;
constexpr size_t SM_DC = SM_PS + 1048576;
constexpr size_t SM_NLOC = SM_DC + 262144;
constexpr size_t SM_ST = SM_NLOC + 262144;
constexpr size_t SM_QKH = SM_ST + 4194304;
constexpr size_t SM_BAR = SM_QKH + 1572864;
constexpr size_t SM_END = SM_BAR + 16384;
constexpr size_t OFF_BIG = OFF_SM + 10485760;
static_assert(SM_END <= 10485760, "small region");
constexpr size_t OFF_Q = OFF_BIG, OFF_K = OFF_Q + 16777216, OFF_KWT = OFF_K + 16777216, OFF_VT = OFF_KWT + 16777216,
                 OFF_KVT = OFF_VT + 33554432, OFF_P = OFF_KVT + 33554432, OFF_Z = OFF_P + 16777216, WS_END = OFF_Z + 67108864;
constexpr size_t OFF_ACT = OFF_BIG, OFF_FH = OFF_ACT + 92274688;

struct Params {
    const float *x, *c; const int* pos; const float *ada_w, *ada_b, *ntg, *nfg, *ret_w_in, *ret_gn, *ret_w_out,
        *ml_w_in, *ml_bg, *ml_cw, *ml_cb, *ml_gn, *ml_w_out, *up_w, *fcw, *fcb, *dn_w, *fin_g;
    float* out; unsigned char* ws; int ph_lo, ph_hi;
};

__device__ __forceinline__ unsigned cvt_pk_bf16(float lo, float hi) { unsigned r; asm volatile("v_cvt_pk_bf16_f32 %0, %1, %2" : "=v"(r) : "v"(lo), "v"(hi)); return r; }
__device__ __forceinline__ float bf_lo(unsigned w) { return __uint_as_float(w << 16); }
__device__ __forceinline__ float bf_hi(unsigned w) { return __uint_as_float(w & 0xffff0000u); }
__device__ __forceinline__ float siluf(float v) { return v * __builtin_amdgcn_rcpf(1.0f + __expf(-v)); }
__device__ __forceinline__ float sigmf(float v) { return __builtin_amdgcn_rcpf(1.0f + __expf(-v)); }
__device__ __forceinline__ float dpp_shr1(float old, float x) { return __builtin_bit_cast(float, __builtin_amdgcn_update_dpp(__builtin_bit_cast(int, old), __builtin_bit_cast(int, x), 0x111, 0xf, 0xf, false)); }
__device__ __forceinline__ float dpp_shr2(float old, float x) { return __builtin_bit_cast(float, __builtin_amdgcn_update_dpp(__builtin_bit_cast(int, old), __builtin_bit_cast(int, x), 0x112, 0xf, 0xf, false)); }
__device__ __forceinline__ float dpp_ror1(float x) { return __builtin_bit_cast(float, __builtin_amdgcn_update_dpp(0, __builtin_bit_cast(int, x), 0x121, 0xf, 0xf, true)); }
__device__ __forceinline__ float dpp_ror2(float x) { return __builtin_bit_cast(float, __builtin_amdgcn_update_dpp(0, __builtin_bit_cast(int, x), 0x122, 0xf, 0xf, true)); }
__device__ __forceinline__ float dpp_mirror(float x) { return __builtin_bit_cast(float, __builtin_amdgcn_update_dpp(0, __builtin_bit_cast(int, x), 0x140, 0xf, 0xf, true)); }
__device__ __forceinline__ float dpp_swap01(float x) { return __builtin_bit_cast(float, __builtin_amdgcn_update_dpp(0, __builtin_bit_cast(int, x), 0xB1, 0xf, 0xf, true)); }
__device__ __forceinline__ float wave_sum(float v) { for (int o = 32; o >= 1; o >>= 1) v += __shfl_xor(v, o); return v; }
__device__ __forceinline__ u32x4 pack8(const f32x4 a, const f32x4 b) { u32x4 w; w.x = cvt_pk_bf16(a[0], a[1]); w.y = cvt_pk_bf16(a[2], a[3]); w.z = cvt_pk_bf16(b[0], b[1]); w.w = cvt_pk_bf16(b[2], b[3]); return w; }
__device__ __forceinline__ void unpack8(const u32x4 w, float (&f)[8]) { f[0] = bf_lo(w.x); f[1] = bf_hi(w.x); f[2] = bf_lo(w.y); f[3] = bf_hi(w.y); f[4] = bf_lo(w.z); f[5] = bf_hi(w.z); f[6] = bf_lo(w.w); f[7] = bf_hi(w.w); }

namespace gm {
constexpr int BM = 256, BK = 64, HALF = 128, HTB = HALF * BK * 2, STAGE_BYTES = 8 * HTB, NXCD = 8, WGM = 8;
__device__ __forceinline__ int lds_byte(int r, int c) { const int st = (r >> 4) * 2 + (c >> 5), rr = r & 15, cc = c & 31, ob = rr * 64 + cc * 2; return st * 1024 + (ob ^ (((ob >> 9) & 1) << 5)); }
__device__ __forceinline__ void stage_rc(int b, int& R, int& C) { const int st = b / 1024, sb = b % 1024, swz = sb ^ (((sb >> 9) & 1) << 5); R = (st >> 1) * 16 + swz / 64; C = (st & 1) * 32 + (swz % 64) / 2; }
__device__ __forceinline__ int perm32(int rho) { const int n = rho >> 4, i = rho & 15; return 8 * (i >> 2) + 4 * n + (i & 3); }

struct U { const char *a1, *b1, *a2, *b2; long co; int i0, i1, i2, i3, half, roff; };
struct GP { int lda, ldb, n1, nt; };

struct SchedPlain {
    const char* A; const char* B; const char* B2; int nM, nN, nsplit, G, c; size_t ta, tb; long ldc; int vt; int nfull = 1 << 30;
    __device__ __forceinline__ bool next(int i, U& u) const { return at((long)i * G + c, u); }
    __device__ __forceinline__ bool at(long L, U& u) const {
        const int nwg = nM * nN; int hf = 0, ro = 0;
        if (L >= nfull) { const long hi = L - nfull; L = nfull + (hi >> 1); hf = 1; ro = (int)(hi & 1) * 128; }
        if (L >= nwg) return false;
        int wgid = (int)L; { const int q = nwg / NXCD, r = nwg % NXCD, xcd = wgid % NXCD, off = wgid / NXCD; wgid = (xcd < r ? xcd * (q + 1) : r * (q + 1) + (xcd - r) * q) + off; }
        const int nig = WGM * nN, gid = wgid / nig, fm = gid * WGM, gsz = (nM - fm) < WGM ? (nM - fm) : WGM;
        const int pm = fm + ((wgid % nig) % gsz), pn = (wgid % nig) / gsz;
        u.half = hf; u.roff = ro; u.a1 = A + (size_t)pm * ta + (size_t)(ro >> 7) * (ta >> 1); u.b1 = pn < nsplit ? B + (size_t)pn * tb : B2 + (size_t)(pn - nsplit) * tb; u.a2 = u.a1; u.b2 = u.b1;
        u.co = vt ? ((long)((pm >> 1) * 64 + pn) * 512 + (pm & 1) * 256) * 256 : (long)pm * 256 * ldc + (long)pn * 256; u.i0 = pm; u.i1 = pn; u.i2 = 0; u.i3 = 0; return true;
    }
};

struct SchedMulti {
    SchedPlain s0, s1, s2; int n0, n1, n2, G, c;
    __device__ __forceinline__ bool next(int i, U& u) const {
        const long L = (long)i * G + c; bool ok; int w;
        if (L < n0) { ok = s0.at(L, u); w = 0; } else if (L < n0 + n1) { ok = s1.at(L - n0, u); w = 1; } else if (L < n0 + n1 + n2) { ok = s2.at(L - n0 - n1, u); w = 2; } else return false;
        u.i3 = w; return ok;
    }
};

template <class Epi, class Sched, bool TWOSEG>
__device__ __forceinline__ void gemm_phase(LAS unsigned char* lds, const GP g, const Sched& S, const Epi& E) {
    int tid = threadIdx.x; asm volatile("" : "+v"(tid));
    const int wid = __builtin_amdgcn_readfirstlane(tid >> 6), lane = tid & 63, wr = wid >> 2, wc = wid & 3, fr = lane & 15, fq = lane >> 4;
    const int nt = g.nt;
    unsigned voffA[2], voffB[2];
#pragma unroll
    for (int i = 0; i < 2; ++i) { int R, C; stage_rc(tid * 16 + i * 8192, R, C); const int Rb = Epi::PERM ? ((R & ~31) + perm32(R & 31)) : R;
        voffA[i] = (unsigned)(R * g.lda + C) * 2u; voffB[i] = (unsigned)(Rb * g.ldb + C) * 2u; }
    const size_t hsA1 = (size_t)HALF * g.lda * 2, hsB1 = (size_t)HALF * g.ldb * 2;
    const unsigned ldsw = (unsigned)wid * 1024u;
    const int aoff = lds_byte(wr * 64 + fr, fq * 8), boff = lds_byte(wc * 32 + fr, fq * 8);
#define G_SA(b, h) (((b) * 2 + (h)) * HTB)
#define G_SB(b, h) ((4 + (b) * 2 + (h)) * HTB)
#define G_STAGE(bufoff, gbase, voff) do { _Pragma("unroll") for (int _i = 0; _i < 2; ++_i) \
        __builtin_amdgcn_global_load_lds((const unsigned*)((const char*)(gbase) + (voff)[_i]), (LAS unsigned*)(lds + (bufoff) + ldsw + _i * 8192), 16, 0, 0); } while (0)
#define G_LDA(dst, b, h) do { _Pragma("unroll") for (int m = 0; m < 4; ++m) _Pragma("unroll") for (int k = 0; k < 2; ++k) dst[m][k] = *(const LAS bf16x8*)(lds + G_SA(b, h) + aoff + m * 2048 + k * 1024); } while (0)
#define G_LDB(dst, b, h) do { _Pragma("unroll") for (int n = 0; n < 2; ++n) _Pragma("unroll") for (int k = 0; k < 2; ++k) dst[n][k] = *(const LAS bf16x8*)(lds + G_SB(b, h) + boff + n * 2048 + k * 1024); } while (0)
#define G_MMA(ai, bj, At, Bt) do { __builtin_amdgcn_s_setprio(1); _Pragma("unroll") for (int m = 0; m < 4; ++m) _Pragma("unroll") for (int n = 0; n < 2; ++n) _Pragma("unroll") for (int k = 0; k < 2; ++k) \
        acc[ai][bj][m][n] = __builtin_amdgcn_mfma_f32_16x16x32_bf16(Bt[n][k], At[m][k], acc[ai][bj][m][n], 0, 0, 0); __builtin_amdgcn_s_setprio(0); } while (0)
#define G_WAIT_V(n) asm volatile("s_waitcnt vmcnt(" #n ")" ::: "memory")
#define G_WAIT_L(n) asm volatile("s_waitcnt lgkmcnt(" #n ")" ::: "memory")
#define G_BAR __builtin_amdgcn_s_barrier()
#define G_SCHED __builtin_amdgcn_sched_barrier(0)
    U cur, nxt; int ui = 0;
    if (!S.next(0, cur)) return;
    f32x4 acc[2][2][4][2];
#pragma unroll
    for (int a = 0; a < 2; ++a)
#pragma unroll
        for (int b = 0; b < 2; ++b)
#pragma unroll
            for (int m = 0; m < 4; ++m)
#pragma unroll
                for (int n = 0; n < 2; ++n) acc[a][b][m][n] = (f32x4){0.f, 0.f, 0.f, 0.f};
    bf16x8 At[4][2], B0[2][2], B1[2][2];
    G_STAGE(G_SB(0, 0), cur.b1, voffB); G_STAGE(G_SA(0, 0), cur.a1, voffA); G_STAGE(G_SB(0, 1), cur.b1 + hsB1, voffB); G_STAGE(G_SA(0, 1), cur.a1 + hsA1, voffA);
    if (wr == 1) G_BAR;
    G_WAIT_V(4); G_BAR;
    G_STAGE(G_SB(1, 0), cur.b1 + 128, voffB); G_STAGE(G_SA(1, 0), cur.a1 + 128, voffA); G_STAGE(G_SB(1, 1), cur.b1 + hsB1 + 128, voffB);
    G_WAIT_V(6); G_BAR;
    for (;;) {
        const bool has_next = S.next(ui + 1, nxt);
        const char* nA = has_next ? nxt.a1 : cur.a1; const char* nB = has_next ? nxt.b1 : cur.b1;
        for (int t = 0; t < nt; t += 2) {
            const bool last = (t == nt - 2);
            const bool sg1 = TWOSEG && (t >= g.n1);
            const bool sg2 = TWOSEG && !last && (t + 2 >= g.n1);
            const char* a1 = sg1 ? cur.a2 + (size_t)(t + 1 - g.n1) * 128 : cur.a1 + (size_t)(t + 1) * 128;
            const char* a2 = last ? nA : (sg2 ? cur.a2 + (size_t)(t + 2 - g.n1) * 128 : cur.a1 + (size_t)(t + 2) * 128);
            const char* b2 = last ? nB : (sg2 ? cur.b2 + (size_t)(t + 2 - g.n1) * 128 : cur.b1 + (size_t)(t + 2) * 128);
            const char* a3 = a2 + 128; const char* b3 = b2 + 128;
            if (TWOSEG) { if (t == g.n1) E.mid(acc, cur, wr, wc, fr, fq); }
            G_LDB(B0, 0, 0); G_SCHED; G_LDA(At, 0, 0); G_STAGE(G_SA(1, 1), a1 + hsA1, voffA);
            G_WAIT_L(8); G_BAR; G_WAIT_L(0); G_MMA(0, 0, At, B0); G_BAR; G_SCHED;
            G_LDB(B1, 0, 1); G_STAGE(G_SB(0, 0), b2, voffB);
            G_BAR; G_WAIT_L(0); G_MMA(0, 1, At, B1); G_BAR;
            G_LDA(At, 0, 1); G_STAGE(G_SA(0, 0), a2, voffA);
            G_BAR; G_WAIT_L(0); if (!cur.half) G_MMA(1, 0, At, B0); G_BAR; G_SCHED;
            G_STAGE(G_SB(0, 1), b2 + hsB1, voffB);
            G_WAIT_V(6); G_BAR; if (!cur.half) G_MMA(1, 1, At, B1); G_BAR;
            G_LDB(B0, 1, 0); G_SCHED; G_LDA(At, 1, 0); G_STAGE(G_SA(0, 1), a2 + hsA1, voffA);
            G_WAIT_L(8); G_BAR; G_WAIT_L(0); G_MMA(0, 0, At, B0); G_BAR; G_SCHED;
            G_LDB(B1, 1, 1); G_STAGE(G_SB(1, 0), b3, voffB);
            G_BAR; G_WAIT_L(0); G_MMA(0, 1, At, B1); G_BAR;
            G_LDA(At, 1, 1); G_STAGE(G_SA(1, 0), a3, voffA);
            G_BAR; G_WAIT_L(0); if (!cur.half) G_MMA(1, 0, At, B0); G_BAR; G_SCHED;
            G_STAGE(G_SB(1, 1), b3 + hsB1, voffB);
            G_WAIT_V(6); G_BAR; if (!cur.half) G_MMA(1, 1, At, B1); G_BAR;
        }
        E(acc, cur, wr, wc, fr, fq);
        if (!has_next) break;
#pragma unroll
        for (int a = 0; a < 2; ++a)
#pragma unroll
            for (int b = 0; b < 2; ++b)
#pragma unroll
                for (int m = 0; m < 4; ++m)
#pragma unroll
                    for (int n = 0; n < 2; ++n) acc[a][b][m][n] = (f32x4){0.f, 0.f, 0.f, 0.f};
        cur = nxt; ++ui;
    }
    G_WAIT_V(0);
    if (wr == 0) G_BAR;
    G_BAR;
#undef G_SA
#undef G_SB
#undef G_STAGE
#undef G_LDA
#undef G_LDB
#undef G_MMA
#undef G_WAIT_V
#undef G_WAIT_L
#undef G_BAR
#undef G_SCHED
}
}

typedef f32x4 Acc[2][2][4][2];

struct EpiPlain {
    static constexpr bool PERM = true; bf16_t* base; long ldc;
    __device__ __forceinline__ void mid(Acc&, const gm::U&, int, int, int, int) const {}
    __device__ __forceinline__ void operator()(const Acc& acc, const gm::U& u, int wr, int wc, int fr_, int fq_) const {
        int fr = fr_, fq = fq_; asm volatile("" : "+v"(fr), "+v"(fq));
        bf16_t* d = base + u.co + (long)(wr * 64 + fr) * ldc + wc * 32 + 8 * fq;
#pragma unroll
        for (int ai = 0; ai < 2; ++ai)
#pragma unroll
            for (int m = 0; m < 4; ++m)
#pragma unroll
                for (int bj = 0; bj < 2; ++bj) *(u32x4*)(d + (long)(ai * 128 + m * 16) * ldc + bj * 128) = pack8(acc[ai][bj][m][0], acc[ai][bj][m][1]);
    }
};

template <int KIND> struct EpiQK {
    static constexpr bool PERM = true; bf16_t* Q; bf16_t* K; const int* pos; const float* ifq; bf16_t* qkh; bf16_t* kwt; const float* wkt; int pair;
    __device__ __forceinline__ void mid(Acc&, const gm::U&, int, int, int, int) const {}
    __device__ __forceinline__ void operator()(const Acc& acc, const gm::U& u, int wr, int wc, int fr_, int fq_) const {
        int fr = fr_, fq = fq_; asm volatile("" : "+v"(fr), "+v"(fq));
        const int pm = u.i0, pn = u.i1, d0 = wc * 32 + 8 * fq;
        bf16_t* dst = (pn < 2 ? Q : K) + (size_t)(pn & 1) * S_ * 256 + d0;
        if (KIND == 0) {
            const float sc = pn < 2 ? 1.0f : 0.0625f;
            const f32x4 f0 = *(const f32x4*)(ifq + d0), f1 = *(const f32x4*)(ifq + d0 + 4);
#pragma unroll
            for (int ai = 0; ai < 2; ++ai)
#pragma unroll
                for (int m = 0; m < 4; ++m) {
                    const int t = pm * 256 + ai * 128 + wr * 64 + m * 16 + fr; const float pf = (float)pos[t];
                    f32x4 o1[2], o2[2];
#pragma unroll
                    for (int n = 0; n < 2; ++n)
#pragma unroll
                        for (int e = 0; e < 4; ++e) {
                            const float ang = pf * (n ? f1[e] : f0[e]);
                            const double rev = (double)ang * 0.15915494309189535; const float fx = (float)(rev - __builtin_rint(rev));
                            const float sn = __builtin_amdgcn_sinf(fx), cs = __builtin_amdgcn_cosf(fx);
                            const float t1 = acc[ai][0][m][n][e], t2 = acc[ai][1][m][n][e];
                            o1[n][e] = (t1 * cs - t2 * sn) * sc; o2[n][e] = (t1 * sn + t2 * cs) * sc; }
                    *(u32x4*)(dst + (size_t)t * 256) = pack8(o1[0], o1[1]); *(u32x4*)(dst + (size_t)t * 256 + 128) = pack8(o2[0], o2[1]);
                    if (pn >= 2) {
                        const int h2 = pn & 1, tl = ai * 128 + wr * 64 + m * 16 + fr; const float wk = wkt[(size_t)(2 * pair + h2) * S_ + t];
                        bf16_t* kp = kwt + ((size_t)(h2 * 64 + pm) * 256 + d0) * 256 + tl;
#pragma unroll
                        for (int n = 0; n < 2; ++n)
#pragma unroll
                            for (int e = 0; e < 4; e += 2) { const unsigned w1 = cvt_pk_bf16(o1[n][e] * wk, o1[n][e + 1] * wk), w2 = cvt_pk_bf16(o2[n][e] * wk, o2[n][e + 1] * wk);
                                kp[(size_t)(4 * n + e) * 256] = (bf16_t)(w1 & 0xffffu); kp[(size_t)(4 * n + e + 1) * 256] = (bf16_t)(w1 >> 16);
                                kp[(size_t)(128 + 4 * n + e) * 256] = (bf16_t)(w2 & 0xffffu); kp[(size_t)(128 + 4 * n + e + 1) * 256] = (bf16_t)(w2 >> 16); } } }
        } else {
#pragma unroll
            for (int ai = 0; ai < 2; ++ai)
#pragma unroll
                for (int m = 0; m < 4; ++m) {
                    const int t = pm * 256 + ai * 128 + wr * 64 + m * 16 + fr;
#pragma unroll
                    for (int bj = 0; bj < 2; ++bj) { const u32x4 w = pack8(acc[ai][bj][m][0], acc[ai][bj][m][1]);
                        *(u32x4*)(dst + (size_t)t * 256 + bj * 128) = w;
                        if (m == 3 && fr >= 13) { const int gq = pm * 4 + ai * 2 + wr; *(u32x4*)(qkh + ((size_t)gq * 3 + (fr - 13)) * 1024 + pn * 256 + bj * 128 + d0) = w; } } }
        }
    }
};

template <bool PSUM> struct EpiS {
    static constexpr bool PERM = true; bf16_t* P; const float* RB; const float* CB; float* PS; int pair;
    __device__ __forceinline__ void mid(Acc&, const gm::U&, int, int, int, int) const {}
    __device__ __forceinline__ void operator()(const Acc& acc, const gm::U& u, int wr, int wc, int fr_, int fq_) const {
        int fr = fr_, fq = fq_; asm volatile("" : "+v"(fr), "+v"(fq));
        const int ch = u.i0, h2 = u.i1, h = 2 * pair + h2, c0 = wc * 32 + 8 * fq, r0 = u.roff + wr * 64 + fr;
        const float* rb = RB + (size_t)h * S_ + ch * 256 + r0; const float* cb = CB + (size_t)h * S_ + ch * 256 + c0;
        bf16_t* d = P + ((size_t)(h2 * 64 + ch) * 256 + r0) * 256 + c0;
        float rbv[4], rs[4];
#pragma unroll
        for (int m = 0; m < 4; ++m) { rbv[m] = rb[m * 16]; rs[m] = 0.f; }
#pragma unroll
        for (int bj = 0; bj < 2; ++bj)
#pragma unroll
            for (int n = 0; n < 2; ++n) {
                const f32x4 cbv = *(const f32x4*)(cb + bj * 128 + 4 * n);
#pragma unroll
                for (int m = 0; m < 4; ++m) {
                    const int dij = (r0 + m * 16) - (bj * 128 + c0 + 4 * n);
                    f32x4 v;
#pragma unroll
                    for (int e = 0; e < 4; ++e) { const float w = (dij - e >= 0) ? acc[0][bj][m][n][e] * __builtin_amdgcn_exp2f((rbv[m] + cbv[e]) * 1.44269504f) : 0.f; v[e] = w; rs[m] += w; }
                    u32x2 pk; pk.x = cvt_pk_bf16(v[0], v[1]); pk.y = cvt_pk_bf16(v[2], v[3]);
                    *(u32x2*)(d + (size_t)(m * 16) * 256 + bj * 128 + 4 * n) = pk; }
            }
        if (PSUM) {
#pragma unroll
            for (int m = 0; m < 4; ++m) { float r = rs[m]; r += __shfl_xor(r, 16); r += __shfl_xor(r, 32);
                if (fq == 0) PS[((size_t)(ch * 256 + r0 + m * 16) * 4 + h) * 4 + wc] = r; } }
    }
};

template <bool STATS> struct EpiO {
    static constexpr bool PERM = true; bf16_t* Z; const float* XS; float* ST; int pair;
    __device__ __forceinline__ void mid(Acc& acc, const gm::U& u, int wr, int wc, int fr, int fq) const {
        const int ch = u.i0, h = 2 * pair + u.i1; const float* xs = XS + (size_t)h * S_ + ch * 256 + wr * 64 + fr;
#pragma unroll
        for (int ai = 0; ai < 2; ++ai)
#pragma unroll
            for (int m = 0; m < 4; ++m) { const float x = xs[ai * 128 + m * 16];
#pragma unroll
                for (int bj = 0; bj < 2; ++bj)
#pragma unroll
                    for (int n = 0; n < 2; ++n) acc[ai][bj][m][n] *= x; }
    }
    __device__ __forceinline__ void operator()(const Acc& acc, const gm::U& u, int wr, int wc, int fr_, int fq_) const {
        int fr = fr_, fq = fq_; asm volatile("" : "+v"(fr), "+v"(fq));
        const int ch = u.i0, h = 2 * pair + u.i1, nt2 = u.i2, c0 = wc * 32 + 8 * fq;
        bf16_t* d = Z + (size_t)(ch * 256) * 2048 + h * 512 + nt2 * 256 + c0;
#pragma unroll
        for (int ai = 0; ai < 2; ++ai)
#pragma unroll
            for (int m = 0; m < 4; ++m) {
                const int i = ai * 128 + wr * 64 + m * 16 + fr; float s = 0.f, q = 0.f;
#pragma unroll
                for (int bj = 0; bj < 2; ++bj) { *(u32x4*)(d + (size_t)i * 2048 + bj * 128) = pack8(acc[ai][bj][m][0], acc[ai][bj][m][1]);
                    if (STATS) {
#pragma unroll
                        for (int n = 0; n < 2; ++n)
#pragma unroll
                            for (int e = 0; e < 4; ++e) { const float v = acc[ai][bj][m][n][e]; s += v; q += v * v; } } }
                if (STATS) { s += __shfl_xor(s, 16); s += __shfl_xor(s, 32); q += __shfl_xor(q, 16); q += __shfl_xor(q, 32);
                    if (fq == 0) { float* st = ST + (((size_t)(ch * 256 + i) * 4 + h) * 8 + nt2 * 4 + wc) * 2; st[0] = s; st[1] = q; } } }
    }
};

template <int KIND> struct EpiG {
    static constexpr bool PERM = true; bf16_t* Z; float* ST; const float* gng; const float* PS; const float* XS; const float* DC; const float* EM; int pair;
    __device__ __forceinline__ void mid(Acc&, const gm::U&, int, int, int, int) const {}
    __device__ __forceinline__ void operator()(const Acc& acc, const gm::U& u, int wr, int wc, int fr_, int fq_) const {
        int fr = fr_, fq = fq_; asm volatile("" : "+v"(fr), "+v"(fq));
        const int pm = u.i0, pn = u.i1, h = 2 * pair + (pn >> 1), nt2 = pn & 1, c0 = wc * 32 + 8 * fq;
        const int colb = pair * 1024 + pn * 256 + c0;
        f32x4 gv[2][2];
        if (KIND == 0) {
#pragma unroll
            for (int bj = 0; bj < 2; ++bj)
#pragma unroll
                for (int n = 0; n < 2; ++n) gv[bj][n] = *(const f32x4*)(gng + colb + bj * 128 + 4 * n);
        }
#pragma unroll
        for (int ai = 0; ai < 2; ++ai)
#pragma unroll
            for (int m = 0; m < 4; ++m) {
                const int t = pm * 256 + ai * 128 + wr * 64 + m * 16 + fr;
                bf16_t* zp = Z + (size_t)t * 2048 + colb;
                if (KIND == 0) {
                    const f32x4* st = (const f32x4*)(ST + ((size_t)t * 4 + h) * 16);
                    const f32x4 a = st[0], b = st[1], c = st[2], d = st[3];
                    const float s = (a[0] + a[2]) + (b[0] + b[2]) + (c[0] + c[2]) + (d[0] + d[2]);
                    const float q = (a[1] + a[3]) + (b[1] + b[3]) + (c[1] + c[3]) + (d[1] + d[3]);
                    const float mu = s * (1.0f / 512.0f); const float var = fmaxf(q * (1.0f / 512.0f) - mu * mu, 0.f); const float rstd = rsqrtf(var + EPS);
#pragma unroll
                    for (int bj = 0; bj < 2; ++bj) { float y[8]; unpack8(*(const u32x4*)(zp + bj * 128), y); f32x4 o[2];
#pragma unroll
                        for (int n = 0; n < 2; ++n)
#pragma unroll
                            for (int e = 0; e < 4; ++e) o[n][e] = siluf(acc[ai][bj][m][n][e]) * (y[4 * n + e] - mu) * rstd * gv[bj][n][e];
                        *(u32x4*)(zp + bj * 128) = pack8(o[0], o[1]); }
                } else {
                    const f32x4 ps = *(const f32x4*)(PS + ((size_t)t * 4 + h) * 4);
                    const float den = (ps[0] + ps[1]) + (ps[2] + ps[3]) + XS[(size_t)h * S_ + t] * DC[(size_t)t * 4 + h];
                    const float inv = __builtin_amdgcn_rcpf(fmaxf(fabsf(den), EM[(size_t)h * S_ + t]));
                    float s = 0.f, q = 0.f;
#pragma unroll
                    for (int bj = 0; bj < 2; ++bj) { float y[8]; unpack8(*(const u32x4*)(zp + bj * 128), y); f32x4 o[2];
#pragma unroll
                        for (int n = 0; n < 2; ++n)
#pragma unroll
                            for (int e = 0; e < 4; ++e) { const float v = sigmf(acc[ai][bj][m][n][e]) * y[4 * n + e] * inv; o[n][e] = v; s += v; q += v * v; }
                        *(u32x4*)(zp + bj * 128) = pack8(o[0], o[1]); }
                    s += __shfl_xor(s, 16); s += __shfl_xor(s, 32); q += __shfl_xor(q, 16); q += __shfl_xor(q, 32);
                    if (fq == 0) { float* st = ST + (((size_t)t * 4 + h) * 8 + nt2 * 4 + wc) * 2; st[0] = s; st[1] = q; }
                }
            }
    }
};

struct EpiRes {
    static constexpr bool PERM = false; const float* base; float* out; const float* gate;
    __device__ __forceinline__ void mid(Acc&, const gm::U&, int, int, int, int) const {}
    __device__ __forceinline__ void operator()(const Acc& acc, const gm::U& u, int wr, int wc, int fr_, int fq_) const {
        int fr = fr_, fq = fq_; asm volatile("" : "+v"(fr), "+v"(fq));
        const int row0 = u.i0 * 256 + wr * 64 + fr, col0 = u.i1 * 256 + wc * 32 + 4 * fq;
        f32x4 gv[2][2];
#pragma unroll
        for (int bj = 0; bj < 2; ++bj)
#pragma unroll
            for (int n = 0; n < 2; ++n) gv[bj][n] = *(const f32x4*)(gate + col0 + bj * 128 + n * 16);
#pragma unroll
        for (int ai = 0; ai < 2; ++ai)
#pragma unroll
            for (int m = 0; m < 4; ++m) { const size_t ro = (size_t)(row0 + ai * 128 + m * 16) * 1024 + col0;
#pragma unroll
                for (int bj = 0; bj < 2; ++bj)
#pragma unroll
                    for (int n = 0; n < 2; ++n) { const size_t o = ro + bj * 128 + n * 16; const f32x4 b = *(const f32x4*)(base + o); *(f32x4*)(out + o) = b + gv[bj][n] * acc[ai][bj][m][n]; } }
    }
};

struct EpiUp {
    static constexpr bool PERM = true; bf16_t* act; bf16_t* fh; const float* cw; const float* cb;
    __device__ __forceinline__ void mid(Acc&, const gm::U&, int, int, int, int) const {}
    __device__ __forceinline__ void operator()(const Acc& acc, const gm::U& u, int wr, int wc, int fr_, int fq_) const {
        int fr = fr_, fq = fq_; asm volatile("" : "+v"(fr), "+v"(fq));
        const int pm = u.i0, pn = u.i1, c0 = wc * 32 + 8 * fq, lane = fq * 16 + fr;
        u32x2 pk0[2][4];
#pragma unroll
        for (int n = 0; n < 2; ++n) {
            f32x4 w0[2], w1[2], w2[2], bb[2];
#pragma unroll
            for (int bj = 0; bj < 2; ++bj) { const int chn = bj * DFF + pn * 128 + c0 + 4 * n;
                w0[bj] = *(const f32x4*)(cw + chn); w1[bj] = *(const f32x4*)(cw + 2 * DFF + chn); w2[bj] = *(const f32x4*)(cw + 4 * DFF + chn); bb[bj] = *(const f32x4*)(cb + chn); }
#pragma unroll
            for (int ai = 0; ai < 2; ++ai) { if (ai == 1 && u.half) continue;
#pragma unroll
                for (int m = 0; m < 4; ++m) {
                    f32x4 uu[2];
#pragma unroll
                    for (int bj = 0; bj < 2; ++bj)
#pragma unroll
                        for (int e = 0; e < 4; ++e) {
                            const float cur = acc[ai][bj][m][n][e]; const float prv = acc[ai][bj][m > 0 ? m - 1 : 0][n][e];
                            const float mr = dpp_mirror(prv), mr2 = dpp_swap01(mr);
                            const float p1 = dpp_shr1(mr, cur), p2 = dpp_shr2(mr2, cur);
                            uu[bj][e] = bb[bj][e] + w0[bj][e] * p2 + w1[bj][e] * p1 + w2[bj][e] * cur; }
                    u32x2 pk; pk.x = cvt_pk_bf16(siluf(uu[0][0]) * uu[1][0], siluf(uu[0][1]) * uu[1][1]); pk.y = cvt_pk_bf16(siluf(uu[0][2]) * uu[1][2], siluf(uu[0][3]) * uu[1][3]);
                    if (n == 0) pk0[ai][m] = pk;
                    else { const int t = pm * 256 + u.roff + ai * 128 + wr * 64 + m * 16 + fr; u32x4 w; w.x = pk0[ai][m].x; w.y = pk0[ai][m].y; w.z = pk.x; w.w = pk.y;
                        *(u32x4*)(act + (size_t)t * DFF + pn * 128 + c0) = w; }
                } }
        }
#pragma unroll
        for (int ai = 0; ai < 2; ++ai) { if (ai == 1 && u.half) continue;
            const int gq = pm * 4 + (u.roff >> 6) + ai * 2 + wr;
            if (fr >= 14) {
#pragma unroll
                for (int bj = 0; bj < 2; ++bj) *(u32x4*)(fh + ((size_t)gq * 4 + (fr - 14)) * (2 * DFF) + pn * 256 + bj * 128 + c0) = pack8(acc[ai][bj][3][0], acc[ai][bj][3][1]);
            }
            if (fr < 2) {
#pragma unroll
                for (int bj = 0; bj < 2; ++bj) *(u32x4*)(fh + ((size_t)gq * 4 + 2 + fr) * (2 * DFF) + pn * 256 + bj * 128 + c0) = pack8(acc[ai][bj][0][0], acc[ai][bj][0][1]);
            }
        }
    }
};

template <class E0, class E1, class E2> struct EpiMulti {
    static constexpr bool PERM = true; E0 e0; E1 e1; E2 e2;
    static_assert(E0::PERM && E1::PERM && E2::PERM, "mixed staging orders");
    __device__ __forceinline__ void mid(Acc&, const gm::U&, int, int, int, int) const {}
    __device__ __forceinline__ void operator()(const Acc& acc, const gm::U& u, int wr, int wc, int fr, int fq) const {
        if (u.i3 == 0) e0(acc, u, wr, wc, fr, fq); else if (u.i3 == 1) e1(acc, u, wr, wc, fr, fq); else e2(acc, u, wr, wc, fr, fq);
    }
};

struct SchedS { const char* Q; const char* K; int G, c;
    __device__ __forceinline__ bool next(int i, gm::U& u) const { const int L = i * G + c; if (L >= 256) return false; const int h2 = L & 1, hv = (L >> 1) & 1, ch = L >> 2;
        const size_t o = ((size_t)h2 * S_ + ch * 256) * 256 * 2; u.a1 = Q + o + (size_t)hv * 128 * 256 * 2; u.b1 = K + o; u.a2 = u.a1; u.b2 = u.b1; u.co = 0; u.i0 = ch; u.i1 = h2; u.i2 = 0; u.i3 = 0; u.half = 1; u.roff = hv * 128; return true; } };
struct SchedKV { const char* VT; const char* KWT; int G, c;
    __device__ __forceinline__ bool next(int i, gm::U& u) const { const int L = i * G + c; if (L >= 256) return false; const int mt = L & 1, h2 = (L >> 1) & 1, ch = L >> 2;
        u.a1 = VT + ((size_t)(h2 * 64 + ch) * 512 + mt * 256) * 256 * 2; u.b1 = KWT + ((size_t)(h2 * 64 + ch) * 256) * 256 * 2; u.a2 = u.a1; u.b2 = u.b1;
        u.co = ((long)(h2 * 64 + ch) * 512 + mt * 256) * 256; u.i0 = ch; u.i1 = h2; u.i2 = mt; u.i3 = 0; u.half = 0; u.roff = 0; return true; } };
struct SchedO { const char* Q; const char* KVT; const char* P; const char* VT; int G, c;
    __device__ __forceinline__ bool next(int i, gm::U& u) const { const int L = i * G + c; if (L >= 256) return false; const int nt2 = L & 1, h2 = (L >> 1) & 1, ch = L >> 2;
        u.a1 = Q + ((size_t)h2 * S_ + ch * 256) * 256 * 2; u.b1 = KVT + ((size_t)(h2 * 64 + ch) * 512 + nt2 * 256) * 256 * 2;
        u.a2 = P + ((size_t)(h2 * 64 + ch) * 65536) * 2; u.b2 = VT + ((size_t)(h2 * 64 + ch) * 512 + nt2 * 256) * 256 * 2;
        u.co = 0; u.i0 = ch; u.i1 = h2; u.i2 = nt2; u.i3 = 0; u.half = 0; u.roff = 0; return true; } };

struct Frame { LAS unsigned char* lds; int G, bid, tid, wid, lane; };
__device__ __forceinline__ Frame fresh(const Frame& f) { Frame r = f; asm volatile("" : "+v"(r.tid)); r.lane = r.tid & 63; r.wid = __builtin_amdgcn_readfirstlane(r.tid >> 6); return r; }

struct TileD { const float* src; bf16_t* dst; int lds_, ldd; };
struct MixerTiles { const float* win; const float* wout; bf16_t* WIN; bf16_t* WOUT; int ldin;
    __device__ __forceinline__ TileD operator()(int u) const {
        if (u < 1536) { const int kt = u & 15, ct = u >> 4; return TileD{win + (size_t)kt * 64 * ldin + ct * 64, WIN + (size_t)ct * 64 * 1024 + kt * 64, ldin, 1024}; }
        const int v = u - 1536, kt = v & 31, ct = v >> 5; return TileD{wout + (size_t)kt * 64 * 1024 + ct * 64, WOUT + (size_t)ct * 64 * 2048 + kt * 64, 1024, 2048}; } };
struct FfnTiles { const float* wup; const float* wdn; bf16_t* WUP; bf16_t* WDN;
    __device__ __forceinline__ TileD operator()(int u) const {
        if (u < 1408) { const int kt = u & 15, ct = u >> 4, c0 = ct * 64;
            const int cc = c0 < DFF ? c0 : c0 - DFF; const int r0 = (cc >> 7) * 256 + (c0 < DFF ? 0 : 128) + (cc & 127);
            return TileD{wup + (size_t)kt * 64 * 5632 + c0, WUP + (size_t)r0 * 1024 + kt * 64, 5632, 1024}; }
        const int v = u - 1408, kt = v % 44, ct = v / 44; return TileD{wdn + (size_t)kt * 64 * 1024 + ct * 64, WDN + (size_t)ct * 64 * DFF + kt * 64, 1024, DFF}; } };
template <class TD> __device__ __forceinline__ void convert_tiles(const Frame& F, int ntiles, const TD& td) {
    LAS float* tile = (LAS float*)F.lds;
    const int tx = F.tid & 63, ty = F.tid >> 6, n = F.tid >> 3, kk = (F.tid & 7) * 8;
    for (int u0 = F.bid; u0 < ntiles; u0 += 4 * F.G) {
        float v[4][8];
#pragma unroll
        for (int j = 0; j < 4; ++j) { const int u = u0 + j * F.G; if (u < ntiles) { const TileD d = td(u);
#pragma unroll
                for (int i = 0; i < 8; ++i) v[j][i] = d.src[(size_t)(ty + 8 * i) * d.lds_ + tx]; } }
#pragma unroll
        for (int j = 0; j < 4; ++j) { if (u0 + j * F.G < ntiles) {
#pragma unroll
                for (int i = 0; i < 8; ++i) tile[j * 4160 + (ty + 8 * i) * 65 + tx] = v[j][i]; } }
        __syncthreads();
#pragma unroll
        for (int j = 0; j < 4; ++j) { const int u = u0 + j * F.G; if (u < ntiles) { const TileD d = td(u); const LAS float* t = tile + j * 4160;
                u32x4 w; w.x = cvt_pk_bf16(t[(kk + 0) * 65 + n], t[(kk + 1) * 65 + n]); w.y = cvt_pk_bf16(t[(kk + 2) * 65 + n], t[(kk + 3) * 65 + n]);
                w.z = cvt_pk_bf16(t[(kk + 4) * 65 + n], t[(kk + 5) * 65 + n]); w.w = cvt_pk_bf16(t[(kk + 6) * 65 + n], t[(kk + 7) * 65 + n]);
                *(u32x4*)(d.dst + (size_t)n * d.ldd + kk) = w; } }
        __syncthreads();
    }
}
__device__ __forceinline__ void convert_mixer_weights(const Frame& F, const Params& p, int layer) {
    const MixerTiles td{layer == 0 ? p.ret_w_in : p.ml_w_in, layer == 0 ? p.ret_w_out : p.ml_w_out, (bf16_t*)(p.ws + OFF_WIN), (bf16_t*)(p.ws + OFF_WOUT), layer == 0 ? 6144 : 6152};
    convert_tiles(F, 2048, td);
}
__device__ __forceinline__ void convert_ffn_weights(const Frame& F, const Params& p, int layer) {
    const FfnTiles td{p.up_w + (size_t)layer * 1024 * 5632, p.dn_w + (size_t)layer * 2816 * 1024, (bf16_t*)(p.ws + OFF_WUP), (bf16_t*)(p.ws + OFF_WDN)};
    convert_tiles(F, 2112, td);
}

__device__ __forceinline__ void prologue_phase(const Frame& F, const Params& p) {
    float* MOD = (float*)(p.ws + OFF_SM + SM_MOD);
    LAS float* red = (LAS float*)F.lds;
    for (int u = F.bid; u < 192; u += F.G) {
        const int l = u / 96, cgp = u % 96, cq = F.tid & 15, kg = F.tid >> 4;
        const float* w = p.ada_w + (size_t)l * 1024 * 6144 + cgp * 64 + cq * 4;
        f32x4 a = {0.f, 0.f, 0.f, 0.f};
#pragma unroll 8
        for (int k = kg * 32; k < kg * 32 + 32; ++k) { const float cv = p.c[k]; const float ca = siluf(cv); a += ca * *(const f32x4*)(w + (size_t)k * 6144); }
        __syncthreads();
#pragma unroll
        for (int e = 0; e < 4; ++e) red[kg * 64 + cq * 4 + e] = a[e];
        __syncthreads();
        if (F.tid < 64) { float s = 0.f; for (int k = 0; k < 32; ++k) s += red[k * 64 + F.tid]; MOD[l * 6144 + cgp * 64 + F.tid] = s + p.ada_b[l * 6144 + cgp * 64 + F.tid]; }
    }
    const int gt = F.bid * 512 + F.tid, gn = F.G * 512;
    if (gt < 128) ((float*)(p.ws + OFF_SM + SM_IFQ))[gt] = powf(10000.0f, -(float)(2 * gt) / 256.0f);
    float* RB = (float*)(p.ws + OFF_SM + SM_RB); float* CB = (float*)(p.ws + OFF_SM + SM_CB); float* XS = (float*)(p.ws + OFF_SM + SM_XS); float* WK = (float*)(p.ws + OFF_SM + SM_WK);
    for (int e = gt; e < 4 * S_; e += gn) { const int h = e >> 14, t = e & (S_ - 1), i = t & 255; const float lg = logf(1.0f - exp2f(-5.0f - (float)h));
        RB[e] = (float)i * lg; CB[e] = -(float)i * lg; XS[e] = expf((float)(i + 1) * lg); WK[e] = expf((float)(255 - i) * lg); }
    if (gt < 256) { const int h = gt >> 6; const float lg = logf(1.0f - exp2f(-5.0f - (float)h)); ((float*)(p.ws + OFF_SM + SM_SCP))[gt] = expf(256.0f * lg); ((float*)(p.ws + OFF_SM + SM_SCN))[gt] = 1.0f; }
}

template <bool GATES> __device__ __forceinline__ void norm_phase(const Frame& F, const Params& p, const float* xin, const float* g, const float* sh, const float* sc) {
    bf16_t* H = (bf16_t*)(p.ws + OFF_H);
    LAS float* wg = (LAS float*)F.lds;
    if (GATES) { __syncthreads(); for (int e = F.tid; e < 8192; e += 512) wg[e] = p.ml_w_in[(size_t)(e >> 3) * 6152 + 6144 + (e & 7)]; __syncthreads(); }
    float* LI = (float*)(p.ws + OFF_SM + SM_LI); float* LF = (float*)(p.ws + OFF_SM + SM_LF);
    f32x4 gv[4], scv[4], shv[4];
#pragma unroll
    for (int j = 0; j < 4; ++j) { const int c = F.lane * 4 + 256 * j; gv[j] = *(const f32x4*)(g + c); scv[j] = *(const f32x4*)(sc + c); shv[j] = *(const f32x4*)(sh + c); }
    for (int row0 = (F.bid * 8 + F.wid) * 4; row0 < S_; row0 += F.G * 8 * 4) {
        f32x4 xa[4][4];
#pragma unroll
        for (int rr = 0; rr < 4; ++rr)
#pragma unroll
            for (int j = 0; j < 4; ++j) xa[rr][j] = *(const f32x4*)(xin + (size_t)(row0 + rr) * 1024 + F.lane * 4 + 256 * j);
#pragma unroll
        for (int rr = 0; rr < 4; ++rr) {
        const int row = row0 + rr; f32x4 xv[4]; float ss = 0.f;
#pragma unroll
        for (int j = 0; j < 4; ++j) { xv[j] = xa[rr][j]; ss += xv[j][0] * xv[j][0] + xv[j][1] * xv[j][1] + xv[j][2] * xv[j][2] + xv[j][3] * xv[j][3]; }
        ss = wave_sum(ss); const float rstd = rsqrtf(ss * (1.0f / 1024.0f) + EPS);
        float gp[8];
        if (GATES) {
#pragma unroll
            for (int k = 0; k < 8; ++k) gp[k] = 0.f; }
#pragma unroll
        for (int j = 0; j < 4; ++j) { f32x4 hv;
#pragma unroll
            for (int e = 0; e < 4; ++e) hv[e] = xv[j][e] * rstd * gv[j][e] * (1.0f + scv[j][e]) + shv[j][e];
            u32x2 w; w.x = cvt_pk_bf16(hv[0], hv[1]); w.y = cvt_pk_bf16(hv[2], hv[3]);
            *(u32x2*)(H + (size_t)row * 1024 + F.lane * 4 + 256 * j) = w;
            if (GATES) {
#pragma unroll
                for (int e = 0; e < 4; ++e) { const LAS float* wr_ = wg + (F.lane * 4 + 256 * j + e) * 8;
#pragma unroll
                    for (int k = 0; k < 8; ++k) gp[k] += hv[e] * wr_[k]; } } }
        if (GATES) {
#pragma unroll
            for (int k = 0; k < 8; ++k) gp[k] = wave_sum(gp[k]);
            if (F.lane == 0) {
#pragma unroll
                for (int k = 0; k < 4; ++k) { LI[(size_t)row * 4 + k] = gp[k] + p.ml_bg[k]; const float v = gp[4 + k] + p.ml_bg[4 + k]; LF[(size_t)row * 4 + k] = fminf(v, 0.f) - log1pf(expf(-fabsf(v))); } } }
        }
    }
}

__device__ __forceinline__ void prep_a(const Frame& F, const Params& p) {
    const float* LI = (const float*)(p.ws + OFF_SM + SM_LI); const float* LF = (const float*)(p.ws + OFF_SM + SM_LF);
    float* GG = (float*)(p.ws + OFF_SM + SM_GG); float* CB = (float*)(p.ws + OFF_SM + SM_CB); float* PM = (float*)(p.ws + OFF_SM + SM_PM); float* WK = (float*)(p.ws + OFF_SM + SM_WK);
    float* GL = (float*)(p.ws + OFF_SM + SM_GL); float* ML = (float*)(p.ws + OFF_SM + SM_ML);
    for (int u = F.bid; u < 256 && F.wid == 0; u += F.G) {
        const int h = u >> 6, ch = u & 63, t0 = ch * 256 + F.lane * 4;
        float g[4], cb[4], pm[4]; float run = 0.f;
#pragma unroll
        for (int e = 0; e < 4; ++e) { run += LF[(size_t)(t0 + e) * 4 + h]; g[e] = run; }
        float incl = run;
        for (int o = 1; o < 64; o <<= 1) { const float v = __shfl_up(incl, o); if (F.lane >= o) incl += v; }
        const float excl = incl - run;
        float lm = -INFINITY;
#pragma unroll
        for (int e = 0; e < 4; ++e) { g[e] += excl; cb[e] = LI[(size_t)(t0 + e) * 4 + h] - g[e]; lm = fmaxf(lm, cb[e]); pm[e] = lm; }
        float im = lm;
        for (int o = 1; o < 64; o <<= 1) { const float v = __shfl_up(im, o); if (F.lane >= o) im = fmaxf(im, v); }
        float em = __shfl_up(im, 1); if (F.lane == 0) em = -INFINITY;
#pragma unroll
        for (int e = 0; e < 4; ++e) pm[e] = fmaxf(pm[e], em);
        const float gL = __shfl(g[3], 63), pml = __shfl(pm[3], 63);
#pragma unroll
        for (int e = 0; e < 4; ++e) { const size_t o = (size_t)h * S_ + t0 + e; GG[o] = g[e]; CB[o] = cb[e]; PM[o] = pm[e]; WK[o] = expf(cb[e] - pml); }
        if (F.lane == 0) { GL[u] = gL; ML[u] = gL + pml; }
    }
}
__device__ __forceinline__ void prep_b(const Frame& F, const Params& p) {
    const float* GG = (const float*)(p.ws + OFF_SM + SM_GG); const float* PM = (const float*)(p.ws + OFF_SM + SM_PM);
    const float* GL = (const float*)(p.ws + OFF_SM + SM_GL); const float* ML = (const float*)(p.ws + OFF_SM + SM_ML);
    float* RB = (float*)(p.ws + OFF_SM + SM_RB); float* XS = (float*)(p.ws + OFF_SM + SM_XS); float* EM = (float*)(p.ws + OFF_SM + SM_EM);
    float* SCP = (float*)(p.ws + OFF_SM + SM_SCP); float* SCN = (float*)(p.ws + OFF_SM + SM_SCN);
    for (int u = F.bid; u < 256 && F.wid == 0; u += F.G) {
        const int h = u >> 6, ch = u & 63;
        const float glv = GL[h * 64 + F.lane], mlv = ML[h * 64 + F.lane];
        float m = 0.f;
#pragma unroll 8
        for (int c2 = 0; c2 < 64; ++c2) { const float gl = __shfl(glv, c2), ml = __shfl(mlv, c2); if (c2 < ch) m = fmaxf(gl + m, ml); }
#pragma unroll
        for (int e = 0; e < 4; ++e) { const size_t o = (size_t)h * S_ + ch * 256 + F.lane * 4 + e; const float mx = fmaxf(m, PM[o]); RB[o] = -mx; XS[o] = expf(m - mx); EM[o] = expf(-(GG[o] + mx)); }
        if (F.lane == 0) { const float mn = fmaxf(GL[u] + m, ML[u]); SCP[u] = expf(GL[u] + m - mn); SCN[u] = expf(ML[u] - mn); }
    }
}

template <int KIND> __device__ __forceinline__ void r3_pass(const Frame& F, const Params& p, int pair) {
    bf16_t* Qb = (bf16_t*)(p.ws + OFF_Q); bf16_t* Kb = (bf16_t*)(p.ws + OFF_K); bf16_t* KWT = (bf16_t*)(p.ws + OFF_KWT);
    const bf16_t* QKH = (const bf16_t*)(p.ws + OFF_SM + SM_QKH); const float* WK = (const float*)(p.ws + OFF_SM + SM_WK); float* NLOC = (float*)(p.ws + OFF_SM + SM_NLOC);
    LAS bf16_t* T = (LAS bf16_t*)F.lds;
    const int tr = F.tid >> 3, tc = (F.tid & 7) * 8;
    for (int u = F.bid; u < 1024; u += F.G) {
        const int ch = u >> 4, pc0 = (u & 15) * 64; const bool isk = pc0 >= 512;
        if (KIND == 0 && !isk) continue;
        const int bc0 = pc0 & 511, h2 = bc0 >> 8, h = 2 * pair + h2;
        bf16_t* buf = (isk ? Kb : Qb) + (size_t)h2 * S_ * 256 + (bc0 & 255) + tc;
        float cw[4][8], cbias[8];
        if (KIND == 1) { const int gc = (isk ? 1024 : 0) + pair * 512 + bc0 + tc;
#pragma unroll
            for (int j = 0; j < 4; ++j) { const f32x4 a = *(const f32x4*)(p.ml_cw + j * 2048 + gc), b = *(const f32x4*)(p.ml_cw + j * 2048 + gc + 4);
#pragma unroll
                for (int e = 0; e < 4; ++e) { cw[j][e] = a[e]; cw[j][4 + e] = b[e]; } }
            const f32x4 a = *(const f32x4*)(p.ml_cb + gc), b = *(const f32x4*)(p.ml_cb + gc + 4);
#pragma unroll
            for (int e = 0; e < 4; ++e) { cbias[e] = a[e]; cbias[4 + e] = b[e]; } }
        float nsum = 0.f;
        u32x4 nx[4]; float wkn = 0.f;
#define R3_LOAD(dst, s_) do { const int t_ = ch * 256 + (s_) * 64 + tr; dst[0] = *(const u32x4*)(buf + (size_t)t_ * 256); \
            if (KIND == 1) { _Pragma("unroll") for (int d = 1; d <= 3; ++d) { const int tt = t_ - d; u32x4 w_ = {0u, 0u, 0u, 0u}; \
                if (tr - d >= 0) w_ = *(const u32x4*)(buf + (size_t)tt * 256); \
                else if (tt >= 0) w_ = *(const u32x4*)(QKH + ((size_t)(tt >> 6) * 3 + ((tt & 63) - 61)) * 1024 + pc0 + tc); \
                dst[d] = w_; } } } while (0)
        R3_LOAD(nx, 0); if (isk) wkn = WK[(size_t)h * S_ + ch * 256 + tr];
        for (int s = 0; s < 4; ++s) {
            const int t = ch * 256 + s * 64 + tr;
            u32x4 cu[4];
#pragma unroll
            for (int d = 0; d < 4; ++d) cu[d] = nx[d];
            const float wk = wkn;
            if (s < 3) { R3_LOAD(nx, s + 1); if (isk) wkn = WK[(size_t)h * S_ + t + 64]; }
            float v[8]; unpack8(cu[0], v);
            if (KIND == 1) {
                float o[8];
#pragma unroll
                for (int e = 0; e < 8; ++e) o[e] = cbias[e] + cw[3][e] * v[e];
#pragma unroll
                for (int d = 1; d <= 3; ++d) { float x[8]; unpack8(cu[d], x);
#pragma unroll
                    for (int e = 0; e < 8; ++e) o[e] += cw[3 - d][e] * x[e]; }
#pragma unroll
                for (int e = 0; e < 8; ++e) { v[e] = siluf(o[e]); if (isk) v[e] *= 0.0625f; }
                __syncthreads();
                u32x4 w; w.x = cvt_pk_bf16(v[0], v[1]); w.y = cvt_pk_bf16(v[2], v[3]); w.z = cvt_pk_bf16(v[4], v[5]); w.w = cvt_pk_bf16(v[6], v[7]);
                *(u32x4*)(buf + (size_t)t * 256) = w;
            }
            if (isk) {
#pragma unroll
                for (int e = 0; e < 8; e += 2) { const unsigned w = cvt_pk_bf16(v[e] * wk, v[e + 1] * wk); T[(tc + e) * 72 + tr] = (bf16_t)(w & 0xffffu); T[(tc + e + 1) * 72 + tr] = (bf16_t)(w >> 16); }
                __syncthreads();
                const int col = F.tid >> 3, seg = F.tid & 7;
                const u32x4 w = *(const LAS u32x4*)(T + col * 72 + seg * 8);
                *(u32x4*)(KWT + ((size_t)(h2 * 64 + ch) * 256 + (bc0 & 255) + col) * 256 + s * 64 + seg * 8) = w;
                float x[8]; unpack8(w, x); nsum += ((x[0] + x[1]) + (x[2] + x[3])) + ((x[4] + x[5]) + (x[6] + x[7]));
                __syncthreads();
            }
        }
#undef R3_LOAD
        if (KIND == 1 && isk) { nsum += __shfl_xor(nsum, 1); nsum += __shfl_xor(nsum, 2); nsum += __shfl_xor(nsum, 4);
            if ((F.tid & 7) == 0) NLOC[((size_t)h * 64 + ch) * 256 + (bc0 & 255) + (F.tid >> 3)] = nsum; }
    }
}

template <int KIND> __device__ __forceinline__ void scan_phase(const Frame& F, const Params& p, int pair) {
    unsigned* KV = (unsigned*)(p.ws + OFF_KVT);
    const float* SCP = (const float*)(p.ws + OFF_SM + SM_SCP); const float* SCN = (const float*)(p.ws + OFF_SM + SM_SCN);
    for (int e0 = F.bid * 512; e0 < 131072; e0 += F.G * 512) {
        const int h2 = e0 >> 16, h = 2 * pair + h2; unsigned* base = KV + (size_t)h2 * 64 * 65536 + (e0 & 65535) + F.tid;
        float s0 = 0.f, s1 = 0.f;
#pragma unroll 1
        for (int cb = 0; cb < 64; cb += 64) {
            unsigned v[64];
#pragma unroll
            for (int c = 0; c < 64; ++c) v[c] = base[(size_t)(cb + c) * 65536];
#pragma unroll
            for (int c = 0; c < 64; ++c) { base[(size_t)(cb + c) * 65536] = cvt_pk_bf16(s0, s1); const float a = SCP[h * 64 + cb + c], b = SCN[h * 64 + cb + c]; s0 = a * s0 + b * bf_lo(v[c]); s1 = a * s1 + b * bf_hi(v[c]); }
        }
    }
    if (KIND == 1) {
        const float* NLOC = (const float*)(p.ws + OFF_SM + SM_NLOC); const bf16_t* Qb = (const bf16_t*)(p.ws + OFF_Q); float* DC = (float*)(p.ws + OFF_SM + SM_DC);
        LAS float* nv = (LAS float*)F.lds;
        for (int u = F.bid; u < 256; u += F.G) {
            const int h2 = u & 1, hv = (u >> 1) & 1, ch = u >> 2, h = 2 * pair + h2;
            __syncthreads();
            if (F.tid < 256) { float n = 0.f;
#pragma unroll 1
                for (int cb = 0; cb < 64; cb += 16) { if (cb >= ch) break; float x[16];
#pragma unroll
                    for (int c = 0; c < 16; ++c) x[c] = (cb + c < ch) ? NLOC[((size_t)h * 64 + cb + c) * 256 + F.tid] : 0.f;
#pragma unroll
                    for (int c = 0; c < 16; ++c) if (cb + c < ch) n = SCP[h * 64 + cb + c] * n + SCN[h * 64 + cb + c] * x[c]; }
                nv[F.tid] = n; }
            __syncthreads();
            const f32x4 nn = *(const LAS f32x4*)(nv + F.lane * 4);
#pragma unroll 1
            for (int r0 = 0; r0 < 16; r0 += 8) { const int t0 = ch * 256 + hv * 128 + F.wid * 16 + r0; u32x2 w[8];
#pragma unroll
                for (int r = 0; r < 8; ++r) w[r] = *(const u32x2*)(Qb + ((size_t)h2 * S_ + t0 + r) * 256 + F.lane * 4);
#pragma unroll
                for (int r = 0; r < 8; ++r) { float d = bf_lo(w[r].x) * nn[0] + bf_hi(w[r].x) * nn[1] + bf_lo(w[r].y) * nn[2] + bf_hi(w[r].y) * nn[3];
                    d = wave_sum(d); if (F.lane == 0) DC[(size_t)(t0 + r) * 4 + h] = d; } }
        }
    }
}

__device__ __forceinline__ void gn_pass(const Frame& F, const Params& p) {
    bf16_t* Z = (bf16_t*)(p.ws + OFF_Z); const float* ST = (const float*)(p.ws + OFF_SM + SM_ST);
    for (int u0 = (F.bid * 8 + F.wid) * 4; u0 < S_ * 4; u0 += F.G * 8 * 4) {
        f32x4 st[4][4]; u32x4 zz[4]; f32x4 g0[4], g1[4];
#pragma unroll
        for (int j = 0; j < 4; ++j) { const int u = u0 + j; const f32x4* sp = (const f32x4*)(ST + (size_t)u * 16);
            st[j][0] = sp[0]; st[j][1] = sp[1]; st[j][2] = sp[2]; st[j][3] = sp[3];
            zz[j] = *(const u32x4*)(Z + (size_t)(u >> 2) * 2048 + (u & 3) * 512 + F.lane * 8);
            g0[j] = *(const f32x4*)(p.ml_gn + (u & 3) * 512 + F.lane * 8); g1[j] = *(const f32x4*)(p.ml_gn + (u & 3) * 512 + F.lane * 8 + 4); }
#pragma unroll
        for (int j = 0; j < 4; ++j) { const int u = u0 + j; const f32x4 a = st[j][0], b = st[j][1], c = st[j][2], d = st[j][3];
            const float s = (a[0] + a[2]) + (b[0] + b[2]) + (c[0] + c[2]) + (d[0] + d[2]), q = (a[1] + a[3]) + (b[1] + b[3]) + (c[1] + c[3]) + (d[1] + d[3]);
            const float mu = s * (1.0f / 512.0f), rstd = rsqrtf(fmaxf(q * (1.0f / 512.0f) - mu * mu, 0.f) + EPS);
            float y[8]; unpack8(zz[j], y); f32x4 o0, o1;
#pragma unroll
            for (int e = 0; e < 4; ++e) { o0[e] = (y[e] - mu) * rstd * g0[j][e]; o1[e] = (y[4 + e] - mu) * rstd * g1[j][e]; }
            *(u32x4*)(Z + (size_t)(u >> 2) * 2048 + (u & 3) * 512 + F.lane * 8) = pack8(o0, o1); }
    }
}

__device__ __forceinline__ void ffn_fix_panel(const Frame& F, const Params& p, int layer, int pm) {
    const bf16_t* FH = (const bf16_t*)(p.ws + OFF_FH); bf16_t* ACT = (bf16_t*)(p.ws + OFF_ACT);
    const float* cw = p.fcw + (size_t)layer * 3 * 5632; const float* cb = p.fcb + (size_t)layer * 5632;
    if (F.tid < 352) {
        const int chn = F.tid * 8, pn = chn >> 7, cc = chn & 127;
        f32x4 bq[2][2], a0[2][2], a1[2][2], a2[2][2];
#pragma unroll
        for (int bj = 0; bj < 2; ++bj)
#pragma unroll
            for (int v = 0; v < 2; ++v) { const int wch = bj * DFF + chn + 4 * v;
                bq[bj][v] = *(const f32x4*)(cb + wch); a0[bj][v] = *(const f32x4*)(cw + wch); a1[bj][v] = *(const f32x4*)(cw + 5632 + wch); a2[bj][v] = *(const f32x4*)(cw + 2 * 5632 + wch); }
#pragma unroll 1
        for (int gb = 0; gb < 2; ++gb) {
            u32x4 h[2][2][4];
#pragma unroll
            for (int gi = 0; gi < 2; ++gi) { const int gq = pm * 4 + gb * 2 + gi;
#pragma unroll
                for (int bj = 0; bj < 2; ++bj) { const int col = pn * 256 + bj * 128 + cc; const u32x4 z = {0u, 0u, 0u, 0u};
                    h[gi][bj][0] = gq > 0 ? *(const u32x4*)(FH + ((size_t)(gq - 1) * 4 + 0) * 5632 + col) : z;
                    h[gi][bj][1] = gq > 0 ? *(const u32x4*)(FH + ((size_t)(gq - 1) * 4 + 1) * 5632 + col) : z;
                    h[gi][bj][2] = *(const u32x4*)(FH + ((size_t)gq * 4 + 2) * 5632 + col);
                    h[gi][bj][3] = *(const u32x4*)(FH + ((size_t)gq * 4 + 3) * 5632 + col); } }
#pragma unroll
            for (int gi = 0; gi < 2; ++gi) { const int gq = pm * 4 + gb * 2 + gi;
#pragma unroll
                for (int r = 0; r < 2; ++r) {
                    float ua[8], ub[8];
#pragma unroll
                    for (int bj = 0; bj < 2; ++bj) { float* uo = bj ? ub : ua; float x0[8], x1[8], x2[8];
                        unpack8(h[gi][bj][r], x0); unpack8(h[gi][bj][r + 1], x1); unpack8(h[gi][bj][r + 2], x2);
#pragma unroll
                        for (int v = 0; v < 2; ++v)
#pragma unroll
                            for (int e = 0; e < 4; ++e) uo[4 * v + e] = bq[bj][v][e] + a0[bj][v][e] * x0[4 * v + e] + a1[bj][v][e] * x1[4 * v + e] + a2[bj][v][e] * x2[4 * v + e]; }
                    f32x4 o0, o1;
#pragma unroll
                    for (int e = 0; e < 4; ++e) { o0[e] = siluf(ua[e]) * ub[e]; o1[e] = siluf(ua[4 + e]) * ub[4 + e]; }
                    *(u32x4*)(ACT + (size_t)(gq * 64 + r) * DFF + chn) = pack8(o0, o1); } }
        }
    }
}

__device__ __forceinline__ void final_norm(const Frame& F, const Params& p) {
    f32x4 g[4];
#pragma unroll
    for (int j = 0; j < 4; ++j) g[j] = *(const f32x4*)(p.fin_g + F.lane * 4 + 256 * j);
    for (int row0 = (F.bid * 8 + F.wid) * 8; row0 < S_; row0 += F.G * 8 * 8) {
        f32x4 xa[8][4];
#pragma unroll
        for (int rr = 0; rr < 8; ++rr)
#pragma unroll
            for (int j = 0; j < 4; ++j) xa[rr][j] = *(const f32x4*)(p.out + (size_t)(row0 + rr) * 1024 + F.lane * 4 + 256 * j);
#pragma unroll
        for (int rr = 0; rr < 8; ++rr) { float ss = 0.f;
#pragma unroll
            for (int j = 0; j < 4; ++j) ss += xa[rr][j][0] * xa[rr][j][0] + xa[rr][j][1] * xa[rr][j][1] + xa[rr][j][2] * xa[rr][j][2] + xa[rr][j][3] * xa[rr][j][3];
            ss = wave_sum(ss); const float rstd = rsqrtf(ss * (1.0f / 1024.0f) + EPS);
#pragma unroll
            for (int j = 0; j < 4; ++j) *(f32x4*)(p.out + (size_t)(row0 + rr) * 1024 + F.lane * 4 + 256 * j) = xa[rr][j] * rstd * g[j]; }
    }
}

#define XB_TMO      128
#define XB_XCNT(j)  (256  + 64 * (j))
#define XB_XSUB(j)  (1280 + 64 * (j))
#define XB_XGEN(j)  (2304 + 64 * (j))
#define XB_TOP      3328
#define XB_TOPGEN   3392
#define XCD_BAR_WORDS 3456
#define XB_SPIN_CAP (1u << 18)
__device__ __forceinline__ unsigned xb_ld(unsigned* p)              { return __hip_atomic_load(p, __ATOMIC_RELAXED, __HIP_MEMORY_SCOPE_AGENT); }
__device__ __forceinline__ unsigned xb_add(unsigned* p, unsigned v) { return __hip_atomic_fetch_add(p, v, __ATOMIC_RELAXED, __HIP_MEMORY_SCOPE_AGENT); }
__device__ __forceinline__ unsigned xb_xcc_id() { return (unsigned)__builtin_amdgcn_s_getreg((3 << 11) | 20) & 0xFu; }
#define XB_SPIN(cond, bar) do { unsigned _sp = 0; while (cond) { __builtin_amdgcn_s_sleep(1); \
    if ((++_sp & 255u) == 0u) { if (xb_ld(&(bar)[XB_TMO])) break; if (_sp > XB_SPIN_CAP) { atomicAdd(&(bar)[XB_TMO], 1u); break; } } } } while (0)
struct XcdBarrier { unsigned* bar; unsigned x; volatile LAS unsigned* st; };
__device__ __forceinline__ XcdBarrier xcd_barrier_post(unsigned* bar, volatile LAS unsigned* st) {
    XcdBarrier b; b.bar = bar; b.x = xb_xcc_id(); b.st = st;
    if (threadIdx.x == 0) (void)xb_add(&bar[XB_XCNT(b.x)], 1u);
    return b;
}
__device__ __forceinline__ void xcd_barrier_complete(unsigned* bar, unsigned x, unsigned& nloc, unsigned& nx) {
    const unsigned G = gridDim.x * gridDim.y * gridDim.z;
    unsigned sum, cnt, mine, sp = 0u;
    for (;;) {
        sum = 0u; cnt = 0u; mine = 0u;
#pragma unroll
        for (unsigned j = 0; j < 16; ++j) { const unsigned c = xb_ld(&bar[XB_XCNT(j)]); sum += c; cnt += (c > 0u) ? 1u : 0u; mine = (j == x) ? c : mine; }
        if (sum == G) break;
        __builtin_amdgcn_s_sleep(1);
        if ((++sp & 255u) == 0u) { if (xb_ld(&bar[XB_TMO])) break; if (sp > XB_SPIN_CAP) { atomicAdd(&bar[XB_TMO], 1u); break; } }
    }
    nloc = mine > 0u ? mine : 1u; nx = cnt > 0u ? cnt : 1u;
}
__device__ __forceinline__ void xcd_barrier(const XcdBarrier& b) {
    asm volatile("s_waitcnt vmcnt(0)" ::: "memory");
    __syncthreads();
    if (threadIdx.x == 0) {
        unsigned* bar = b.bar;
        __builtin_amdgcn_s_waitcnt(0);
        unsigned nloc = b.st[0], nx = b.st[1];
        if (nloc == 0u) { xcd_barrier_complete(bar, b.x, nloc, nx); b.st[0] = nloc; b.st[1] = nx; }
        const unsigned old = xb_add(&bar[XB_XSUB(b.x)], 1u);
        const unsigned gen = old / nloc;
        if (old + 1u == (gen + 1u) * nloc) {
            __builtin_amdgcn_fence(__ATOMIC_RELEASE, "agent");
            asm volatile("s_waitcnt vmcnt(0)" ::: "memory");
            const unsigned og = xb_add(&bar[XB_TOP], 1u);
            const unsigned tg = og / nx;
            if (og + 1u == (tg + 1u) * nx) xb_add(&bar[XB_TOPGEN], 1u);
            else XB_SPIN(xb_ld(&bar[XB_TOPGEN]) == tg, bar);
            __builtin_amdgcn_fence(__ATOMIC_ACQUIRE, "agent");
            xb_add(&bar[XB_XGEN(b.x)], 1u);
            asm volatile("s_waitcnt vmcnt(0)" ::: "memory");
        } else {
            XB_SPIN(xb_ld(&bar[XB_XGEN(b.x)]) == gen, bar);
            __builtin_amdgcn_fence(__ATOMIC_ACQUIRE, "agent");
            asm volatile("s_waitcnt vmcnt(0)" ::: "memory");
        }
    }
    __syncthreads();
}

constexpr int N_PHASES = 33;
#ifdef ONLY_PH
#define PH_ON(k) ((k) == ONLY_PH)
#else
#define PH_ON(k) (p.ph_lo <= (k) && (k) < p.ph_hi)
#endif
#ifndef PROBE_CAT
#define PROBE_CAT 0
#endif
#if PROBE_CAT
#define RT() __builtin_amdgcn_s_memrealtime()
#define PH_END(k) do { if ((k) + 1 < p.ph_hi) { __syncthreads(); const unsigned long long t0_ = RT(); xcd_barrier(xbar); if (PROBE_CAT == 2) tprobe += RT() - t0_; } } while (0)
#define GT0 const unsigned long long tg0_ = RT();
#define GT1(c) if (PROBE_CAT == 1 || PROBE_CAT == (c)) tprobe += RT() - tg0_;
#else
#define PH_END(k) do { if ((k) + 1 < p.ph_hi) xcd_barrier(xbar); } while (0)
#define GT0
#define GT1(c)
#endif

typedef gm::SchedPlain SP;
template <int KIND> __device__ __forceinline__ SP sched_qk(const Frame& F, const Params& p, int pair) {
    const char* H = (const char*)(p.ws + OFF_H); const char* WIN = (const char*)(p.ws + OFF_WIN);
    return SP{H, WIN + (size_t)(pair * 512) * 2048, WIN + (size_t)(1024 + pair * 512) * 2048, 64, 4, 2, F.G, F.bid, (size_t)256 * 2048, (size_t)256 * 2048, 256, 0}; }
__device__ __forceinline__ SP sched_vt(const Frame& F, const Params& p, int pair) {
    const char* H = (const char*)(p.ws + OFF_H); const char* WIN = (const char*)(p.ws + OFF_WIN);
    return SP{WIN + (size_t)(2048 + pair * 1024) * 2048, H, H, 4, 64, 64, F.G, F.bid, (size_t)256 * 2048, (size_t)256 * 2048, 256, 1}; }
__device__ __forceinline__ SP sched_g(const Frame& F, const Params& p, int pair) {
    const char* H = (const char*)(p.ws + OFF_H); const char* WIN = (const char*)(p.ws + OFF_WIN);
    return SP{H, WIN + (size_t)(4096 + pair * 1024) * 2048, WIN, 64, 4, 4, F.G, F.bid, (size_t)256 * 2048, (size_t)256 * 2048, 2048, 0}; }
template <int KIND> __device__ __forceinline__ EpiQK<KIND> epi_qk(const Params& p, int pair) {
    return EpiQK<KIND>{(bf16_t*)(p.ws + OFF_Q), (bf16_t*)(p.ws + OFF_K), p.pos, (const float*)(p.ws + OFF_SM + SM_IFQ), (bf16_t*)(p.ws + OFF_SM + SM_QKH), (bf16_t*)(p.ws + OFF_KWT), (const float*)(p.ws + OFF_SM + SM_WK), pair}; }
template <int KIND> __device__ __forceinline__ EpiG<KIND> epi_g(const Params& p, int pair) {
    return EpiG<KIND>{(bf16_t*)(p.ws + OFF_Z), (float*)(p.ws + OFF_SM + SM_ST), KIND == 0 ? p.ret_gn : p.ml_gn, (const float*)(p.ws + OFF_SM + SM_PS), (const float*)(p.ws + OFF_SM + SM_XS),
                      (const float*)(p.ws + OFF_SM + SM_DC), (const float*)(p.ws + OFF_SM + SM_EM), pair}; }

template <int KIND, int PAIR> __device__ __forceinline__ void pair_core(const Frame& F0, const Params& p, const XcdBarrier& xbar, int base, unsigned long long& tprobe) {
    unsigned char* ws = p.ws; constexpr int pair = PAIR; constexpr int R = (KIND == 1) ? 1 : 0;
    if (KIND == 1) { if (PH_ON(base + 0)) { const Frame F = fresh(F0);
        if (pair == 0) prep_b(F, p);
        { GT0 r3_pass<KIND>(F, p, pair); GT1(9) }
        PH_END(base + 0); } }
    if (PH_ON(base + R)) { const Frame F = fresh(F0);
        { SchedKV S{(const char*)(ws + OFF_VT), (const char*)(ws + OFF_KWT), F.G, F.bid}; EpiPlain E{(bf16_t*)(ws + OFF_KVT), 256};
          { GT0 gm::gemm_phase<EpiPlain, SchedKV, false>(F.lds, gm::GP{256, 256, 4, 4}, S, E); GT1(5) } }
        { SchedS S{(const char*)(ws + OFF_Q), (const char*)(ws + OFF_K), F.G, F.bid};
          EpiS<KIND == 1> E{(bf16_t*)(ws + OFF_P), (const float*)(ws + OFF_SM + SM_RB), (const float*)(ws + OFF_SM + SM_CB), (float*)(ws + OFF_SM + SM_PS), pair};
          { GT0 gm::gemm_phase<EpiS<KIND == 1>, SchedS, false>(F.lds, gm::GP{256, 256, 4, 4}, S, E); GT1(5) } }
        PH_END(base + R); }
    if (PH_ON(base + R + 1)) { const Frame F = fresh(F0); { GT0 scan_phase<KIND>(F, p, pair); GT1(10) } PH_END(base + R + 1); }
    if (PH_ON(base + R + 2)) { const Frame F = fresh(F0);
        SchedO S{(const char*)(ws + OFF_Q), (const char*)(ws + OFF_KVT), (const char*)(ws + OFF_P), (const char*)(ws + OFF_VT), F.G, F.bid};
        EpiO<KIND == 0> E{(bf16_t*)(ws + OFF_Z), (const float*)(ws + OFF_SM + SM_XS), (float*)(ws + OFF_SM + SM_ST), pair};
        { GT0 gm::gemm_phase<EpiO<KIND == 0>, SchedO, true>(F.lds, gm::GP{256, 256, 4, 8}, S, E); GT1(5) }
        PH_END(base + R + 2); }
}

template <int KIND> __device__ __forceinline__ void layer_program(const Frame& F0, const Params& p, const XcdBarrier& xbar, int base, unsigned long long& tprobe) {
    constexpr int layer = KIND;
    unsigned char* ws = p.ws; const float* MOD = (const float*)(ws + OFF_SM + SM_MOD) + layer * 6144;
    const char* H = (const char*)(ws + OFF_H);
    if (PH_ON(base)) { const Frame F = fresh(F0);
        { GT0 convert_mixer_weights(F, p, layer); GT1(7) }
        { GT0 norm_phase<KIND == 1>(F, p, layer == 0 ? p.x : p.out, p.ntg + layer * 1024, MOD, MOD + 1024); GT1(8) }
        PH_END(base); }
    if (PH_ON(base + 1)) { const Frame F = fresh(F0);
        gm::SchedMulti S{sched_qk<KIND>(F, p, 0), sched_vt(F, p, 0), sched_vt(F, p, 0), 256, 256, 0, F.G, F.bid};
        EpiMulti<EpiQK<KIND>, EpiPlain, EpiPlain> E{epi_qk<KIND>(p, 0), EpiPlain{(bf16_t*)(ws + OFF_VT), 256}, EpiPlain{(bf16_t*)(ws + OFF_VT), 256}};
        { GT0 gm::gemm_phase<EpiMulti<EpiQK<KIND>, EpiPlain, EpiPlain>, gm::SchedMulti, false>(F.lds, gm::GP{1024, 1024, 16, 16}, S, E); GT1(4) }
        if (KIND == 1) prep_a(F, p);
        PH_END(base + 1); }
    constexpr int PC = (KIND == 1) ? 4 : 3;
    pair_core<KIND, 0>(F0, p, xbar, base + 2, tprobe);
    if (PH_ON(base + 2 + PC)) { const Frame F = fresh(F0);
        gm::SchedMulti S{sched_g(F, p, 0), sched_qk<KIND>(F, p, 1), sched_vt(F, p, 1), 256, 256, 256, F.G, F.bid};
        EpiMulti<EpiG<KIND>, EpiQK<KIND>, EpiPlain> E{epi_g<KIND>(p, 0), epi_qk<KIND>(p, 1), EpiPlain{(bf16_t*)(ws + OFF_VT), 256}};
        { GT0 gm::gemm_phase<EpiMulti<EpiG<KIND>, EpiQK<KIND>, EpiPlain>, gm::SchedMulti, false>(F.lds, gm::GP{1024, 1024, 16, 16}, S, E); GT1(4) }
        PH_END(base + 2 + PC); }
    pair_core<KIND, 1>(F0, p, xbar, base + 3 + PC, tprobe);
    if (PH_ON(base + 3 + 2 * PC)) { const Frame F = fresh(F0);
        SP S = sched_g(F, p, 1); EpiG<KIND> E = epi_g<KIND>(p, 1);
        { GT0 gm::gemm_phase<EpiG<KIND>, SP, false>(F.lds, gm::GP{1024, 1024, 16, 16}, S, E); GT1(4) }
        PH_END(base + 3 + 2 * PC); }
    int k = base + 4 + 2 * PC;
    if (KIND == 1) { if (PH_ON(k)) { const Frame F = fresh(F0); { GT0 gn_pass(F, p); GT1(11) } PH_END(k); } ++k; }
    if (PH_ON(k)) { const Frame F = fresh(F0);
        SP S{(const char*)(ws + OFF_Z), (const char*)(ws + OFF_WOUT), (const char*)(ws + OFF_WOUT), 64, 4, 4, F.G, F.bid, (size_t)256 * 4096, (size_t)256 * 4096, 1024, 0};
        EpiRes E{layer == 0 ? p.x : p.out, p.out, MOD + 2048};
        { GT0 gm::gemm_phase<EpiRes, SP, false>(F.lds, gm::GP{2048, 2048, 32, 32}, S, E); GT1(6) }
        PH_END(k); }
    ++k;
    if (PH_ON(k)) { const Frame F = fresh(F0); { GT0 convert_ffn_weights(F, p, layer); GT1(7) } { GT0 norm_phase<false>(F, p, p.out, p.nfg + layer * 1024, MOD + 3072, MOD + 4096); GT1(8) } PH_END(k); }
    ++k;
    if (PH_ON(k)) { const Frame F = fresh(F0);
        SP S{H, (const char*)(ws + OFF_WUP), (const char*)(ws + OFF_WUP), 64, 22, 22, F.G, F.bid, (size_t)256 * 2048, (size_t)256 * 2048, DFF, 0, 1280};
        EpiUp E{(bf16_t*)(ws + OFF_ACT), (bf16_t*)(ws + OFF_FH), p.fcw + (size_t)layer * 3 * 5632, p.fcb + (size_t)layer * 5632};
        { GT0 gm::gemm_phase<EpiUp, SP, false>(F.lds, gm::GP{1024, 1024, 16, 16}, S, E); GT1(3) }
        PH_END(k); }
    ++k;
    if (PH_ON(k)) { const Frame F = fresh(F0);
        SP S{(const char*)(ws + OFF_ACT), (const char*)(ws + OFF_WDN), (const char*)(ws + OFF_WDN), 64, 4, 4, F.G, F.bid, (size_t)256 * DFF * 2, (size_t)256 * DFF * 2, 1024, 0};
        { GT0 gm::U u; for (int i = 0; S.next(i, u); ++i) ffn_fix_panel(F, p, layer, u.i0);
          asm volatile("s_waitcnt vmcnt(0)" ::: "memory"); __syncthreads(); GT1(11) }
        EpiRes E{p.out, p.out, MOD + 5120};
        { GT0 gm::gemm_phase<EpiRes, SP, false>(F.lds, gm::GP{DFF, DFF, 44, 44}, S, E); GT1(6) }
        PH_END(k); }
}

__global__ void __launch_bounds__(512, 2) fwd_kernel(Params p) {
    extern __shared__ __attribute__((aligned(16))) unsigned char smem[];
    Frame F0; F0.lds = (LAS unsigned char*)smem; F0.G = gridDim.x; F0.bid = blockIdx.x; F0.tid = threadIdx.x; F0.wid = 0; F0.lane = 0;
    cg::grid_group grid = cg::this_grid();
    if (p.ph_hi < 0) grid.sync();
    unsigned long long tprobe = 0;
    volatile LAS unsigned* xst = (volatile LAS unsigned*)(smem + gm::STAGE_BYTES);
    if (threadIdx.x < 4) xst[threadIdx.x] = 0u;
    __syncthreads();
    const XcdBarrier xbar = xcd_barrier_post((unsigned*)(p.ws + OFF_SM + SM_BAR), xst);
    if (PH_ON(0)) { const Frame F = fresh(F0); { GT0 prologue_phase(F, p); GT1(11) } PH_END(0); }
    layer_program<0>(F0, p, xbar, 1, tprobe);
    layer_program<1>(F0, p, xbar, 15, tprobe);
    if (PH_ON(32)) { const Frame F = fresh(F0); { GT0 final_norm(F, p); GT1(11) } }
#if PROBE_CAT
    if (blockIdx.x == 0) { const unsigned long long t0 = RT(); while (RT() - t0 < tprobe) __builtin_amdgcn_s_sleep(8); }
#endif
}

extern "C" void kernel_launch(void* const* d_in, const int* in_sizes, int n_in, void* d_out, int out_size, void* d_ws, size_t ws_size, hipStream_t stream) {
    static int grid_blocks = 0;
    constexpr int LDS_BYTES = gm::STAGE_BYTES + 16;
    if (!grid_blocks) {
        int dev = 0, cus = 0, per_cu = 0;
        (void)hipGetDevice(&dev); (void)hipDeviceGetAttribute(&cus, hipDeviceAttributeMultiprocessorCount, dev);
        (void)hipFuncSetAttribute((const void*)fwd_kernel, hipFuncAttributeMaxDynamicSharedMemorySize, LDS_BYTES);
        (void)hipOccupancyMaxActiveBlocksPerMultiprocessor(&per_cu, (const void*)fwd_kernel, 512, LDS_BYTES);
        if (per_cu < 1) per_cu = 1;
        grid_blocks = cus;
        if (ws_size < WS_END) fprintf(stderr, "kernel_launch: workspace too small: %zu < %zu\n", ws_size, (size_t)WS_END);
        (void)hipGetLastError();
    }
    Params p{};
    p.x = (const float*)d_in[0]; p.c = (const float*)d_in[1]; p.pos = (const int*)d_in[2]; p.ada_w = (const float*)d_in[3]; p.ada_b = (const float*)d_in[4];
    p.ntg = (const float*)d_in[5]; p.nfg = (const float*)d_in[6]; p.ret_w_in = (const float*)d_in[7]; p.ret_gn = (const float*)d_in[8]; p.ret_w_out = (const float*)d_in[9];
    p.ml_w_in = (const float*)d_in[10]; p.ml_bg = (const float*)d_in[11]; p.ml_cw = (const float*)d_in[12]; p.ml_cb = (const float*)d_in[13]; p.ml_gn = (const float*)d_in[14];
    p.ml_w_out = (const float*)d_in[15]; p.up_w = (const float*)d_in[16]; p.fcw = (const float*)d_in[17]; p.fcb = (const float*)d_in[18]; p.dn_w = (const float*)d_in[19];
    p.fin_g = (const float*)d_in[20]; p.out = (float*)d_out; p.ws = (unsigned char*)d_ws;
#if MULTI_LAUNCH
    for (int ph = 0; ph < N_PHASES; ++ph) { p.ph_lo = ph; p.ph_hi = ph + 1; hipLaunchKernelGGL(fwd_kernel, dim3(grid_blocks), dim3(512), LDS_BYTES, stream, p); }
#else
    p.ph_lo = 0; p.ph_hi = N_PHASES;
    (void)hipMemsetAsync((unsigned char*)d_ws + OFF_SM + SM_BAR, 0, XCD_BAR_WORDS * 4, stream);
    void* args[] = {&p};
    hipError_t e = hipLaunchCooperativeKernel((void*)fwd_kernel, dim3(grid_blocks), dim3(512), args, LDS_BYTES, stream);
    if (e != hipSuccess) fprintf(stderr, "cooperative launch failed: %s (grid %d)\n", hipGetErrorString(e), grid_blocks);
#endif
}
```

```cpp
#include <hip/hip_runtime.h>
#include <hip/hip_cooperative_groups.h>
#include <cstdio>
namespace cg = cooperative_groups;

#ifndef MULTI_LAUNCH
#define MULTI_LAUNCH 0
#endif

#define LAS __attribute__((address_space(3)))
typedef unsigned short bf16_t;
typedef short bf16x8 __attribute__((ext_vector_type(8)));
typedef float f32x4 __attribute__((ext_vector_type(4)));
typedef unsigned u32x4 __attribute__((ext_vector_type(4)));
typedef unsigned u32x2 __attribute__((ext_vector_type(2)));

constexpr int S_ = 16384, D_ = 1024, DFF = 2816;
constexpr float EPS = 1e-6f;

constexpr size_t OFF_W = 0;
constexpr size_t OFF_WIN = 0, OFF_WOUT = 12582912, OFF_WUP = 0, OFF_WDN = 11534336;
constexpr size_t OFF_H = 17301504;
constexpr size_t OFF_SM = OFF_H + 33554432;
constexpr size_t SM_MOD = 0;
constexpr size_t SM_IFQ = SM_MOD + 49152;
constexpr size_t SM_RB = SM_IFQ + 512;
constexpr size_t TBL = 262144;
constexpr size_t SM_CB = SM_RB + TBL, SM_XS = SM_CB + TBL, SM_WK = SM_XS + TBL, SM_EM = SM_WK + TBL, SM_GG = SM_EM + TBL, SM_PM = SM_GG + TBL;
constexpr size_t SM_GL = SM_PM + TBL;
constexpr size_t SM_ML = SM_GL + 1024, SM_SCP = SM_ML + 1024, SM_SCN = SM_SCP + 1024;
constexpr size_t SM_LI = SM_SCN + 1024;
constexpr size_t SM_LF = SM_LI + 262144;
constexpr size_t SM_PS = SM_LF + 262144;
constexpr size_t SM_DC = SM_PS + 1048576;
constexpr size_t SM_NLOC = SM_DC + 262144;
constexpr size_t SM_ST = SM_NLOC + 262144;
constexpr size_t SM_QKH = SM_ST + 4194304;
constexpr size_t SM_BAR = SM_QKH + 1572864;
constexpr size_t SM_END = SM_BAR + 16384;
constexpr size_t OFF_BIG = OFF_SM + 10485760;
static_assert(SM_END <= 10485760, "small region");
constexpr size_t OFF_Q = OFF_BIG, OFF_K = OFF_Q + 16777216, OFF_KWT = OFF_K + 16777216, OFF_VT = OFF_KWT + 16777216,
                 OFF_KVT = OFF_VT + 33554432, OFF_P = OFF_KVT + 33554432, OFF_Z = OFF_P + 16777216, WS_END = OFF_Z + 67108864;
constexpr size_t OFF_ACT = OFF_BIG, OFF_FH = OFF_ACT + 92274688;

struct Params {
    const float *x, *c; const int* pos; const float *ada_w, *ada_b, *ntg, *nfg, *ret_w_in, *ret_gn, *ret_w_out,
        *ml_w_in, *ml_bg, *ml_cw, *ml_cb, *ml_gn, *ml_w_out, *up_w, *fcw, *fcb, *dn_w, *fin_g;
    float* out; unsigned char* ws; int ph_lo, ph_hi;
};

__device__ __forceinline__ unsigned cvt_pk_bf16(float lo, float hi) { unsigned r; asm volatile("v_cvt_pk_bf16_f32 %0, %1, %2" : "=v"(r) : "v"(lo), "v"(hi)); return r; }
__device__ __forceinline__ float bf_lo(unsigned w) { return __uint_as_float(w << 16); }
__device__ __forceinline__ float bf_hi(unsigned w) { return __uint_as_float(w & 0xffff0000u); }
__device__ __forceinline__ float siluf(float v) { return v * __builtin_amdgcn_rcpf(1.0f + __expf(-v)); }
__device__ __forceinline__ float sigmf(float v) { return __builtin_amdgcn_rcpf(1.0f + __expf(-v)); }
__device__ __forceinline__ float dpp_shr1(float old, float x) { return __builtin_bit_cast(float, __builtin_amdgcn_update_dpp(__builtin_bit_cast(int, old), __builtin_bit_cast(int, x), 0x111, 0xf, 0xf, false)); }
__device__ __forceinline__ float dpp_shr2(float old, float x) { return __builtin_bit_cast(float, __builtin_amdgcn_update_dpp(__builtin_bit_cast(int, old), __builtin_bit_cast(int, x), 0x112, 0xf, 0xf, false)); }
__device__ __forceinline__ float dpp_ror1(float x) { return __builtin_bit_cast(float, __builtin_amdgcn_update_dpp(0, __builtin_bit_cast(int, x), 0x121, 0xf, 0xf, true)); }
__device__ __forceinline__ float dpp_ror2(float x) { return __builtin_bit_cast(float, __builtin_amdgcn_update_dpp(0, __builtin_bit_cast(int, x), 0x122, 0xf, 0xf, true)); }
__device__ __forceinline__ float dpp_mirror(float x) { return __builtin_bit_cast(float, __builtin_amdgcn_update_dpp(0, __builtin_bit_cast(int, x), 0x140, 0xf, 0xf, true)); }
__device__ __forceinline__ float dpp_swap01(float x) { return __builtin_bit_cast(float, __builtin_amdgcn_update_dpp(0, __builtin_bit_cast(int, x), 0xB1, 0xf, 0xf, true)); }
__device__ __forceinline__ float wave_sum(float v) { for (int o = 32; o >= 1; o >>= 1) v += __shfl_xor(v, o); return v; }
__device__ __forceinline__ u32x4 pack8(const f32x4 a, const f32x4 b) { u32x4 w; w.x = cvt_pk_bf16(a[0], a[1]); w.y = cvt_pk_bf16(a[2], a[3]); w.z = cvt_pk_bf16(b[0], b[1]); w.w = cvt_pk_bf16(b[2], b[3]); return w; }
__device__ __forceinline__ void unpack8(const u32x4 w, float (&f)[8]) { f[0] = bf_lo(w.x); f[1] = bf_hi(w.x); f[2] = bf_lo(w.y); f[3] = bf_hi(w.y); f[4] = bf_lo(w.z); f[5] = bf_hi(w.z); f[6] = bf_lo(w.w); f[7] = bf_hi(w.w); }

namespace gm {
constexpr int BM = 256, BK = 64, HALF = 128, HTB = HALF * BK * 2, STAGE_BYTES = 8 * HTB, NXCD = 8, WGM = 8;
__device__ __forceinline__ int lds_byte(int r, int c) { const int st = (r >> 4) * 2 + (c >> 5), rr = r & 15, cc = c & 31, ob = rr * 64 + cc * 2; return st * 1024 + (ob ^ (((ob >> 9) & 1) << 5)); }
__device__ __forceinline__ void stage_rc(int b, int& R, int& C) { const int st = b / 1024, sb = b % 1024, swz = sb ^ (((sb >> 9) & 1) << 5); R = (st >> 1) * 16 + swz / 64; C = (st & 1) * 32 + (swz % 64) / 2; }
__device__ __forceinline__ int perm32(int rho) { const int n = rho >> 4, i = rho & 15; return 8 * (i >> 2) + 4 * n + (i & 3); }

struct U { const char *a1, *b1, *a2, *b2; long co; int i0, i1, i2, i3; };
struct GP { int lda, ldb, n1, nt; };

struct SchedPlain {
    const char* A; const char* B; const char* B2; int nM, nN, nsplit, G, c; size_t ta, tb; long ldc; int vt;
    __device__ __forceinline__ bool next(int i, U& u) const { return at((long)i * G + c, u); }
    __device__ __forceinline__ bool at(long L, U& u) const {
        const int nwg = nM * nN; if (L >= nwg) return false;
        int wgid = (int)L; { const int q = nwg / NXCD, r = nwg % NXCD, xcd = wgid % NXCD, off = wgid / NXCD; wgid = (xcd < r ? xcd * (q + 1) : r * (q + 1) + (xcd - r) * q) + off; }
        const int nig = WGM * nN, gid = wgid / nig, fm = gid * WGM, gsz = (nM - fm) < WGM ? (nM - fm) : WGM;
        const int pm = fm + ((wgid % nig) % gsz), pn = (wgid % nig) / gsz;
        u.a1 = A + (size_t)pm * ta; u.b1 = pn < nsplit ? B + (size_t)pn * tb : B2 + (size_t)(pn - nsplit) * tb; u.a2 = u.a1; u.b2 = u.b1;
        u.co = vt ? ((long)((pm >> 1) * 64 + pn) * 512 + (pm & 1) * 256) * 256 : (long)pm * 256 * ldc + (long)pn * 256; u.i0 = pm; u.i1 = pn; u.i2 = 0; u.i3 = 0; return true;
    }
};

struct SchedMulti {
    SchedPlain s0, s1, s2; int n0, n1, n2, G, c;
    __device__ __forceinline__ bool next(int i, U& u) const {
        const long L = (long)i * G + c; bool ok; int w;
        if (L < n0) { ok = s0.at(L, u); w = 0; } else if (L < n0 + n1) { ok = s1.at(L - n0, u); w = 1; } else if (L < n0 + n1 + n2) { ok = s2.at(L - n0 - n1, u); w = 2; } else return false;
        u.i3 = w; return ok;
    }
};

template <class Epi, class Sched, bool TWOSEG>
__device__ __forceinline__ void gemm_phase(LAS unsigned char* lds, const GP g, const Sched& S, const Epi& E) {
    int tid = threadIdx.x; asm volatile("" : "+v"(tid));
    const int wid = __builtin_amdgcn_readfirstlane(tid >> 6), lane = tid & 63, wr = wid >> 2, wc = wid & 3, fr = lane & 15, fq = lane >> 4;
    const int nt = g.nt;
    unsigned voffA[2], voffB[2];
#pragma unroll
    for (int i = 0; i < 2; ++i) { int R, C; stage_rc(tid * 16 + i * 8192, R, C); const int Rb = Epi::PERM ? ((R & ~31) + perm32(R & 31)) : R;
        voffA[i] = (unsigned)(R * g.lda + C) * 2u; voffB[i] = (unsigned)(Rb * g.ldb + C) * 2u; }
    const size_t hsA1 = (size_t)HALF * g.lda * 2, hsB1 = (size_t)HALF * g.ldb * 2;
    const unsigned ldsw = (unsigned)wid * 1024u;
    const int aoff = lds_byte(wr * 64 + fr, fq * 8), boff = lds_byte(wc * 32 + fr, fq * 8);
#define G_SA(b, h) (((b) * 2 + (h)) * HTB)
#define G_SB(b, h) ((4 + (b) * 2 + (h)) * HTB)
#define G_STAGE(bufoff, gbase, voff) do { _Pragma("unroll") for (int _i = 0; _i < 2; ++_i) \
        __builtin_amdgcn_global_load_lds((const unsigned*)((const char*)(gbase) + (voff)[_i]), (LAS unsigned*)(lds + (bufoff) + ldsw + _i * 8192), 16, 0, 0); } while (0)
#define G_LDA(dst, b, h) do { _Pragma("unroll") for (int m = 0; m < 4; ++m) _Pragma("unroll") for (int k = 0; k < 2; ++k) dst[m][k] = *(const LAS bf16x8*)(lds + G_SA(b, h) + aoff + m * 2048 + k * 1024); } while (0)
#define G_LDB(dst, b, h) do { _Pragma("unroll") for (int n = 0; n < 2; ++n) _Pragma("unroll") for (int k = 0; k < 2; ++k) dst[n][k] = *(const LAS bf16x8*)(lds + G_SB(b, h) + boff + n * 2048 + k * 1024); } while (0)
#define G_MMA(ai, bj, At, Bt) do { __builtin_amdgcn_s_setprio(1); _Pragma("unroll") for (int m = 0; m < 4; ++m) _Pragma("unroll") for (int n = 0; n < 2; ++n) _Pragma("unroll") for (int k = 0; k < 2; ++k) \
        acc[ai][bj][m][n] = __builtin_amdgcn_mfma_f32_16x16x32_bf16(Bt[n][k], At[m][k], acc[ai][bj][m][n], 0, 0, 0); __builtin_amdgcn_s_setprio(0); } while (0)
#define G_WAIT_V(n) asm volatile("s_waitcnt vmcnt(" #n ")" ::: "memory")
#define G_WAIT_L(n) asm volatile("s_waitcnt lgkmcnt(" #n ")" ::: "memory")
#define G_BAR __builtin_amdgcn_s_barrier()
#define G_SCHED __builtin_amdgcn_sched_barrier(0)
    U cur, nxt; int ui = 0;
    if (!S.next(0, cur)) return;
    f32x4 acc[2][2][4][2];
#pragma unroll
    for (int a = 0; a < 2; ++a)
#pragma unroll
        for (int b = 0; b < 2; ++b)
#pragma unroll
            for (int m = 0; m < 4; ++m)
#pragma unroll
                for (int n = 0; n < 2; ++n) acc[a][b][m][n] = (f32x4){0.f, 0.f, 0.f, 0.f};
    bf16x8 At[4][2], B0[2][2], B1[2][2];
    G_STAGE(G_SB(0, 0), cur.b1, voffB); G_STAGE(G_SA(0, 0), cur.a1, voffA); G_STAGE(G_SB(0, 1), cur.b1 + hsB1, voffB); G_STAGE(G_SA(0, 1), cur.a1 + hsA1, voffA);
    if (wr == 1) G_BAR;
    G_WAIT_V(4); G_BAR;
    G_STAGE(G_SB(1, 0), cur.b1 + 128, voffB); G_STAGE(G_SA(1, 0), cur.a1 + 128, voffA); G_STAGE(G_SB(1, 1), cur.b1 + hsB1 + 128, voffB);
    G_WAIT_V(6); G_BAR;
    for (;;) {
        const bool has_next = S.next(ui + 1, nxt);
        const char* nA = has_next ? nxt.a1 : cur.a1; const char* nB = has_next ? nxt.b1 : cur.b1;
        for (int t = 0; t < nt; t += 2) {
            const bool last = (t == nt - 2);
            const bool sg1 = TWOSEG && (t >= g.n1);
            const bool sg2 = TWOSEG && !last && (t + 2 >= g.n1);
            const char* a1 = sg1 ? cur.a2 + (size_t)(t + 1 - g.n1) * 128 : cur.a1 + (size_t)(t + 1) * 128;
            const char* a2 = last ? nA : (sg2 ? cur.a2 + (size_t)(t + 2 - g.n1) * 128 : cur.a1 + (size_t)(t + 2) * 128);
            const char* b2 = last ? nB : (sg2 ? cur.b2 + (size_t)(t + 2 - g.n1) * 128 : cur.b1 + (size_t)(t + 2) * 128);
            const char* a3 = a2 + 128; const char* b3 = b2 + 128;
            if (TWOSEG) { if (t == g.n1) E.mid(acc, cur, wr, wc, fr, fq); }
            G_LDB(B0, 0, 0); G_SCHED; G_LDA(At, 0, 0); G_STAGE(G_SA(1, 1), a1 + hsA1, voffA);
            G_WAIT_L(8); G_BAR; G_WAIT_L(0); G_MMA(0, 0, At, B0); G_BAR; G_SCHED;
            G_LDB(B1, 0, 1); G_STAGE(G_SB(0, 0), b2, voffB);
            G_BAR; G_WAIT_L(0); G_MMA(0, 1, At, B1); G_BAR;
            G_LDA(At, 0, 1); G_STAGE(G_SA(0, 0), a2, voffA);
            G_BAR; G_WAIT_L(0); G_MMA(1, 0, At, B0); G_BAR; G_SCHED;
            G_STAGE(G_SB(0, 1), b2 + hsB1, voffB);
            G_WAIT_V(6); G_BAR; G_MMA(1, 1, At, B1); G_BAR;
            G_LDB(B0, 1, 0); G_SCHED; G_LDA(At, 1, 0); G_STAGE(G_SA(0, 1), a2 + hsA1, voffA);
            G_WAIT_L(8); G_BAR; G_WAIT_L(0); G_MMA(0, 0, At, B0); G_BAR; G_SCHED;
            G_LDB(B1, 1, 1); G_STAGE(G_SB(1, 0), b3, voffB);
            G_BAR; G_WAIT_L(0); G_MMA(0, 1, At, B1); G_BAR;
            G_LDA(At, 1, 1); G_STAGE(G_SA(1, 0), a3, voffA);
            G_BAR; G_WAIT_L(0); G_MMA(1, 0, At, B0); G_BAR; G_SCHED;
            G_STAGE(G_SB(1, 1), b3 + hsB1, voffB);
            G_WAIT_V(6); G_BAR; G_MMA(1, 1, At, B1); G_BAR;
        }
        E(acc, cur, wr, wc, fr, fq);
        if (!has_next) break;
#pragma unroll
        for (int a = 0; a < 2; ++a)
#pragma unroll
            for (int b = 0; b < 2; ++b)
#pragma unroll
                for (int m = 0; m < 4; ++m)
#pragma unroll
                    for (int n = 0; n < 2; ++n) acc[a][b][m][n] = (f32x4){0.f, 0.f, 0.f, 0.f};
        cur = nxt; ++ui;
    }
    G_WAIT_V(0);
    if (wr == 0) G_BAR;
    G_BAR;
#undef G_SA
#undef G_SB
#undef G_STAGE
#undef G_LDA
#undef G_LDB
#undef G_MMA
#undef G_WAIT_V
#undef G_WAIT_L
#undef G_BAR
#undef G_SCHED
}
}

typedef f32x4 Acc[2][2][4][2];

struct EpiPlain {
    static constexpr bool PERM = true; bf16_t* base; long ldc;
    __device__ __forceinline__ void mid(Acc&, const gm::U&, int, int, int, int) const {}
    __device__ __forceinline__ void operator()(const Acc& acc, const gm::U& u, int wr, int wc, int fr_, int fq_) const {
        int fr = fr_, fq = fq_; asm volatile("" : "+v"(fr), "+v"(fq));
        bf16_t* d = base + u.co + (long)(wr * 64 + fr) * ldc + wc * 32 + 8 * fq;
#pragma unroll
        for (int ai = 0; ai < 2; ++ai)
#pragma unroll
            for (int m = 0; m < 4; ++m)
#pragma unroll
                for (int bj = 0; bj < 2; ++bj) *(u32x4*)(d + (long)(ai * 128 + m * 16) * ldc + bj * 128) = pack8(acc[ai][bj][m][0], acc[ai][bj][m][1]);
    }
};

template <int KIND> struct EpiQK {
    static constexpr bool PERM = true; bf16_t* Q; bf16_t* K; const int* pos; const float* ifq; bf16_t* qkh; bf16_t* kwt; const float* wkt; int pair;
    __device__ __forceinline__ void mid(Acc&, const gm::U&, int, int, int, int) const {}
    __device__ __forceinline__ void operator()(const Acc& acc, const gm::U& u, int wr, int wc, int fr_, int fq_) const {
        int fr = fr_, fq = fq_; asm volatile("" : "+v"(fr), "+v"(fq));
        const int pm = u.i0, pn = u.i1, d0 = wc * 32 + 8 * fq;
        bf16_t* dst = (pn < 2 ? Q : K) + (size_t)(pn & 1) * S_ * 256 + d0;
        if (KIND == 0) {
            const float sc = pn < 2 ? 1.0f : 0.0625f;
            const f32x4 f0 = *(const f32x4*)(ifq + d0), f1 = *(const f32x4*)(ifq + d0 + 4);
#pragma unroll
            for (int ai = 0; ai < 2; ++ai)
#pragma unroll
                for (int m = 0; m < 4; ++m) {
                    const int t = pm * 256 + ai * 128 + wr * 64 + m * 16 + fr; const float pf = (float)pos[t];
                    f32x4 o1[2], o2[2];
#pragma unroll
                    for (int n = 0; n < 2; ++n)
#pragma unroll
                        for (int e = 0; e < 4; ++e) {
                            const float ang = pf * (n ? f1[e] : f0[e]);
                            const double rev = (double)ang * 0.15915494309189535; const float fx = (float)(rev - __builtin_rint(rev));
                            const float sn = __builtin_amdgcn_sinf(fx), cs = __builtin_amdgcn_cosf(fx);
                            const float t1 = acc[ai][0][m][n][e], t2 = acc[ai][1][m][n][e];
                            o1[n][e] = (t1 * cs - t2 * sn) * sc; o2[n][e] = (t1 * sn + t2 * cs) * sc; }
                    *(u32x4*)(dst + (size_t)t * 256) = pack8(o1[0], o1[1]); *(u32x4*)(dst + (size_t)t * 256 + 128) = pack8(o2[0], o2[1]);
                    if (pn >= 2) {
                        const int h2 = pn & 1, tl = ai * 128 + wr * 64 + m * 16 + fr; const float wk = wkt[(size_t)(2 * pair + h2) * S_ + t];
                        bf16_t* kp = kwt + ((size_t)(h2 * 64 + pm) * 256 + d0) * 256 + tl;
#pragma unroll
                        for (int n = 0; n < 2; ++n)
#pragma unroll
                            for (int e = 0; e < 4; e += 2) { const unsigned w1 = cvt_pk_bf16(o1[n][e] * wk, o1[n][e + 1] * wk), w2 = cvt_pk_bf16(o2[n][e] * wk, o2[n][e + 1] * wk);
                                kp[(size_t)(4 * n + e) * 256] = (bf16_t)(w1 & 0xffffu); kp[(size_t)(4 * n + e + 1) * 256] = (bf16_t)(w1 >> 16);
                                kp[(size_t)(128 + 4 * n + e) * 256] = (bf16_t)(w2 & 0xffffu); kp[(size_t)(128 + 4 * n + e + 1) * 256] = (bf16_t)(w2 >> 16); } } }
        } else {
#pragma unroll
            for (int ai = 0; ai < 2; ++ai)
#pragma unroll
                for (int m = 0; m < 4; ++m) {
                    const int t = pm * 256 + ai * 128 + wr * 64 + m * 16 + fr;
#pragma unroll
                    for (int bj = 0; bj < 2; ++bj) { const u32x4 w = pack8(acc[ai][bj][m][0], acc[ai][bj][m][1]);
                        *(u32x4*)(dst + (size_t)t * 256 + bj * 128) = w;
                        if (m == 3 && fr >= 13) { const int gq = pm * 4 + ai * 2 + wr; *(u32x4*)(qkh + ((size_t)gq * 3 + (fr - 13)) * 1024 + pn * 256 + bj * 128 + d0) = w; } } }
        }
    }
};

template <bool PSUM> struct EpiS {
    static constexpr bool PERM = true; bf16_t* P; const float* RB; const float* CB; float* PS; int pair;
    __device__ __forceinline__ void mid(Acc&, const gm::U&, int, int, int, int) const {}
    __device__ __forceinline__ void operator()(const Acc& acc, const gm::U& u, int wr, int wc, int fr_, int fq_) const {
        int fr = fr_, fq = fq_; asm volatile("" : "+v"(fr), "+v"(fq));
        const int ch = u.i0, h2 = u.i1, h = 2 * pair + h2, c0 = wc * 32 + 8 * fq;
        const float* rb = RB + (size_t)h * S_ + ch * 256 + wr * 64 + fr; const float* cb = CB + (size_t)h * S_ + ch * 256 + c0;
        bf16_t* d = P + ((size_t)(h2 * 64 + ch) * 256 + wr * 64 + fr) * 256 + c0;
        float rbv[2][4], rs[2][4];
#pragma unroll
        for (int ai = 0; ai < 2; ++ai)
#pragma unroll
            for (int m = 0; m < 4; ++m) { rbv[ai][m] = rb[ai * 128 + m * 16]; rs[ai][m] = 0.f; }
#pragma unroll
        for (int bj = 0; bj < 2; ++bj)
#pragma unroll
            for (int n = 0; n < 2; ++n) {
                const f32x4 cbv = *(const f32x4*)(cb + bj * 128 + 4 * n);
#pragma unroll
                for (int ai = 0; ai < 2; ++ai)
#pragma unroll
                    for (int m = 0; m < 4; ++m) {
                        const int dij = (ai * 128 + wr * 64 + m * 16 + fr) - (bj * 128 + c0 + 4 * n);
                        f32x4 v;
#pragma unroll
                        for (int e = 0; e < 4; ++e) { const float w = (dij - e >= 0) ? acc[ai][bj][m][n][e] * __builtin_amdgcn_exp2f((rbv[ai][m] + cbv[e]) * 1.44269504f) : 0.f; v[e] = w; rs[ai][m] += w; }
                        u32x2 pk; pk.x = cvt_pk_bf16(v[0], v[1]); pk.y = cvt_pk_bf16(v[2], v[3]);
                        *(u32x2*)(d + (size_t)(ai * 128 + m * 16) * 256 + bj * 128 + 4 * n) = pk; }
            }
        if (PSUM) {
#pragma unroll
            for (int ai = 0; ai < 2; ++ai)
#pragma unroll
                for (int m = 0; m < 4; ++m) { float r = rs[ai][m]; r += __shfl_xor(r, 16); r += __shfl_xor(r, 32);
                    if (fq == 0) PS[((size_t)(ch * 256 + ai * 128 + wr * 64 + m * 16 + fr) * 4 + h) * 4 + wc] = r; } }
    }
};

template <bool STATS> struct EpiO {
    static constexpr bool PERM = true; bf16_t* Z; const float* XS; float* ST; int pair;
    __device__ __forceinline__ void mid(Acc& acc, const gm::U& u, int wr, int wc, int fr, int fq) const {
        const int ch = u.i0, h = 2 * pair + u.i1; const float* xs = XS + (size_t)h * S_ + ch * 256 + wr * 64 + fr;
#pragma unroll
        for (int ai = 0; ai < 2; ++ai)
#pragma unroll
            for (int m = 0; m < 4; ++m) { const float x = xs[ai * 128 + m * 16];
#pragma unroll
                for (int bj = 0; bj < 2; ++bj)
#pragma unroll
                    for (int n = 0; n < 2; ++n) acc[ai][bj][m][n] *= x; }
    }
    __device__ __forceinline__ void operator()(const Acc& acc, const gm::U& u, int wr, int wc, int fr_, int fq_) const {
        int fr = fr_, fq = fq_; asm volatile("" : "+v"(fr), "+v"(fq));
        const int ch = u.i0, h = 2 * pair + u.i1, nt2 = u.i2, c0 = wc * 32 + 8 * fq;
        bf16_t* d = Z + (size_t)(ch * 256) * 2048 + h * 512 + nt2 * 256 + c0;
#pragma unroll
        for (int ai = 0; ai < 2; ++ai)
#pragma unroll
            for (int m = 0; m < 4; ++m) {
                const int i = ai * 128 + wr * 64 + m * 16 + fr; float s = 0.f, q = 0.f;
#pragma unroll
                for (int bj = 0; bj < 2; ++bj) { *(u32x4*)(d + (size_t)i * 2048 + bj * 128) = pack8(acc[ai][bj][m][0], acc[ai][bj][m][1]);
                    if (STATS) {
#pragma unroll
                        for (int n = 0; n < 2; ++n)
#pragma unroll
                            for (int e = 0; e < 4; ++e) { const float v = acc[ai][bj][m][n][e]; s += v; q += v * v; } } }
                if (STATS) { s += __shfl_xor(s, 16); s += __shfl_xor(s, 32); q += __shfl_xor(q, 16); q += __shfl_xor(q, 32);
                    if (fq == 0) { float* st = ST + (((size_t)(ch * 256 + i) * 4 + h) * 8 + nt2 * 4 + wc) * 2; st[0] = s; st[1] = q; } } }
    }
};

template <int KIND> struct EpiG {
    static constexpr bool PERM = true; bf16_t* Z; float* ST; const float* gng; const float* PS; const float* XS; const float* DC; const float* EM; int pair;
    __device__ __forceinline__ void mid(Acc&, const gm::U&, int, int, int, int) const {}
    __device__ __forceinline__ void operator()(const Acc& acc, const gm::U& u, int wr, int wc, int fr_, int fq_) const {
        int fr = fr_, fq = fq_; asm volatile("" : "+v"(fr), "+v"(fq));
        const int pm = u.i0, pn = u.i1, h = 2 * pair + (pn >> 1), nt2 = pn & 1, c0 = wc * 32 + 8 * fq;
        const int colb = pair * 1024 + pn * 256 + c0;
        f32x4 gv[2][2];
        if (KIND == 0) {
#pragma unroll
            for (int bj = 0; bj < 2; ++bj)
#pragma unroll
                for (int n = 0; n < 2; ++n) gv[bj][n] = *(const f32x4*)(gng + colb + bj * 128 + 4 * n);
        }
#pragma unroll
        for (int ai = 0; ai < 2; ++ai)
#pragma unroll
            for (int m = 0; m < 4; ++m) {
                const int t = pm * 256 + ai * 128 + wr * 64 + m * 16 + fr;
                bf16_t* zp = Z + (size_t)t * 2048 + colb;
                if (KIND == 0) {
                    const f32x4* st = (const f32x4*)(ST + ((size_t)t * 4 + h) * 16);
                    const f32x4 a = st[0], b = st[1], c = st[2], d = st[3];
                    const float s = (a[0] + a[2]) + (b[0] + b[2]) + (c[0] + c[2]) + (d[0] + d[2]);
                    const float q = (a[1] + a[3]) + (b[1] + b[3]) + (c[1] + c[3]) + (d[1] + d[3]);
                    const float mu = s * (1.0f / 512.0f); const float var = fmaxf(q * (1.0f / 512.0f) - mu * mu, 0.f); const float rstd = rsqrtf(var + EPS);
#pragma unroll
                    for (int bj = 0; bj < 2; ++bj) { float y[8]; unpack8(*(const u32x4*)(zp + bj * 128), y); f32x4 o[2];
#pragma unroll
                        for (int n = 0; n < 2; ++n)
#pragma unroll
                            for (int e = 0; e < 4; ++e) o[n][e] = siluf(acc[ai][bj][m][n][e]) * (y[4 * n + e] - mu) * rstd * gv[bj][n][e];
                        *(u32x4*)(zp + bj * 128) = pack8(o[0], o[1]); }
                } else {
                    const f32x4 ps = *(const f32x4*)(PS + ((size_t)t * 4 + h) * 4);
                    const float den = (ps[0] + ps[1]) + (ps[2] + ps[3]) + XS[(size_t)h * S_ + t] * DC[(size_t)t * 4 + h];
                    const float inv = __builtin_amdgcn_rcpf(fmaxf(fabsf(den), EM[(size_t)h * S_ + t]));
                    float s = 0.f, q = 0.f;
#pragma unroll
                    for (int bj = 0; bj < 2; ++bj) { float y[8]; unpack8(*(const u32x4*)(zp + bj * 128), y); f32x4 o[2];
#pragma unroll
                        for (int n = 0; n < 2; ++n)
#pragma unroll
                            for (int e = 0; e < 4; ++e) { const float v = sigmf(acc[ai][bj][m][n][e]) * y[4 * n + e] * inv; o[n][e] = v; s += v; q += v * v; }
                        *(u32x4*)(zp + bj * 128) = pack8(o[0], o[1]); }
                    s += __shfl_xor(s, 16); s += __shfl_xor(s, 32); q += __shfl_xor(q, 16); q += __shfl_xor(q, 32);
                    if (fq == 0) { float* st = ST + (((size_t)t * 4 + h) * 8 + nt2 * 4 + wc) * 2; st[0] = s; st[1] = q; }
                }
            }
    }
};

struct EpiRes {
    static constexpr bool PERM = false; const float* base; float* out; const float* gate;
    __device__ __forceinline__ void mid(Acc&, const gm::U&, int, int, int, int) const {}
    __device__ __forceinline__ void operator()(const Acc& acc, const gm::U& u, int wr, int wc, int fr_, int fq_) const {
        int fr = fr_, fq = fq_; asm volatile("" : "+v"(fr), "+v"(fq));
        const int row0 = u.i0 * 256 + wr * 64 + fr, col0 = u.i1 * 256 + wc * 32 + 4 * fq;
        f32x4 gv[2][2];
#pragma unroll
        for (int bj = 0; bj < 2; ++bj)
#pragma unroll
            for (int n = 0; n < 2; ++n) gv[bj][n] = *(const f32x4*)(gate + col0 + bj * 128 + n * 16);
#pragma unroll
        for (int ai = 0; ai < 2; ++ai)
#pragma unroll
            for (int m = 0; m < 4; ++m) { const size_t ro = (size_t)(row0 + ai * 128 + m * 16) * 1024 + col0;
#pragma unroll
                for (int bj = 0; bj < 2; ++bj)
#pragma unroll
                    for (int n = 0; n < 2; ++n) { const size_t o = ro + bj * 128 + n * 16; const f32x4 b = *(const f32x4*)(base + o); *(f32x4*)(out + o) = b + gv[bj][n] * acc[ai][bj][m][n]; } }
    }
};

struct EpiUp {
    static constexpr bool PERM = true; bf16_t* act; bf16_t* fh; const float* cw; const float* cb;
    __device__ __forceinline__ void mid(Acc&, const gm::U&, int, int, int, int) const {}
    __device__ __forceinline__ void operator()(const Acc& acc, const gm::U& u, int wr, int wc, int fr_, int fq_) const {
        int fr = fr_, fq = fq_; asm volatile("" : "+v"(fr), "+v"(fq));
        const int pm = u.i0, pn = u.i1, c0 = wc * 32 + 8 * fq, lane = fq * 16 + fr;
        u32x2 pk0[2][4];
#pragma unroll
        for (int n = 0; n < 2; ++n) {
            f32x4 w0[2], w1[2], w2[2], bb[2];
#pragma unroll
            for (int bj = 0; bj < 2; ++bj) { const int chn = bj * DFF + pn * 128 + c0 + 4 * n;
                w0[bj] = *(const f32x4*)(cw + chn); w1[bj] = *(const f32x4*)(cw + 2 * DFF + chn); w2[bj] = *(const f32x4*)(cw + 4 * DFF + chn); bb[bj] = *(const f32x4*)(cb + chn); }
#pragma unroll
            for (int ai = 0; ai < 2; ++ai)
#pragma unroll
                for (int m = 0; m < 4; ++m) {
                    f32x4 uu[2];
#pragma unroll
                    for (int bj = 0; bj < 2; ++bj)
#pragma unroll
                        for (int e = 0; e < 4; ++e) {
                            const float cur = acc[ai][bj][m][n][e]; const float prv = acc[ai][bj][m > 0 ? m - 1 : 0][n][e];
                            const float mr = dpp_mirror(prv), mr2 = dpp_swap01(mr);
                            const float p1 = dpp_shr1(mr, cur), p2 = dpp_shr2(mr2, cur);
                            uu[bj][e] = bb[bj][e] + w0[bj][e] * p2 + w1[bj][e] * p1 + w2[bj][e] * cur; }
                    u32x2 pk; pk.x = cvt_pk_bf16(siluf(uu[0][0]) * uu[1][0], siluf(uu[0][1]) * uu[1][1]); pk.y = cvt_pk_bf16(siluf(uu[0][2]) * uu[1][2], siluf(uu[0][3]) * uu[1][3]);
                    if (n == 0) pk0[ai][m] = pk;
                    else { const int t = pm * 256 + ai * 128 + wr * 64 + m * 16 + fr; u32x4 w; w.x = pk0[ai][m].x; w.y = pk0[ai][m].y; w.z = pk.x; w.w = pk.y;
                        *(u32x4*)(act + (size_t)t * DFF + pn * 128 + c0) = w; }
                }
        }
#pragma unroll
        for (int ai = 0; ai < 2; ++ai) {
            const int gq = pm * 4 + ai * 2 + wr;
            if (fr >= 14) {
#pragma unroll
                for (int bj = 0; bj < 2; ++bj) *(u32x4*)(fh + ((size_t)gq * 4 + (fr - 14)) * (2 * DFF) + pn * 256 + bj * 128 + c0) = pack8(acc[ai][bj][3][0], acc[ai][bj][3][1]);
            }
            if (fr < 2) {
#pragma unroll
                for (int bj = 0; bj < 2; ++bj) *(u32x4*)(fh + ((size_t)gq * 4 + 2 + fr) * (2 * DFF) + pn * 256 + bj * 128 + c0) = pack8(acc[ai][bj][0][0], acc[ai][bj][0][1]);
            }
        }
    }
};

template <class E0, class E1, class E2> struct EpiMulti {
    static constexpr bool PERM = true; E0 e0; E1 e1; E2 e2;
    static_assert(E0::PERM && E1::PERM && E2::PERM, "mixed staging orders");
    __device__ __forceinline__ void mid(Acc&, const gm::U&, int, int, int, int) const {}
    __device__ __forceinline__ void operator()(const Acc& acc, const gm::U& u, int wr, int wc, int fr, int fq) const {
        if (u.i3 == 0) e0(acc, u, wr, wc, fr, fq); else if (u.i3 == 1) e1(acc, u, wr, wc, fr, fq); else e2(acc, u, wr, wc, fr, fq);
    }
};

struct SchedS { const char* Q; const char* K; int G, c;
    __device__ __forceinline__ bool next(int i, gm::U& u) const { const int L = i * G + c; if (L >= 128) return false; const int h2 = L & 1, ch = L >> 1;
        const size_t o = ((size_t)h2 * S_ + ch * 256) * 256 * 2; u.a1 = Q + o; u.b1 = K + o; u.a2 = u.a1; u.b2 = u.b1; u.co = 0; u.i0 = ch; u.i1 = h2; u.i2 = 0; u.i3 = 0; return true; } };
struct SchedKV { const char* VT; const char* KWT; int G, c;
    __device__ __forceinline__ bool next(int i, gm::U& u) const { const int L = i * G + c; if (L >= 256) return false; const int mt = L & 1, h2 = (L >> 1) & 1, ch = L >> 2;
        u.a1 = VT + ((size_t)(h2 * 64 + ch) * 512 + mt * 256) * 256 * 2; u.b1 = KWT + ((size_t)(h2 * 64 + ch) * 256) * 256 * 2; u.a2 = u.a1; u.b2 = u.b1;
        u.co = ((long)(h2 * 64 + ch) * 512 + mt * 256) * 256; u.i0 = ch; u.i1 = h2; u.i2 = mt; u.i3 = 0; return true; } };
struct SchedO { const char* Q; const char* KVT; const char* P; const char* VT; int G, c;
    __device__ __forceinline__ bool next(int i, gm::U& u) const { const int L = i * G + c; if (L >= 256) return false; const int nt2 = L & 1, h2 = (L >> 1) & 1, ch = L >> 2;
        u.a1 = Q + ((size_t)h2 * S_ + ch * 256) * 256 * 2; u.b1 = KVT + ((size_t)(h2 * 64 + ch) * 512 + nt2 * 256) * 256 * 2;
        u.a2 = P + ((size_t)(h2 * 64 + ch) * 65536) * 2; u.b2 = VT + ((size_t)(h2 * 64 + ch) * 512 + nt2 * 256) * 256 * 2;
        u.co = 0; u.i0 = ch; u.i1 = h2; u.i2 = nt2; u.i3 = 0; return true; } };

struct Frame { LAS unsigned char* lds; int G, bid, tid, wid, lane; };
__device__ __forceinline__ Frame fresh(const Frame& f) { Frame r = f; asm volatile("" : "+v"(r.tid)); r.lane = r.tid & 63; r.wid = __builtin_amdgcn_readfirstlane(r.tid >> 6); return r; }

struct TileD { const float* src; bf16_t* dst; int lds_, ldd; };
struct MixerTiles { const float* win; const float* wout; bf16_t* WIN; bf16_t* WOUT; int ldin;
    __device__ __forceinline__ TileD operator()(int u) const {
        if (u < 1536) { const int kt = u & 15, ct = u >> 4; return TileD{win + (size_t)kt * 64 * ldin + ct * 64, WIN + (size_t)ct * 64 * 1024 + kt * 64, ldin, 1024}; }
        const int v = u - 1536, kt = v & 31, ct = v >> 5; return TileD{wout + (size_t)kt * 64 * 1024 + ct * 64, WOUT + (size_t)ct * 64 * 2048 + kt * 64, 1024, 2048}; } };
struct FfnTiles { const float* wup; const float* wdn; bf16_t* WUP; bf16_t* WDN;
    __device__ __forceinline__ TileD operator()(int u) const {
        if (u < 1408) { const int kt = u & 15, ct = u >> 4, c0 = ct * 64;
            const int cc = c0 < DFF ? c0 : c0 - DFF; const int r0 = (cc >> 7) * 256 + (c0 < DFF ? 0 : 128) + (cc & 127);
            return TileD{wup + (size_t)kt * 64 * 5632 + c0, WUP + (size_t)r0 * 1024 + kt * 64, 5632, 1024}; }
        const int v = u - 1408, kt = v % 44, ct = v / 44; return TileD{wdn + (size_t)kt * 64 * 1024 + ct * 64, WDN + (size_t)ct * 64 * DFF + kt * 64, 1024, DFF}; } };
template <class TD> __device__ __forceinline__ void convert_tiles(const Frame& F, int ntiles, const TD& td) {
    LAS float* tile = (LAS float*)F.lds;
    const int tx = F.tid & 63, ty = F.tid >> 6, n = F.tid >> 3, kk = (F.tid & 7) * 8;
    for (int u0 = F.bid; u0 < ntiles; u0 += 4 * F.G) {
        float v[4][8];
#pragma unroll
        for (int j = 0; j < 4; ++j) { const int u = u0 + j * F.G; if (u < ntiles) { const TileD d = td(u);
#pragma unroll
                for (int i = 0; i < 8; ++i) v[j][i] = d.src[(size_t)(ty + 8 * i) * d.lds_ + tx]; } }
#pragma unroll
        for (int j = 0; j < 4; ++j) { if (u0 + j * F.G < ntiles) {
#pragma unroll
                for (int i = 0; i < 8; ++i) tile[j * 4160 + (ty + 8 * i) * 65 + tx] = v[j][i]; } }
        __syncthreads();
#pragma unroll
        for (int j = 0; j < 4; ++j) { const int u = u0 + j * F.G; if (u < ntiles) { const TileD d = td(u); const LAS float* t = tile + j * 4160;
                u32x4 w; w.x = cvt_pk_bf16(t[(kk + 0) * 65 + n], t[(kk + 1) * 65 + n]); w.y = cvt_pk_bf16(t[(kk + 2) * 65 + n], t[(kk + 3) * 65 + n]);
                w.z = cvt_pk_bf16(t[(kk + 4) * 65 + n], t[(kk + 5) * 65 + n]); w.w = cvt_pk_bf16(t[(kk + 6) * 65 + n], t[(kk + 7) * 65 + n]);
                *(u32x4*)(d.dst + (size_t)n * d.ldd + kk) = w; } }
        __syncthreads();
    }
}
__device__ __forceinline__ void convert_mixer_weights(const Frame& F, const Params& p, int layer) {
    const MixerTiles td{layer == 0 ? p.ret_w_in : p.ml_w_in, layer == 0 ? p.ret_w_out : p.ml_w_out, (bf16_t*)(p.ws + OFF_WIN), (bf16_t*)(p.ws + OFF_WOUT), layer == 0 ? 6144 : 6152};
    convert_tiles(F, 2048, td);
}
__device__ __forceinline__ void convert_ffn_weights(const Frame& F, const Params& p, int layer) {
    const FfnTiles td{p.up_w + (size_t)layer * 1024 * 5632, p.dn_w + (size_t)layer * 2816 * 1024, (bf16_t*)(p.ws + OFF_WUP), (bf16_t*)(p.ws + OFF_WDN)};
    convert_tiles(F, 2112, td);
}

__device__ __forceinline__ void prologue_phase(const Frame& F, const Params& p) {
    float* MOD = (float*)(p.ws + OFF_SM + SM_MOD);
    LAS float* red = (LAS float*)F.lds;
    for (int u = F.bid; u < 192; u += F.G) {
        const int l = u / 96, cgp = u % 96, cq = F.tid & 15, kg = F.tid >> 4;
        const float* w = p.ada_w + (size_t)l * 1024 * 6144 + cgp * 64 + cq * 4;
        f32x4 a = {0.f, 0.f, 0.f, 0.f};
#pragma unroll 8
        for (int k = kg * 32; k < kg * 32 + 32; ++k) { const float cv = p.c[k]; const float ca = siluf(cv); a += ca * *(const f32x4*)(w + (size_t)k * 6144); }
        __syncthreads();
#pragma unroll
        for (int e = 0; e < 4; ++e) red[kg * 64 + cq * 4 + e] = a[e];
        __syncthreads();
        if (F.tid < 64) { float s = 0.f; for (int k = 0; k < 32; ++k) s += red[k * 64 + F.tid]; MOD[l * 6144 + cgp * 64 + F.tid] = s + p.ada_b[l * 6144 + cgp * 64 + F.tid]; }
    }
    const int gt = F.bid * 512 + F.tid, gn = F.G * 512;
    if (gt < 128) ((float*)(p.ws + OFF_SM + SM_IFQ))[gt] = powf(10000.0f, -(float)(2 * gt) / 256.0f);
    float* RB = (float*)(p.ws + OFF_SM + SM_RB); float* CB = (float*)(p.ws + OFF_SM + SM_CB); float* XS = (float*)(p.ws + OFF_SM + SM_XS); float* WK = (float*)(p.ws + OFF_SM + SM_WK);
    for (int e = gt; e < 4 * S_; e += gn) { const int h = e >> 14, t = e & (S_ - 1), i = t & 255; const float lg = logf(1.0f - exp2f(-5.0f - (float)h));
        RB[e] = (float)i * lg; CB[e] = -(float)i * lg; XS[e] = expf((float)(i + 1) * lg); WK[e] = expf((float)(255 - i) * lg); }
    if (gt < 256) { const int h = gt >> 6; const float lg = logf(1.0f - exp2f(-5.0f - (float)h)); ((float*)(p.ws + OFF_SM + SM_SCP))[gt] = expf(256.0f * lg); ((float*)(p.ws + OFF_SM + SM_SCN))[gt] = 1.0f; }
}

template <bool GATES> __device__ __forceinline__ void norm_phase(const Frame& F, const Params& p, const float* xin, const float* g, const float* sh, const float* sc) {
    bf16_t* H = (bf16_t*)(p.ws + OFF_H);
    LAS float* wg = (LAS float*)F.lds;
    if (GATES) { __syncthreads(); for (int e = F.tid; e < 8192; e += 512) wg[e] = p.ml_w_in[(size_t)(e >> 3) * 6152 + 6144 + (e & 7)]; __syncthreads(); }
    float* LI = (float*)(p.ws + OFF_SM + SM_LI); float* LF = (float*)(p.ws + OFF_SM + SM_LF);
    f32x4 gv[4], scv[4], shv[4];
#pragma unroll
    for (int j = 0; j < 4; ++j) { const int c = F.lane * 4 + 256 * j; gv[j] = *(const f32x4*)(g + c); scv[j] = *(const f32x4*)(sc + c); shv[j] = *(const f32x4*)(sh + c); }
    for (int row0 = (F.bid * 8 + F.wid) * 4; row0 < S_; row0 += F.G * 8 * 4) {
        f32x4 xa[4][4];
#pragma unroll
        for (int rr = 0; rr < 4; ++rr)
#pragma unroll
            for (int j = 0; j < 4; ++j) xa[rr][j] = *(const f32x4*)(xin + (size_t)(row0 + rr) * 1024 + F.lane * 4 + 256 * j);
#pragma unroll
        for (int rr = 0; rr < 4; ++rr) {
        const int row = row0 + rr; f32x4 xv[4]; float ss = 0.f;
#pragma unroll
        for (int j = 0; j < 4; ++j) { xv[j] = xa[rr][j]; ss += xv[j][0] * xv[j][0] + xv[j][1] * xv[j][1] + xv[j][2] * xv[j][2] + xv[j][3] * xv[j][3]; }
        ss = wave_sum(ss); const float rstd = rsqrtf(ss * (1.0f / 1024.0f) + EPS);
        float gp[8];
        if (GATES) {
#pragma unroll
            for (int k = 0; k < 8; ++k) gp[k] = 0.f; }
#pragma unroll
        for (int j = 0; j < 4; ++j) { f32x4 hv;
#pragma unroll
            for (int e = 0; e < 4; ++e) hv[e] = xv[j][e] * rstd * gv[j][e] * (1.0f + scv[j][e]) + shv[j][e];
            u32x2 w; w.x = cvt_pk_bf16(hv[0], hv[1]); w.y = cvt_pk_bf16(hv[2], hv[3]);
            *(u32x2*)(H + (size_t)row * 1024 + F.lane * 4 + 256 * j) = w;
            if (GATES) {
#pragma unroll
                for (int e = 0; e < 4; ++e) { const LAS float* wr_ = wg + (F.lane * 4 + 256 * j + e) * 8;
#pragma unroll
                    for (int k = 0; k < 8; ++k) gp[k] += hv[e] * wr_[k]; } } }
        if (GATES) {
#pragma unroll
            for (int k = 0; k < 8; ++k) gp[k] = wave_sum(gp[k]);
            if (F.lane == 0) {
#pragma unroll
                for (int k = 0; k < 4; ++k) { LI[(size_t)row * 4 + k] = gp[k] + p.ml_bg[k]; const float v = gp[4 + k] + p.ml_bg[4 + k]; LF[(size_t)row * 4 + k] = fminf(v, 0.f) - log1pf(expf(-fabsf(v))); } } }
        }
    }
}

__device__ __forceinline__ void prep_a(const Frame& F, const Params& p) {
    const float* LI = (const float*)(p.ws + OFF_SM + SM_LI); const float* LF = (const float*)(p.ws + OFF_SM + SM_LF);
    float* GG = (float*)(p.ws + OFF_SM + SM_GG); float* CB = (float*)(p.ws + OFF_SM + SM_CB); float* PM = (float*)(p.ws + OFF_SM + SM_PM); float* WK = (float*)(p.ws + OFF_SM + SM_WK);
    float* GL = (float*)(p.ws + OFF_SM + SM_GL); float* ML = (float*)(p.ws + OFF_SM + SM_ML);
    for (int u = F.bid; u < 256 && F.wid == 0; u += F.G) {
        const int h = u >> 6, ch = u & 63, t0 = ch * 256 + F.lane * 4;
        float g[4], cb[4], pm[4]; float run = 0.f;
#pragma unroll
        for (int e = 0; e < 4; ++e) { run += LF[(size_t)(t0 + e) * 4 + h]; g[e] = run; }
        float incl = run;
        for (int o = 1; o < 64; o <<= 1) { const float v = __shfl_up(incl, o); if (F.lane >= o) incl += v; }
        const float excl = incl - run;
        float lm = -INFINITY;
#pragma unroll
        for (int e = 0; e < 4; ++e) { g[e] += excl; cb[e] = LI[(size_t)(t0 + e) * 4 + h] - g[e]; lm = fmaxf(lm, cb[e]); pm[e] = lm; }
        float im = lm;
        for (int o = 1; o < 64; o <<= 1) { const float v = __shfl_up(im, o); if (F.lane >= o) im = fmaxf(im, v); }
        float em = __shfl_up(im, 1); if (F.lane == 0) em = -INFINITY;
#pragma unroll
        for (int e = 0; e < 4; ++e) pm[e] = fmaxf(pm[e], em);
        const float gL = __shfl(g[3], 63), pml = __shfl(pm[3], 63);
#pragma unroll
        for (int e = 0; e < 4; ++e) { const size_t o = (size_t)h * S_ + t0 + e; GG[o] = g[e]; CB[o] = cb[e]; PM[o] = pm[e]; WK[o] = expf(cb[e] - pml); }
        if (F.lane == 0) { GL[u] = gL; ML[u] = gL + pml; }
    }
}
__device__ __forceinline__ void prep_b(const Frame& F, const Params& p) {
    const float* GG = (const float*)(p.ws + OFF_SM + SM_GG); const float* PM = (const float*)(p.ws + OFF_SM + SM_PM);
    const float* GL = (const float*)(p.ws + OFF_SM + SM_GL); const float* ML = (const float*)(p.ws + OFF_SM + SM_ML);
    float* RB = (float*)(p.ws + OFF_SM + SM_RB); float* XS = (float*)(p.ws + OFF_SM + SM_XS); float* EM = (float*)(p.ws + OFF_SM + SM_EM);
    float* SCP = (float*)(p.ws + OFF_SM + SM_SCP); float* SCN = (float*)(p.ws + OFF_SM + SM_SCN);
    for (int u = F.bid; u < 256 && F.wid == 0; u += F.G) {
        const int h = u >> 6, ch = u & 63;
        const float glv = GL[h * 64 + F.lane], mlv = ML[h * 64 + F.lane];
        float m = 0.f;
#pragma unroll 8
        for (int c2 = 0; c2 < 64; ++c2) { const float gl = __shfl(glv, c2), ml = __shfl(mlv, c2); if (c2 < ch) m = fmaxf(gl + m, ml); }
#pragma unroll
        for (int e = 0; e < 4; ++e) { const size_t o = (size_t)h * S_ + ch * 256 + F.lane * 4 + e; const float mx = fmaxf(m, PM[o]); RB[o] = -mx; XS[o] = expf(m - mx); EM[o] = expf(-(GG[o] + mx)); }
        if (F.lane == 0) { const float mn = fmaxf(GL[u] + m, ML[u]); SCP[u] = expf(GL[u] + m - mn); SCN[u] = expf(ML[u] - mn); }
    }
}

template <int KIND> __device__ __forceinline__ void r3_pass(const Frame& F, const Params& p, int pair) {
    bf16_t* Qb = (bf16_t*)(p.ws + OFF_Q); bf16_t* Kb = (bf16_t*)(p.ws + OFF_K); bf16_t* KWT = (bf16_t*)(p.ws + OFF_KWT);
    const bf16_t* QKH = (const bf16_t*)(p.ws + OFF_SM + SM_QKH); const float* WK = (const float*)(p.ws + OFF_SM + SM_WK); float* NLOC = (float*)(p.ws + OFF_SM + SM_NLOC);
    LAS bf16_t* T = (LAS bf16_t*)F.lds;
    const int tr = F.tid >> 3, tc = (F.tid & 7) * 8;
    for (int u = F.bid; u < 1024; u += F.G) {
        const int ch = u >> 4, pc0 = (u & 15) * 64; const bool isk = pc0 >= 512;
        if (KIND == 0 && !isk) continue;
        const int bc0 = pc0 & 511, h2 = bc0 >> 8, h = 2 * pair + h2;
        bf16_t* buf = (isk ? Kb : Qb) + (size_t)h2 * S_ * 256 + (bc0 & 255) + tc;
        float cw[4][8], cbias[8];
        if (KIND == 1) { const int gc = (isk ? 1024 : 0) + pair * 512 + bc0 + tc;
#pragma unroll
            for (int j = 0; j < 4; ++j) { const f32x4 a = *(const f32x4*)(p.ml_cw + j * 2048 + gc), b = *(const f32x4*)(p.ml_cw + j * 2048 + gc + 4);
#pragma unroll
                for (int e = 0; e < 4; ++e) { cw[j][e] = a[e]; cw[j][4 + e] = b[e]; } }
            const f32x4 a = *(const f32x4*)(p.ml_cb + gc), b = *(const f32x4*)(p.ml_cb + gc + 4);
#pragma unroll
            for (int e = 0; e < 4; ++e) { cbias[e] = a[e]; cbias[4 + e] = b[e]; } }
        float nsum = 0.f;
        u32x4 nx[4]; float wkn = 0.f;
#define R3_LOAD(dst, s_) do { const int t_ = ch * 256 + (s_) * 64 + tr; dst[0] = *(const u32x4*)(buf + (size_t)t_ * 256); \
            if (KIND == 1) { _Pragma("unroll") for (int d = 1; d <= 3; ++d) { const int tt = t_ - d; u32x4 w_ = {0u, 0u, 0u, 0u}; \
                if (tr - d >= 0) w_ = *(const u32x4*)(buf + (size_t)tt * 256); \
                else if (tt >= 0) w_ = *(const u32x4*)(QKH + ((size_t)(tt >> 6) * 3 + ((tt & 63) - 61)) * 1024 + pc0 + tc); \
                dst[d] = w_; } } } while (0)
        R3_LOAD(nx, 0); if (isk) wkn = WK[(size_t)h * S_ + ch * 256 + tr];
        for (int s = 0; s < 4; ++s) {
            const int t = ch * 256 + s * 64 + tr;
            u32x4 cu[4];
#pragma unroll
            for (int d = 0; d < 4; ++d) cu[d] = nx[d];
            const float wk = wkn;
            if (s < 3) { R3_LOAD(nx, s + 1); if (isk) wkn = WK[(size_t)h * S_ + t + 64]; }
            float v[8]; unpack8(cu[0], v);
            if (KIND == 1) {
                float o[8];
#pragma unroll
                for (int e = 0; e < 8; ++e) o[e] = cbias[e] + cw[3][e] * v[e];
#pragma unroll
                for (int d = 1; d <= 3; ++d) { float x[8]; unpack8(cu[d], x);
#pragma unroll
                    for (int e = 0; e < 8; ++e) o[e] += cw[3 - d][e] * x[e]; }
#pragma unroll
                for (int e = 0; e < 8; ++e) { v[e] = siluf(o[e]); if (isk) v[e] *= 0.0625f; }
                __syncthreads();
                u32x4 w; w.x = cvt_pk_bf16(v[0], v[1]); w.y = cvt_pk_bf16(v[2], v[3]); w.z = cvt_pk_bf16(v[4], v[5]); w.w = cvt_pk_bf16(v[6], v[7]);
                *(u32x4*)(buf + (size_t)t * 256) = w;
            }
            if (isk) {
#pragma unroll
                for (int e = 0; e < 8; e += 2) { const unsigned w = cvt_pk_bf16(v[e] * wk, v[e + 1] * wk); T[(tc + e) * 72 + tr] = (bf16_t)(w & 0xffffu); T[(tc + e + 1) * 72 + tr] = (bf16_t)(w >> 16); }
                __syncthreads();
                const int col = F.tid >> 3, seg = F.tid & 7;
                const u32x4 w = *(const LAS u32x4*)(T + col * 72 + seg * 8);
                *(u32x4*)(KWT + ((size_t)(h2 * 64 + ch) * 256 + (bc0 & 255) + col) * 256 + s * 64 + seg * 8) = w;
                float x[8]; unpack8(w, x); nsum += ((x[0] + x[1]) + (x[2] + x[3])) + ((x[4] + x[5]) + (x[6] + x[7]));
                __syncthreads();
            }
        }
#undef R3_LOAD
        if (KIND == 1 && isk) { nsum += __shfl_xor(nsum, 1); nsum += __shfl_xor(nsum, 2); nsum += __shfl_xor(nsum, 4);
            if ((F.tid & 7) == 0) NLOC[((size_t)h * 64 + ch) * 256 + (bc0 & 255) + (F.tid >> 3)] = nsum; }
    }
}

template <int KIND> __device__ __forceinline__ void scan_phase(const Frame& F, const Params& p, int pair) {
    unsigned* KV = (unsigned*)(p.ws + OFF_KVT);
    const float* SCP = (const float*)(p.ws + OFF_SM + SM_SCP); const float* SCN = (const float*)(p.ws + OFF_SM + SM_SCN);
    for (int e0 = F.bid * 512; e0 < 131072; e0 += F.G * 512) {
        const int h2 = e0 >> 16, h = 2 * pair + h2; unsigned* base = KV + (size_t)h2 * 64 * 65536 + (e0 & 65535) + F.tid;
        float s0 = 0.f, s1 = 0.f;
#pragma unroll 1
        for (int cb = 0; cb < 64; cb += 64) {
            unsigned v[64];
#pragma unroll
            for (int c = 0; c < 64; ++c) v[c] = base[(size_t)(cb + c) * 65536];
#pragma unroll
            for (int c = 0; c < 64; ++c) { base[(size_t)(cb + c) * 65536] = cvt_pk_bf16(s0, s1); const float a = SCP[h * 64 + cb + c], b = SCN[h * 64 + cb + c]; s0 = a * s0 + b * bf_lo(v[c]); s1 = a * s1 + b * bf_hi(v[c]); }
        }
    }
    if (KIND == 1) {
        const float* NLOC = (const float*)(p.ws + OFF_SM + SM_NLOC); const bf16_t* Qb = (const bf16_t*)(p.ws + OFF_Q); float* DC = (float*)(p.ws + OFF_SM + SM_DC);
        LAS float* nv = (LAS float*)F.lds;
        for (int u = F.bid; u < 256; u += F.G) {
            const int h2 = u & 1, hv = (u >> 1) & 1, ch = u >> 2, h = 2 * pair + h2;
            __syncthreads();
            if (F.tid < 256) { float n = 0.f;
#pragma unroll 1
                for (int cb = 0; cb < 64; cb += 16) { if (cb >= ch) break; float x[16];
#pragma unroll
                    for (int c = 0; c < 16; ++c) x[c] = (cb + c < ch) ? NLOC[((size_t)h * 64 + cb + c) * 256 + F.tid] : 0.f;
#pragma unroll
                    for (int c = 0; c < 16; ++c) if (cb + c < ch) n = SCP[h * 64 + cb + c] * n + SCN[h * 64 + cb + c] * x[c]; }
                nv[F.tid] = n; }
            __syncthreads();
            const f32x4 nn = *(const LAS f32x4*)(nv + F.lane * 4);
#pragma unroll 1
            for (int r0 = 0; r0 < 16; r0 += 8) { const int t0 = ch * 256 + hv * 128 + F.wid * 16 + r0; u32x2 w[8];
#pragma unroll
                for (int r = 0; r < 8; ++r) w[r] = *(const u32x2*)(Qb + ((size_t)h2 * S_ + t0 + r) * 256 + F.lane * 4);
#pragma unroll
                for (int r = 0; r < 8; ++r) { float d = bf_lo(w[r].x) * nn[0] + bf_hi(w[r].x) * nn[1] + bf_lo(w[r].y) * nn[2] + bf_hi(w[r].y) * nn[3];
                    d = wave_sum(d); if (F.lane == 0) DC[(size_t)(t0 + r) * 4 + h] = d; } }
        }
    }
}

__device__ __forceinline__ void gn_pass(const Frame& F, const Params& p) {
    bf16_t* Z = (bf16_t*)(p.ws + OFF_Z); const float* ST = (const float*)(p.ws + OFF_SM + SM_ST);
    for (int u0 = (F.bid * 8 + F.wid) * 4; u0 < S_ * 4; u0 += F.G * 8 * 4) {
        f32x4 st[4][4]; u32x4 zz[4]; f32x4 g0[4], g1[4];
#pragma unroll
        for (int j = 0; j < 4; ++j) { const int u = u0 + j; const f32x4* sp = (const f32x4*)(ST + (size_t)u * 16);
            st[j][0] = sp[0]; st[j][1] = sp[1]; st[j][2] = sp[2]; st[j][3] = sp[3];
            zz[j] = *(const u32x4*)(Z + (size_t)(u >> 2) * 2048 + (u & 3) * 512 + F.lane * 8);
            g0[j] = *(const f32x4*)(p.ml_gn + (u & 3) * 512 + F.lane * 8); g1[j] = *(const f32x4*)(p.ml_gn + (u & 3) * 512 + F.lane * 8 + 4); }
#pragma unroll
        for (int j = 0; j < 4; ++j) { const int u = u0 + j; const f32x4 a = st[j][0], b = st[j][1], c = st[j][2], d = st[j][3];
            const float s = (a[0] + a[2]) + (b[0] + b[2]) + (c[0] + c[2]) + (d[0] + d[2]), q = (a[1] + a[3]) + (b[1] + b[3]) + (c[1] + c[3]) + (d[1] + d[3]);
            const float mu = s * (1.0f / 512.0f), rstd = rsqrtf(fmaxf(q * (1.0f / 512.0f) - mu * mu, 0.f) + EPS);
            float y[8]; unpack8(zz[j], y); f32x4 o0, o1;
#pragma unroll
            for (int e = 0; e < 4; ++e) { o0[e] = (y[e] - mu) * rstd * g0[j][e]; o1[e] = (y[4 + e] - mu) * rstd * g1[j][e]; }
            *(u32x4*)(Z + (size_t)(u >> 2) * 2048 + (u & 3) * 512 + F.lane * 8) = pack8(o0, o1); }
    }
}

__device__ __forceinline__ void ffn_fix_panel(const Frame& F, const Params& p, int layer, int pm) {
    const bf16_t* FH = (const bf16_t*)(p.ws + OFF_FH); bf16_t* ACT = (bf16_t*)(p.ws + OFF_ACT);
    const float* cw = p.fcw + (size_t)layer * 3 * 5632; const float* cb = p.fcb + (size_t)layer * 5632;
    if (F.tid < 352) {
        const int chn = F.tid * 8, pn = chn >> 7, cc = chn & 127;
        f32x4 bq[2][2], a0[2][2], a1[2][2], a2[2][2];
#pragma unroll
        for (int bj = 0; bj < 2; ++bj)
#pragma unroll
            for (int v = 0; v < 2; ++v) { const int wch = bj * DFF + chn + 4 * v;
                bq[bj][v] = *(const f32x4*)(cb + wch); a0[bj][v] = *(const f32x4*)(cw + wch); a1[bj][v] = *(const f32x4*)(cw + 5632 + wch); a2[bj][v] = *(const f32x4*)(cw + 2 * 5632 + wch); }
#pragma unroll 1
        for (int gb = 0; gb < 2; ++gb) {
            u32x4 h[2][2][4];
#pragma unroll
            for (int gi = 0; gi < 2; ++gi) { const int gq = pm * 4 + gb * 2 + gi;
#pragma unroll
                for (int bj = 0; bj < 2; ++bj) { const int col = pn * 256 + bj * 128 + cc; const u32x4 z = {0u, 0u, 0u, 0u};
                    h[gi][bj][0] = gq > 0 ? *(const u32x4*)(FH + ((size_t)(gq - 1) * 4 + 0) * 5632 + col) : z;
                    h[gi][bj][1] = gq > 0 ? *(const u32x4*)(FH + ((size_t)(gq - 1) * 4 + 1) * 5632 + col) : z;
                    h[gi][bj][2] = *(const u32x4*)(FH + ((size_t)gq * 4 + 2) * 5632 + col);
                    h[gi][bj][3] = *(const u32x4*)(FH + ((size_t)gq * 4 + 3) * 5632 + col); } }
#pragma unroll
            for (int gi = 0; gi < 2; ++gi) { const int gq = pm * 4 + gb * 2 + gi;
#pragma unroll
                for (int r = 0; r < 2; ++r) {
                    float ua[8], ub[8];
#pragma unroll
                    for (int bj = 0; bj < 2; ++bj) { float* uo = bj ? ub : ua; float x0[8], x1[8], x2[8];
                        unpack8(h[gi][bj][r], x0); unpack8(h[gi][bj][r + 1], x1); unpack8(h[gi][bj][r + 2], x2);
#pragma unroll
                        for (int v = 0; v < 2; ++v)
#pragma unroll
                            for (int e = 0; e < 4; ++e) uo[4 * v + e] = bq[bj][v][e] + a0[bj][v][e] * x0[4 * v + e] + a1[bj][v][e] * x1[4 * v + e] + a2[bj][v][e] * x2[4 * v + e]; }
                    f32x4 o0, o1;
#pragma unroll
                    for (int e = 0; e < 4; ++e) { o0[e] = siluf(ua[e]) * ub[e]; o1[e] = siluf(ua[4 + e]) * ub[4 + e]; }
                    *(u32x4*)(ACT + (size_t)(gq * 64 + r) * DFF + chn) = pack8(o0, o1); } }
        }
    }
}

__device__ __forceinline__ void final_norm(const Frame& F, const Params& p) {
    f32x4 g[4];
#pragma unroll
    for (int j = 0; j < 4; ++j) g[j] = *(const f32x4*)(p.fin_g + F.lane * 4 + 256 * j);
    for (int row0 = (F.bid * 8 + F.wid) * 8; row0 < S_; row0 += F.G * 8 * 8) {
        f32x4 xa[8][4];
#pragma unroll
        for (int rr = 0; rr < 8; ++rr)
#pragma unroll
            for (int j = 0; j < 4; ++j) xa[rr][j] = *(const f32x4*)(p.out + (size_t)(row0 + rr) * 1024 + F.lane * 4 + 256 * j);
#pragma unroll
        for (int rr = 0; rr < 8; ++rr) { float ss = 0.f;
#pragma unroll
            for (int j = 0; j < 4; ++j) ss += xa[rr][j][0] * xa[rr][j][0] + xa[rr][j][1] * xa[rr][j][1] + xa[rr][j][2] * xa[rr][j][2] + xa[rr][j][3] * xa[rr][j][3];
            ss = wave_sum(ss); const float rstd = rsqrtf(ss * (1.0f / 1024.0f) + EPS);
#pragma unroll
            for (int j = 0; j < 4; ++j) *(f32x4*)(p.out + (size_t)(row0 + rr) * 1024 + F.lane * 4 + 256 * j) = xa[rr][j] * rstd * g[j]; }
    }
}

#define XB_TMO      128
#define XB_XCNT(j)  (256  + 64 * (j))
#define XB_XSUB(j)  (1280 + 64 * (j))
#define XB_XGEN(j)  (2304 + 64 * (j))
#define XB_TOP      3328
#define XB_TOPGEN   3392
#define XCD_BAR_WORDS 3456
#define XB_SPIN_CAP (1u << 18)
__device__ __forceinline__ unsigned xb_ld(unsigned* p)              { return __hip_atomic_load(p, __ATOMIC_RELAXED, __HIP_MEMORY_SCOPE_AGENT); }
__device__ __forceinline__ unsigned xb_add(unsigned* p, unsigned v) { return __hip_atomic_fetch_add(p, v, __ATOMIC_RELAXED, __HIP_MEMORY_SCOPE_AGENT); }
__device__ __forceinline__ unsigned xb_xcc_id() { return (unsigned)__builtin_amdgcn_s_getreg((3 << 11) | 20) & 0xFu; }
#define XB_SPIN(cond, bar) do { unsigned _sp = 0; while (cond) { __builtin_amdgcn_s_sleep(1); \
    if ((++_sp & 255u) == 0u) { if (xb_ld(&(bar)[XB_TMO])) break; if (_sp > XB_SPIN_CAP) { atomicAdd(&(bar)[XB_TMO], 1u); break; } } } } while (0)
struct XcdBarrier { unsigned* bar; unsigned x; volatile LAS unsigned* st; };
__device__ __forceinline__ XcdBarrier xcd_barrier_post(unsigned* bar, volatile LAS unsigned* st) {
    XcdBarrier b; b.bar = bar; b.x = xb_xcc_id(); b.st = st;
    if (threadIdx.x == 0) (void)xb_add(&bar[XB_XCNT(b.x)], 1u);
    return b;
}
__device__ __forceinline__ void xcd_barrier_complete(unsigned* bar, unsigned x, unsigned& nloc, unsigned& nx) {
    const unsigned G = gridDim.x * gridDim.y * gridDim.z;
    unsigned sum, cnt, mine, sp = 0u;
    for (;;) {
        sum = 0u; cnt = 0u; mine = 0u;
#pragma unroll
        for (unsigned j = 0; j < 16; ++j) { const unsigned c = xb_ld(&bar[XB_XCNT(j)]); sum += c; cnt += (c > 0u) ? 1u : 0u; mine = (j == x) ? c : mine; }
        if (sum == G) break;
        __builtin_amdgcn_s_sleep(1);
        if ((++sp & 255u) == 0u) { if (xb_ld(&bar[XB_TMO])) break; if (sp > XB_SPIN_CAP) { atomicAdd(&bar[XB_TMO], 1u); break; } }
    }
    nloc = mine > 0u ? mine : 1u; nx = cnt > 0u ? cnt : 1u;
}
__device__ __forceinline__ void xcd_barrier(const XcdBarrier& b) {
    asm volatile("s_waitcnt vmcnt(0)" ::: "memory");
    __syncthreads();
    if (threadIdx.x == 0) {
        unsigned* bar = b.bar;
        __builtin_amdgcn_s_waitcnt(0);
        unsigned nloc = b.st[0], nx = b.st[1];
        if (nloc == 0u) { xcd_barrier_complete(bar, b.x, nloc, nx); b.st[0] = nloc; b.st[1] = nx; }
        const unsigned old = xb_add(&bar[XB_XSUB(b.x)], 1u);
        const unsigned gen = old / nloc;
        if (old + 1u == (gen + 1u) * nloc) {
            __builtin_amdgcn_fence(__ATOMIC_RELEASE, "agent");
            asm volatile("s_waitcnt vmcnt(0)" ::: "memory");
            const unsigned og = xb_add(&bar[XB_TOP], 1u);
            const unsigned tg = og / nx;
            if (og + 1u == (tg + 1u) * nx) xb_add(&bar[XB_TOPGEN], 1u);
            else XB_SPIN(xb_ld(&bar[XB_TOPGEN]) == tg, bar);
            __builtin_amdgcn_fence(__ATOMIC_ACQUIRE, "agent");
            asm volatile("s_waitcnt vmcnt(0)" ::: "memory");
        } else {
            XB_SPIN(xb_ld(&bar[XB_TOPGEN]) == gen, bar);
            __builtin_amdgcn_fence(__ATOMIC_ACQUIRE, "agent");
            asm volatile("s_waitcnt vmcnt(0)" ::: "memory");
        }
    }
    __syncthreads();
}

constexpr int N_PHASES = 33;
#ifdef ONLY_PH
#define PH_ON(k) ((k) == ONLY_PH)
#else
#define PH_ON(k) (p.ph_lo <= (k) && (k) < p.ph_hi)
#endif
#ifndef PROBE_CAT
#define PROBE_CAT 0
#endif
#if PROBE_CAT
#define RT() __builtin_amdgcn_s_memrealtime()
#define PH_END(k) do { if ((k) + 1 < p.ph_hi) { __syncthreads(); const unsigned long long t0_ = RT(); xcd_barrier(xbar); if (PROBE_CAT == 2) tprobe += RT() - t0_; } } while (0)
#define GT0 const unsigned long long tg0_ = RT();
#define GT1(c) if (PROBE_CAT == 1 || PROBE_CAT == (c)) tprobe += RT() - tg0_;
#else
#define PH_END(k) do { if ((k) + 1 < p.ph_hi) xcd_barrier(xbar); } while (0)
#define GT0
#define GT1(c)
#endif

typedef gm::SchedPlain SP;
template <int KIND> __device__ __forceinline__ SP sched_qk(const Frame& F, const Params& p, int pair) {
    const char* H = (const char*)(p.ws + OFF_H); const char* WIN = (const char*)(p.ws + OFF_WIN);
    return SP{H, WIN + (size_t)(pair * 512) * 2048, WIN + (size_t)(1024 + pair * 512) * 2048, 64, 4, 2, F.G, F.bid, (size_t)256 * 2048, (size_t)256 * 2048, 256, 0}; }
__device__ __forceinline__ SP sched_vt(const Frame& F, const Params& p, int pair) {
    const char* H = (const char*)(p.ws + OFF_H); const char* WIN = (const char*)(p.ws + OFF_WIN);
    return SP{WIN + (size_t)(2048 + pair * 1024) * 2048, H, H, 4, 64, 64, F.G, F.bid, (size_t)256 * 2048, (size_t)256 * 2048, 256, 1}; }
__device__ __forceinline__ SP sched_g(const Frame& F, const Params& p, int pair) {
    const char* H = (const char*)(p.ws + OFF_H); const char* WIN = (const char*)(p.ws + OFF_WIN);
    return SP{H, WIN + (size_t)(4096 + pair * 1024) * 2048, WIN, 64, 4, 4, F.G, F.bid, (size_t)256 * 2048, (size_t)256 * 2048, 2048, 0}; }
template <int KIND> __device__ __forceinline__ EpiQK<KIND> epi_qk(const Params& p, int pair) {
    return EpiQK<KIND>{(bf16_t*)(p.ws + OFF_Q), (bf16_t*)(p.ws + OFF_K), p.pos, (const float*)(p.ws + OFF_SM + SM_IFQ), (bf16_t*)(p.ws + OFF_SM + SM_QKH), (bf16_t*)(p.ws + OFF_KWT), (const float*)(p.ws + OFF_SM + SM_WK), pair}; }
template <int KIND> __device__ __forceinline__ EpiG<KIND> epi_g(const Params& p, int pair) {
    return EpiG<KIND>{(bf16_t*)(p.ws + OFF_Z), (float*)(p.ws + OFF_SM + SM_ST), KIND == 0 ? p.ret_gn : p.ml_gn, (const float*)(p.ws + OFF_SM + SM_PS), (const float*)(p.ws + OFF_SM + SM_XS),
                      (const float*)(p.ws + OFF_SM + SM_DC), (const float*)(p.ws + OFF_SM + SM_EM), pair}; }

template <int KIND, int PAIR> __device__ __forceinline__ void pair_core(const Frame& F0, const Params& p, const XcdBarrier& xbar, int base, unsigned long long& tprobe) {
    unsigned char* ws = p.ws; constexpr int pair = PAIR; constexpr int R = (KIND == 1) ? 1 : 0;
    if (KIND == 1) { if (PH_ON(base + 0)) { const Frame F = fresh(F0);
        if (pair == 0) prep_b(F, p);
        { GT0 r3_pass<KIND>(F, p, pair); GT1(9) }
        PH_END(base + 0); } }
    if (PH_ON(base + R)) { const Frame F = fresh(F0);
        { SchedKV S{(const char*)(ws + OFF_VT), (const char*)(ws + OFF_KWT), F.G, F.bid}; EpiPlain E{(bf16_t*)(ws + OFF_KVT), 256};
          { GT0 gm::gemm_phase<EpiPlain, SchedKV, false>(F.lds, gm::GP{256, 256, 4, 4}, S, E); GT1(5) } }
        { SchedS S{(const char*)(ws + OFF_Q), (const char*)(ws + OFF_K), F.G, (F.bid + 128) % F.G};
          EpiS<KIND == 1> E{(bf16_t*)(ws + OFF_P), (const float*)(ws + OFF_SM + SM_RB), (const float*)(ws + OFF_SM + SM_CB), (float*)(ws + OFF_SM + SM_PS), pair};
          { GT0 gm::gemm_phase<EpiS<KIND == 1>, SchedS, false>(F.lds, gm::GP{256, 256, 4, 4}, S, E); GT1(5) } }
        PH_END(base + R); }
    if (PH_ON(base + R + 1)) { const Frame F = fresh(F0); { GT0 scan_phase<KIND>(F, p, pair); GT1(10) } PH_END(base + R + 1); }
    if (PH_ON(base + R + 2)) { const Frame F = fresh(F0);
        SchedO S{(const char*)(ws + OFF_Q), (const char*)(ws + OFF_KVT), (const char*)(ws + OFF_P), (const char*)(ws + OFF_VT), F.G, F.bid};
        EpiO<KIND == 0> E{(bf16_t*)(ws + OFF_Z), (const float*)(ws + OFF_SM + SM_XS), (float*)(ws + OFF_SM + SM_ST), pair};
        { GT0 gm::gemm_phase<EpiO<KIND == 0>, SchedO, true>(F.lds, gm::GP{256, 256, 4, 8}, S, E); GT1(5) }
        PH_END(base + R + 2); }
}

template <int KIND> __device__ __forceinline__ void layer_program(const Frame& F0, const Params& p, const XcdBarrier& xbar, int base, unsigned long long& tprobe) {
    constexpr int layer = KIND;
    unsigned char* ws = p.ws; const float* MOD = (const float*)(ws + OFF_SM + SM_MOD) + layer * 6144;
    const char* H = (const char*)(ws + OFF_H);
    if (PH_ON(base)) { const Frame F = fresh(F0);
        { GT0 convert_mixer_weights(F, p, layer); GT1(7) }
        { GT0 norm_phase<KIND == 1>(F, p, layer == 0 ? p.x : p.out, p.ntg + layer * 1024, MOD, MOD + 1024); GT1(8) }
        PH_END(base); }
    if (PH_ON(base + 1)) { const Frame F = fresh(F0);
        gm::SchedMulti S{sched_qk<KIND>(F, p, 0), sched_vt(F, p, 0), sched_vt(F, p, 0), 256, 256, 0, F.G, F.bid};
        EpiMulti<EpiQK<KIND>, EpiPlain, EpiPlain> E{epi_qk<KIND>(p, 0), EpiPlain{(bf16_t*)(ws + OFF_VT), 256}, EpiPlain{(bf16_t*)(ws + OFF_VT), 256}};
        { GT0 gm::gemm_phase<EpiMulti<EpiQK<KIND>, EpiPlain, EpiPlain>, gm::SchedMulti, false>(F.lds, gm::GP{1024, 1024, 16, 16}, S, E); GT1(4) }
        if (KIND == 1) prep_a(F, p);
        PH_END(base + 1); }
    constexpr int PC = (KIND == 1) ? 4 : 3;
    pair_core<KIND, 0>(F0, p, xbar, base + 2, tprobe);
    if (PH_ON(base + 2 + PC)) { const Frame F = fresh(F0);
        gm::SchedMulti S{sched_g(F, p, 0), sched_qk<KIND>(F, p, 1), sched_vt(F, p, 1), 256, 256, 256, F.G, F.bid};
        EpiMulti<EpiG<KIND>, EpiQK<KIND>, EpiPlain> E{epi_g<KIND>(p, 0), epi_qk<KIND>(p, 1), EpiPlain{(bf16_t*)(ws + OFF_VT), 256}};
        { GT0 gm::gemm_phase<EpiMulti<EpiG<KIND>, EpiQK<KIND>, EpiPlain>, gm::SchedMulti, false>(F.lds, gm::GP{1024, 1024, 16, 16}, S, E); GT1(4) }
        PH_END(base + 2 + PC); }
    pair_core<KIND, 1>(F0, p, xbar, base + 3 + PC, tprobe);
    if (PH_ON(base + 3 + 2 * PC)) { const Frame F = fresh(F0);
        SP S = sched_g(F, p, 1); EpiG<KIND> E = epi_g<KIND>(p, 1);
        { GT0 gm::gemm_phase<EpiG<KIND>, SP, false>(F.lds, gm::GP{1024, 1024, 16, 16}, S, E); GT1(4) }
        PH_END(base + 3 + 2 * PC); }
    int k = base + 4 + 2 * PC;
    if (KIND == 1) { if (PH_ON(k)) { const Frame F = fresh(F0); { GT0 gn_pass(F, p); GT1(11) } PH_END(k); } ++k; }
    if (PH_ON(k)) { const Frame F = fresh(F0);
        SP S{(const char*)(ws + OFF_Z), (const char*)(ws + OFF_WOUT), (const char*)(ws + OFF_WOUT), 64, 4, 4, F.G, F.bid, (size_t)256 * 4096, (size_t)256 * 4096, 1024, 0};
        EpiRes E{layer == 0 ? p.x : p.out, p.out, MOD + 2048};
        { GT0 gm::gemm_phase<EpiRes, SP, false>(F.lds, gm::GP{2048, 2048, 32, 32}, S, E); GT1(6) }
        PH_END(k); }
    ++k;
    if (PH_ON(k)) { const Frame F = fresh(F0); { GT0 convert_ffn_weights(F, p, layer); GT1(7) } { GT0 norm_phase<false>(F, p, p.out, p.nfg + layer * 1024, MOD + 3072, MOD + 4096); GT1(8) } PH_END(k); }
    ++k;
    if (PH_ON(k)) { const Frame F = fresh(F0);
        SP S{H, (const char*)(ws + OFF_WUP), (const char*)(ws + OFF_WUP), 64, 22, 22, F.G, F.bid, (size_t)256 * 2048, (size_t)256 * 2048, DFF, 0};
        EpiUp E{(bf16_t*)(ws + OFF_ACT), (bf16_t*)(ws + OFF_FH), p.fcw + (size_t)layer * 3 * 5632, p.fcb + (size_t)layer * 5632};
        { GT0 gm::gemm_phase<EpiUp, SP, false>(F.lds, gm::GP{1024, 1024, 16, 16}, S, E); GT1(3) }
        PH_END(k); }
    ++k;
    if (PH_ON(k)) { const Frame F = fresh(F0);
        SP S{(const char*)(ws + OFF_ACT), (const char*)(ws + OFF_WDN), (const char*)(ws + OFF_WDN), 64, 4, 4, F.G, F.bid, (size_t)256 * DFF * 2, (size_t)256 * DFF * 2, 1024, 0};
        { GT0 gm::U u; for (int i = 0; S.next(i, u); ++i) ffn_fix_panel(F, p, layer, u.i0);
          asm volatile("s_waitcnt vmcnt(0)" ::: "memory"); __syncthreads(); GT1(11) }
        EpiRes E{p.out, p.out, MOD + 5120};
        { GT0 gm::gemm_phase<EpiRes, SP, false>(F.lds, gm::GP{DFF, DFF, 44, 44}, S, E); GT1(6) }
        PH_END(k); }
}

__global__ void __launch_bounds__(512, 2) fwd_kernel(Params p) {
    extern __shared__ __attribute__((aligned(16))) unsigned char smem[];
    Frame F0; F0.lds = (LAS unsigned char*)smem; F0.G = gridDim.x; F0.bid = blockIdx.x; F0.tid = threadIdx.x; F0.wid = 0; F0.lane = 0;
    cg::grid_group grid = cg::this_grid();
    if (p.ph_hi < 0) grid.sync();
    unsigned long long tprobe = 0;
    volatile LAS unsigned* xst = (volatile LAS unsigned*)(smem + gm::STAGE_BYTES);
    if (threadIdx.x < 4) xst[threadIdx.x] = 0u;
    __syncthreads();
    const XcdBarrier xbar = xcd_barrier_post((unsigned*)(p.ws + OFF_SM + SM_BAR), xst);
    if (PH_ON(0)) { const Frame F = fresh(F0); { GT0 prologue_phase(F, p); GT1(11) } PH_END(0); }
    layer_program<0>(F0, p, xbar, 1, tprobe);
    layer_program<1>(F0, p, xbar, 15, tprobe);
    if (PH_ON(32)) { const Frame F = fresh(F0); { GT0 final_norm(F, p); GT1(11) } }
#if PROBE_CAT
    if (blockIdx.x == 0) { const unsigned long long t0 = RT(); while (RT() - t0 < tprobe) __builtin_amdgcn_s_sleep(8); }
#endif
}

extern "C" void kernel_launch(void* const* d_in, const int* in_sizes, int n_in, void* d_out, int out_size, void* d_ws, size_t ws_size, hipStream_t stream) {
    static int grid_blocks = 0;
    constexpr int LDS_BYTES = gm::STAGE_BYTES + 16;
    if (!grid_blocks) {
        int dev = 0, cus = 0, per_cu = 0;
        (void)hipGetDevice(&dev); (void)hipDeviceGetAttribute(&cus, hipDeviceAttributeMultiprocessorCount, dev);
        (void)hipFuncSetAttribute((const void*)fwd_kernel, hipFuncAttributeMaxDynamicSharedMemorySize, LDS_BYTES);
        (void)hipOccupancyMaxActiveBlocksPerMultiprocessor(&per_cu, (const void*)fwd_kernel, 512, LDS_BYTES);
        if (per_cu < 1) per_cu = 1;
        grid_blocks = cus;
        if (ws_size < WS_END) fprintf(stderr, "kernel_launch: workspace too small: %zu < %zu\n", ws_size, (size_t)WS_END);
        (void)hipGetLastError();
    }
    Params p{};
    p.x = (const float*)d_in[0]; p.c = (const float*)d_in[1]; p.pos = (const int*)d_in[2]; p.ada_w = (const float*)d_in[3]; p.ada_b = (const float*)d_in[4];
    p.ntg = (const float*)d_in[5]; p.nfg = (const float*)d_in[6]; p.ret_w_in = (const float*)d_in[7]; p.ret_gn = (const float*)d_in[8]; p.ret_w_out = (const float*)d_in[9];
    p.ml_w_in = (const float*)d_in[10]; p.ml_bg = (const float*)d_in[11]; p.ml_cw = (const float*)d_in[12]; p.ml_cb = (const float*)d_in[13]; p.ml_gn = (const float*)d_in[14];
    p.ml_w_out = (const float*)d_in[15]; p.up_w = (const float*)d_in[16]; p.fcw = (const float*)d_in[17]; p.fcb = (const float*)d_in[18]; p.dn_w = (const float*)d_in[19];
    p.fin_g = (const float*)d_in[20]; p.out = (float*)d_out; p.ws = (unsigned char*)d_ws;
#if MULTI_LAUNCH
    for (int ph = 0; ph < N_PHASES; ++ph) { p.ph_lo = ph; p.ph_hi = ph + 1; hipLaunchKernelGGL(fwd_kernel, dim3(grid_blocks), dim3(512), LDS_BYTES, stream, p); }
#else
    p.ph_lo = 0; p.ph_hi = N_PHASES;
    (void)hipMemsetAsync((unsigned char*)d_ws + OFF_SM + SM_BAR, 0, XCD_BAR_WORDS * 4, stream);
    void* args[] = {&p};
    hipError_t e = hipLaunchCooperativeKernel((void*)fwd_kernel, dim3(grid_blocks), dim3(512), args, LDS_BYTES, stream);
    if (e != hipSuccess) fprintf(stderr, "cooperative launch failed: %s (grid %d)\n", hipGetErrorString(e), grid_blocks);
#endif
}
```

```cpp
#include <hip/hip_runtime.h>
#include <hip/hip_cooperative_groups.h>
#include <cstdio>
namespace cg = cooperative_groups;

#ifndef MULTI_LAUNCH
#define MULTI_LAUNCH 0
#endif

#define LAS __attribute__((address_space(3)))
typedef unsigned short bf16_t;
typedef short bf16x8 __attribute__((ext_vector_type(8)));
typedef float f32x4 __attribute__((ext_vector_type(4)));
typedef unsigned u32x4 __attribute__((ext_vector_type(4)));
typedef unsigned u32x2 __attribute__((ext_vector_type(2)));

constexpr int S_ = 16384, D_ = 1024, DFF = 2816;
constexpr float EPS = 1e-6f;

constexpr size_t OFF_W = 0;
constexpr size_t OFF_WIN = 0, OFF_WOUT = 12582912, OFF_WUP = 0, OFF_WDN = 11534336;
constexpr size_t OFF_H = 17301504;
constexpr size_t OFF_SM = OFF_H + 33554432;
constexpr size_t SM_MOD = 0;
constexpr size_t SM_IFQ = SM_MOD + 49152;
constexpr size_t SM_RB = SM_IFQ + 512;
constexpr size_t TBL = 262144;
constexpr size_t SM_CB = SM_RB + TBL, SM_XS = SM_CB + TBL, SM_WK = SM_XS + TBL, SM_EM = SM_WK + TBL, SM_GG = SM_EM + TBL, SM_PM = SM_GG + TBL;
constexpr size_t SM_GL = SM_PM + TBL;
constexpr size_t SM_ML = SM_GL + 1024, SM_SCP = SM_ML + 1024, SM_SCN = SM_SCP + 1024;
constexpr size_t SM_LI = SM_SCN + 1024;
constexpr size_t SM_LF = SM_LI + 262144;
constexpr size_t SM_PS = SM_LF + 262144;
constexpr size_t SM_DC = SM_PS + 1048576;
constexpr size_t SM_NLOC = SM_DC + 262144;
constexpr size_t SM_ST = SM_NLOC + 262144;
constexpr size_t SM_QKH = SM_ST + 4194304;
constexpr size_t SM_BAR = SM_QKH + 1572864;
constexpr size_t SM_END = SM_BAR + 16384;
constexpr size_t OFF_BIG = OFF_SM + 10485760;
static_assert(SM_END <= 10485760, "small region");
constexpr size_t OFF_Q = OFF_BIG, OFF_K = OFF_Q + 16777216, OFF_KWT = OFF_K + 16777216, OFF_VT = OFF_KWT + 16777216,
                 OFF_KVT = OFF_VT + 33554432, OFF_P = OFF_KVT + 33554432, OFF_Z = OFF_P + 16777216, WS_END = OFF_Z + 67108864;
constexpr size_t OFF_ACT = OFF_BIG, OFF_FH = OFF_ACT + 92274688;

struct Params {
    const float *x, *c; const int* pos; const float *ada_w, *ada_b, *ntg, *nfg, *ret_w_in, *ret_gn, *ret_w_out,
        *ml_w_in, *ml_bg, *ml_cw, *ml_cb, *ml_gn, *ml_w_out, *up_w, *fcw, *fcb, *dn_w, *fin_g;
    float* out; unsigned char* ws; int ph_lo, ph_hi;
};

__device__ __forceinline__ unsigned cvt_pk_bf16(float lo, float hi) { unsigned r; asm volatile("v_cvt_pk_bf16_f32 %0, %1, %2" : "=v"(r) : "v"(lo), "v"(hi)); return r; }
__device__ __forceinline__ float bf_lo(unsigned w) { return __uint_as_float(w << 16); }
__device__ __forceinline__ float bf_hi(unsigned w) { return __uint_as_float(w & 0xffff0000u); }
__device__ __forceinline__ float siluf(float v) { return v * __builtin_amdgcn_rcpf(1.0f + __expf(-v)); }
__device__ __forceinline__ float sigmf(float v) { return __builtin_amdgcn_rcpf(1.0f + __expf(-v)); }
__device__ __forceinline__ float dpp_shr1(float old, float x) { return __builtin_bit_cast(float, __builtin_amdgcn_update_dpp(__builtin_bit_cast(int, old), __builtin_bit_cast(int, x), 0x111, 0xf, 0xf, false)); }
__device__ __forceinline__ float dpp_shr2(float old, float x) { return __builtin_bit_cast(float, __builtin_amdgcn_update_dpp(__builtin_bit_cast(int, old), __builtin_bit_cast(int, x), 0x112, 0xf, 0xf, false)); }
__device__ __forceinline__ float dpp_ror1(float x) { return __builtin_bit_cast(float, __builtin_amdgcn_update_dpp(0, __builtin_bit_cast(int, x), 0x121, 0xf, 0xf, true)); }
__device__ __forceinline__ float dpp_ror2(float x) { return __builtin_bit_cast(float, __builtin_amdgcn_update_dpp(0, __builtin_bit_cast(int, x), 0x122, 0xf, 0xf, true)); }
__device__ __forceinline__ float dpp_mirror(float x) { return __builtin_bit_cast(float, __builtin_amdgcn_update_dpp(0, __builtin_bit_cast(int, x), 0x140, 0xf, 0xf, true)); }
__device__ __forceinline__ float dpp_swap01(float x) { return __builtin_bit_cast(float, __builtin_amdgcn_update_dpp(0, __builtin_bit_cast(int, x), 0xB1, 0xf, 0xf, true)); }
__device__ __forceinline__ float wave_sum(float v) { for (int o = 32; o >= 1; o >>= 1) v += __shfl_xor(v, o); return v; }
__device__ __forceinline__ u32x4 pack8(const f32x4 a, const f32x4 b) { u32x4 w; w.x = cvt_pk_bf16(a[0], a[1]); w.y = cvt_pk_bf16(a[2], a[3]); w.z = cvt_pk_bf16(b[0], b[1]); w.w = cvt_pk_bf16(b[2], b[3]); return w; }
__device__ __forceinline__ void unpack8(const u32x4 w, float (&f)[8]) { f[0] = bf_lo(w.x); f[1] = bf_hi(w.x); f[2] = bf_lo(w.y); f[3] = bf_hi(w.y); f[4] = bf_lo(w.z); f[5] = bf_hi(w.z); f[6] = bf_lo(w.w); f[7] = bf_hi(w.w); }

namespace gm {
constexpr int BM = 256, BK = 64, HALF = 128, HTB = HALF * BK * 2, STAGE_BYTES = 8 * HTB, NXCD = 8, WGM = 8;
__device__ __forceinline__ int lds_byte(int r, int c) { const int st = (r >> 4) * 2 + (c >> 5), rr = r & 15, cc = c & 31, ob = rr * 64 + cc * 2; return st * 1024 + (ob ^ (((ob >> 9) & 1) << 5)); }
__device__ __forceinline__ void stage_rc(int b, int& R, int& C) { const int st = b / 1024, sb = b % 1024, swz = sb ^ (((sb >> 9) & 1) << 5); R = (st >> 1) * 16 + swz / 64; C = (st & 1) * 32 + (swz % 64) / 2; }
__device__ __forceinline__ int perm32(int rho) { const int n = rho >> 4, i = rho & 15; return 8 * (i >> 2) + 4 * n + (i & 3); }

struct U { const char *a1, *b1, *a2, *b2; long co; int i0, i1, i2, i3; };
struct GP { int lda, ldb, n1, nt; };

struct SchedPlain {
    const char* A; const char* B; const char* B2; int nM, nN, nsplit, G, c; size_t ta, tb; long ldc; int vt;
    __device__ __forceinline__ bool next(int i, U& u) const { return at((long)i * G + c, u); }
    __device__ __forceinline__ bool at(long L, U& u) const {
        const int nwg = nM * nN; if (L >= nwg) return false;
        int wgid = (int)L; { const int q = nwg / NXCD, r = nwg % NXCD, xcd = wgid % NXCD, off = wgid / NXCD; wgid = (xcd < r ? xcd * (q + 1) : r * (q + 1) + (xcd - r) * q) + off; }
        const int nig = WGM * nN, gid = wgid / nig, fm = gid * WGM, gsz = (nM - fm) < WGM ? (nM - fm) : WGM;
        const int pm = fm + ((wgid % nig) % gsz), pn = (wgid % nig) / gsz;
        u.a1 = A + (size_t)pm * ta; u.b1 = pn < nsplit ? B + (size_t)pn * tb : B2 + (size_t)(pn - nsplit) * tb; u.a2 = u.a1; u.b2 = u.b1;
        u.co = vt ? ((long)((pm >> 1) * 64 + pn) * 512 + (pm & 1) * 256) * 256 : (long)pm * 256 * ldc + (long)pn * 256; u.i0 = pm; u.i1 = pn; u.i2 = 0; u.i3 = 0; return true;
    }
};

struct SchedMulti {
    SchedPlain s0, s1, s2; int n0, n1, n2, G, c;
    __device__ __forceinline__ bool next(int i, U& u) const {
        const long L = (long)i * G + c; bool ok; int w;
        if (L < n0) { ok = s0.at(L, u); w = 0; } else if (L < n0 + n1) { ok = s1.at(L - n0, u); w = 1; } else if (L < n0 + n1 + n2) { ok = s2.at(L - n0 - n1, u); w = 2; } else return false;
        u.i3 = w; return ok;
    }
};

template <class Epi, class Sched, bool TWOSEG>
__device__ __forceinline__ void gemm_phase(LAS unsigned char* lds, const GP g, const Sched& S, const Epi& E) {
    int tid = threadIdx.x; asm volatile("" : "+v"(tid));
    const int wid = __builtin_amdgcn_readfirstlane(tid >> 6), lane = tid & 63, wr = wid >> 2, wc = wid & 3, fr = lane & 15, fq = lane >> 4;
    const int nt = g.nt;
    unsigned voffA[2], voffB[2];
#pragma unroll
    for (int i = 0; i < 2; ++i) { int R, C; stage_rc(tid * 16 + i * 8192, R, C); const int Rb = Epi::PERM ? ((R & ~31) + perm32(R & 31)) : R;
        voffA[i] = (unsigned)(R * g.lda + C) * 2u; voffB[i] = (unsigned)(Rb * g.ldb + C) * 2u; }
    const size_t hsA1 = (size_t)HALF * g.lda * 2, hsB1 = (size_t)HALF * g.ldb * 2;
    const unsigned ldsw = (unsigned)wid * 1024u;
    const int aoff = lds_byte(wr * 64 + fr, fq * 8), boff = lds_byte(wc * 32 + fr, fq * 8);
#define G_SA(b, h) (((b) * 2 + (h)) * HTB)
#define G_SB(b, h) ((4 + (b) * 2 + (h)) * HTB)
#define G_STAGE(bufoff, gbase, voff) do { _Pragma("unroll") for (int _i = 0; _i < 2; ++_i) \
        __builtin_amdgcn_global_load_lds((const unsigned*)((const char*)(gbase) + (voff)[_i]), (LAS unsigned*)(lds + (bufoff) + ldsw + _i * 8192), 16, 0, 0); } while (0)
#define G_LDA(dst, b, h) do { _Pragma("unroll") for (int m = 0; m < 4; ++m) _Pragma("unroll") for (int k = 0; k < 2; ++k) dst[m][k] = *(const LAS bf16x8*)(lds + G_SA(b, h) + aoff + m * 2048 + k * 1024); } while (0)
#define G_LDB(dst, b, h) do { _Pragma("unroll") for (int n = 0; n < 2; ++n) _Pragma("unroll") for (int k = 0; k < 2; ++k) dst[n][k] = *(const LAS bf16x8*)(lds + G_SB(b, h) + boff + n * 2048 + k * 1024); } while (0)
#define G_MMA(ai, bj, At, Bt) do { __builtin_amdgcn_s_setprio(1); _Pragma("unroll") for (int m = 0; m < 4; ++m) _Pragma("unroll") for (int n = 0; n < 2; ++n) _Pragma("unroll") for (int k = 0; k < 2; ++k) \
        acc[ai][bj][m][n] = __builtin_amdgcn_mfma_f32_16x16x32_bf16(Bt[n][k], At[m][k], acc[ai][bj][m][n], 0, 0, 0); __builtin_amdgcn_s_setprio(0); } while (0)
#define G_WAIT_V(n) asm volatile("s_waitcnt vmcnt(" #n ")" ::: "memory")
#define G_WAIT_L(n) asm volatile("s_waitcnt lgkmcnt(" #n ")" ::: "memory")
#define G_BAR __builtin_amdgcn_s_barrier()
#define G_SCHED __builtin_amdgcn_sched_barrier(0)
    U cur, nxt; int ui = 0;
    if (!S.next(0, cur)) return;
    f32x4 acc[2][2][4][2];
#pragma unroll
    for (int a = 0; a < 2; ++a)
#pragma unroll
        for (int b = 0; b < 2; ++b)
#pragma unroll
            for (int m = 0; m < 4; ++m)
#pragma unroll
                for (int n = 0; n < 2; ++n) acc[a][b][m][n] = (f32x4){0.f, 0.f, 0.f, 0.f};
    bf16x8 At[4][2], B0[2][2], B1[2][2];
    G_STAGE(G_SB(0, 0), cur.b1, voffB); G_STAGE(G_SA(0, 0), cur.a1, voffA); G_STAGE(G_SB(0, 1), cur.b1 + hsB1, voffB); G_STAGE(G_SA(0, 1), cur.a1 + hsA1, voffA);
    if (wr == 1) G_BAR;
    G_WAIT_V(4); G_BAR;
    G_STAGE(G_SB(1, 0), cur.b1 + 128, voffB); G_STAGE(G_SA(1, 0), cur.a1 + 128, voffA); G_STAGE(G_SB(1, 1), cur.b1 + hsB1 + 128, voffB);
    G_WAIT_V(6); G_BAR;
    for (;;) {
        const bool has_next = S.next(ui + 1, nxt);
        const char* nA = has_next ? nxt.a1 : cur.a1; const char* nB = has_next ? nxt.b1 : cur.b1;
        for (int t = 0; t < nt; t += 2) {
            const bool last = (t == nt - 2);
            const bool sg1 = TWOSEG && (t >= g.n1);
            const bool sg2 = TWOSEG && !last && (t + 2 >= g.n1);
            const char* a1 = sg1 ? cur.a2 + (size_t)(t + 1 - g.n1) * 128 : cur.a1 + (size_t)(t + 1) * 128;
            const char* a2 = last ? nA : (sg2 ? cur.a2 + (size_t)(t + 2 - g.n1) * 128 : cur.a1 + (size_t)(t + 2) * 128);
            const char* b2 = last ? nB : (sg2 ? cur.b2 + (size_t)(t + 2 - g.n1) * 128 : cur.b1 + (size_t)(t + 2) * 128);
            const char* a3 = a2 + 128; const char* b3 = b2 + 128;
            if (TWOSEG) { if (t == g.n1) E.mid(acc, cur, wr, wc, fr, fq); }
            G_LDB(B0, 0, 0); G_SCHED; G_LDA(At, 0, 0); G_STAGE(G_SA(1, 1), a1 + hsA1, voffA);
            G_WAIT_L(8); G_BAR; G_WAIT_L(0); G_MMA(0, 0, At, B0); G_BAR; G_SCHED;
            G_LDB(B1, 0, 1); G_STAGE(G_SB(0, 0), b2, voffB);
            G_BAR; G_WAIT_L(0); G_MMA(0, 1, At, B1); G_BAR;
            G_LDA(At, 0, 1); G_STAGE(G_SA(0, 0), a2, voffA);
            G_BAR; G_WAIT_L(0); G_MMA(1, 0, At, B0); G_BAR; G_SCHED;
            G_STAGE(G_SB(0, 1), b2 + hsB1, voffB);
            G_WAIT_V(6); G_BAR; G_MMA(1, 1, At, B1); G_BAR;
            G_LDB(B0, 1, 0); G_SCHED; G_LDA(At, 1, 0); G_STAGE(G_SA(0, 1), a2 + hsA1, voffA);
            G_WAIT_L(8); G_BAR; G_WAIT_L(0); G_MMA(0, 0, At, B0); G_BAR; G_SCHED;
            G_LDB(B1, 1, 1); G_STAGE(G_SB(1, 0), b3, voffB);
            G_BAR; G_WAIT_L(0); G_MMA(0, 1, At, B1); G_BAR;
            G_LDA(At, 1, 1); G_STAGE(G_SA(1, 0), a3, voffA);
            G_BAR; G_WAIT_L(0); G_MMA(1, 0, At, B0); G_BAR; G_SCHED;
            G_STAGE(G_SB(1, 1), b3 + hsB1, voffB);
            G_WAIT_V(6); G_BAR; G_MMA(1, 1, At, B1); G_BAR;
        }
        E(acc, cur, wr, wc, fr, fq);
        if (!has_next) break;
#pragma unroll
        for (int a = 0; a < 2; ++a)
#pragma unroll
            for (int b = 0; b < 2; ++b)
#pragma unroll
                for (int m = 0; m < 4; ++m)
#pragma unroll
                    for (int n = 0; n < 2; ++n) acc[a][b][m][n] = (f32x4){0.f, 0.f, 0.f, 0.f};
        cur = nxt; ++ui;
    }
    G_WAIT_V(0);
    if (wr == 0) G_BAR;
    G_BAR;
#undef G_SA
#undef G_SB
#undef G_STAGE
#undef G_LDA
#undef G_LDB
#undef G_MMA
#undef G_WAIT_V
#undef G_WAIT_L
#undef G_BAR
#undef G_SCHED
}
}

typedef f32x4 Acc[2][2][4][2];

struct EpiPlain {
    static constexpr bool PERM = true; bf16_t* base; long ldc;
    __device__ __forceinline__ void mid(Acc&, const gm::U&, int, int, int, int) const {}
    __device__ __forceinline__ void operator()(const Acc& acc, const gm::U& u, int wr, int wc, int fr_, int fq_) const {
        int fr = fr_, fq = fq_; asm volatile("" : "+v"(fr), "+v"(fq));
        bf16_t* d = base + u.co + (long)(wr * 64 + fr) * ldc + wc * 32 + 8 * fq;
#pragma unroll
        for (int ai = 0; ai < 2; ++ai)
#pragma unroll
            for (int m = 0; m < 4; ++m)
#pragma unroll
                for (int bj = 0; bj < 2; ++bj) *(u32x4*)(d + (long)(ai * 128 + m * 16) * ldc + bj * 128) = pack8(acc[ai][bj][m][0], acc[ai][bj][m][1]);
    }
};

template <int KIND> struct EpiQK {
    static constexpr bool PERM = true; bf16_t* Q; bf16_t* K; const int* pos; const float* ifq; bf16_t* qkh; bf16_t* kwt; const float* wkt; int pair;
    __device__ __forceinline__ void mid(Acc&, const gm::U&, int, int, int, int) const {}
    __device__ __forceinline__ void operator()(const Acc& acc, const gm::U& u, int wr, int wc, int fr_, int fq_) const {
        int fr = fr_, fq = fq_; asm volatile("" : "+v"(fr), "+v"(fq));
        const int pm = u.i0, pn = u.i1, d0 = wc * 32 + 8 * fq;
        bf16_t* dst = (pn < 2 ? Q : K) + (size_t)(pn & 1) * S_ * 256 + d0;
        if (KIND == 0) {
            const float sc = pn < 2 ? 1.0f : 0.0625f;
            const f32x4 f0 = *(const f32x4*)(ifq + d0), f1 = *(const f32x4*)(ifq + d0 + 4);
#pragma unroll
            for (int ai = 0; ai < 2; ++ai)
#pragma unroll
                for (int m = 0; m < 4; ++m) {
                    const int t = pm * 256 + ai * 128 + wr * 64 + m * 16 + fr; const float pf = (float)pos[t];
                    f32x4 o1[2], o2[2];
#pragma unroll
                    for (int n = 0; n < 2; ++n)
#pragma unroll
                        for (int e = 0; e < 4; ++e) {
                            const float ang = pf * (n ? f1[e] : f0[e]);
                            const double rev = (double)ang * 0.15915494309189535; const float fx = (float)(rev - __builtin_rint(rev));
                            const float sn = __builtin_amdgcn_sinf(fx), cs = __builtin_amdgcn_cosf(fx);
                            const float t1 = acc[ai][0][m][n][e], t2 = acc[ai][1][m][n][e];
                            o1[n][e] = (t1 * cs - t2 * sn) * sc; o2[n][e] = (t1 * sn + t2 * cs) * sc; }
                    *(u32x4*)(dst + (size_t)t * 256) = pack8(o1[0], o1[1]); *(u32x4*)(dst + (size_t)t * 256 + 128) = pack8(o2[0], o2[1]);
                    if (pn >= 2) {
                        const int h2 = pn & 1, tl = ai * 128 + wr * 64 + m * 16 + fr; const float wk = wkt[(size_t)(2 * pair + h2) * S_ + t];
                        bf16_t* kp = kwt + ((size_t)(h2 * 64 + pm) * 256 + d0) * 256 + tl;
#pragma unroll
                        for (int n = 0; n < 2; ++n)
#pragma unroll
                            for (int e = 0; e < 4; e += 2) { const unsigned w1 = cvt_pk_bf16(o1[n][e] * wk, o1[n][e + 1] * wk), w2 = cvt_pk_bf16(o2[n][e] * wk, o2[n][e + 1] * wk);
                                kp[(size_t)(4 * n + e) * 256] = (bf16_t)(w1 & 0xffffu); kp[(size_t)(4 * n + e + 1) * 256] = (bf16_t)(w1 >> 16);
                                kp[(size_t)(128 + 4 * n + e) * 256] = (bf16_t)(w2 & 0xffffu); kp[(size_t)(128 + 4 * n + e + 1) * 256] = (bf16_t)(w2 >> 16); } } }
        } else {
#pragma unroll
            for (int ai = 0; ai < 2; ++ai)
#pragma unroll
                for (int m = 0; m < 4; ++m) {
                    const int t = pm * 256 + ai * 128 + wr * 64 + m * 16 + fr;
#pragma unroll
                    for (int bj = 0; bj < 2; ++bj) { const u32x4 w = pack8(acc[ai][bj][m][0], acc[ai][bj][m][1]);
                        *(u32x4*)(dst + (size_t)t * 256 + bj * 128) = w;
                        if (m == 3 && fr >= 13) { const int gq = pm * 4 + ai * 2 + wr; *(u32x4*)(qkh + ((size_t)gq * 3 + (fr - 13)) * 1024 + pn * 256 + bj * 128 + d0) = w; } } }
        }
    }
};

template <bool PSUM> struct EpiS {
    static constexpr bool PERM = true; bf16_t* P; const float* RB; const float* CB; float* PS; int pair;
    __device__ __forceinline__ void mid(Acc&, const gm::U&, int, int, int, int) const {}
    __device__ __forceinline__ void operator()(const Acc& acc, const gm::U& u, int wr, int wc, int fr_, int fq_) const {
        int fr = fr_, fq = fq_; asm volatile("" : "+v"(fr), "+v"(fq));
        const int ch = u.i0, h2 = u.i1, h = 2 * pair + h2, c0 = wc * 32 + 8 * fq;
        const float* rb = RB + (size_t)h * S_ + ch * 256 + wr * 64 + fr; const float* cb = CB + (size_t)h * S_ + ch * 256 + c0;
        bf16_t* d = P + ((size_t)(h2 * 64 + ch) * 256 + wr * 64 + fr) * 256 + c0;
        float rbv[2][4], rs[2][4];
#pragma unroll
        for (int ai = 0; ai < 2; ++ai)
#pragma unroll
            for (int m = 0; m < 4; ++m) { rbv[ai][m] = rb[ai * 128 + m * 16]; rs[ai][m] = 0.f; }
#pragma unroll
        for (int bj = 0; bj < 2; ++bj)
#pragma unroll
            for (int n = 0; n < 2; ++n) {
                const f32x4 cbv = *(const f32x4*)(cb + bj * 128 + 4 * n);
#pragma unroll
                for (int ai = 0; ai < 2; ++ai)
#pragma unroll
                    for (int m = 0; m < 4; ++m) {
                        const int dij = (ai * 128 + wr * 64 + m * 16 + fr) - (bj * 128 + c0 + 4 * n);
                        f32x4 v;
#pragma unroll
                        for (int e = 0; e < 4; ++e) { const float w = (dij - e >= 0) ? acc[ai][bj][m][n][e] * __builtin_amdgcn_exp2f((rbv[ai][m] + cbv[e]) * 1.44269504f) : 0.f; v[e] = w; rs[ai][m] += w; }
                        u32x2 pk; pk.x = cvt_pk_bf16(v[0], v[1]); pk.y = cvt_pk_bf16(v[2], v[3]);
                        *(u32x2*)(d + (size_t)(ai * 128 + m * 16) * 256 + bj * 128 + 4 * n) = pk; }
            }
        if (PSUM) {
#pragma unroll
            for (int ai = 0; ai < 2; ++ai)
#pragma unroll
                for (int m = 0; m < 4; ++m) { float r = rs[ai][m]; r += __shfl_xor(r, 16); r += __shfl_xor(r, 32);
                    if (fq == 0) PS[((size_t)(ch * 256 + ai * 128 + wr * 64 + m * 16 + fr) * 4 + h) * 4 + wc] = r; } }
    }
};

template <bool STATS> struct EpiO {
    static constexpr bool PERM = true; bf16_t* Z; const float* XS; float* ST; int pair;
    __device__ __forceinline__ void mid(Acc& acc, const gm::U& u, int wr, int wc, int fr, int fq) const {
        const int ch = u.i0, h = 2 * pair + u.i1; const float* xs = XS + (size_t)h * S_ + ch * 256 + wr * 64 + fr;
#pragma unroll
        for (int ai = 0; ai < 2; ++ai)
#pragma unroll
            for (int m = 0; m < 4; ++m) { const float x = xs[ai * 128 + m * 16];
#pragma unroll
                for (int bj = 0; bj < 2; ++bj)
#pragma unroll
                    for (int n = 0; n < 2; ++n) acc[ai][bj][m][n] *= x; }
    }
    __device__ __forceinline__ void operator()(const Acc& acc, const gm::U& u, int wr, int wc, int fr_, int fq_) const {
        int fr = fr_, fq = fq_; asm volatile("" : "+v"(fr), "+v"(fq));
        const int ch = u.i0, h = 2 * pair + u.i1, nt2 = u.i2, c0 = wc * 32 + 8 * fq;
        bf16_t* d = Z + (size_t)(ch * 256) * 2048 + h * 512 + nt2 * 256 + c0;
#pragma unroll
        for (int ai = 0; ai < 2; ++ai)
#pragma unroll
            for (int m = 0; m < 4; ++m) {
                const int i = ai * 128 + wr * 64 + m * 16 + fr; float s = 0.f, q = 0.f;
#pragma unroll
                for (int bj = 0; bj < 2; ++bj) { *(u32x4*)(d + (size_t)i * 2048 + bj * 128) = pack8(acc[ai][bj][m][0], acc[ai][bj][m][1]);
                    if (STATS) {
#pragma unroll
                        for (int n = 0; n < 2; ++n)
#pragma unroll
                            for (int e = 0; e < 4; ++e) { const float v = acc[ai][bj][m][n][e]; s += v; q += v * v; } } }
                if (STATS) { s += __shfl_xor(s, 16); s += __shfl_xor(s, 32); q += __shfl_xor(q, 16); q += __shfl_xor(q, 32);
                    if (fq == 0) { float* st = ST + (((size_t)(ch * 256 + i) * 4 + h) * 8 + nt2 * 4 + wc) * 2; st[0] = s; st[1] = q; } } }
    }
};

template <int KIND> struct EpiG {
    static constexpr bool PERM = true; bf16_t* Z; float* ST; const float* gng; const float* PS; const float* XS; const float* DC; const float* EM; int pair;
    __device__ __forceinline__ void mid(Acc&, const gm::U&, int, int, int, int) const {}
    __device__ __forceinline__ void operator()(const Acc& acc, const gm::U& u, int wr, int wc, int fr_, int fq_) const {
        int fr = fr_, fq = fq_; asm volatile("" : "+v"(fr), "+v"(fq));
        const int pm = u.i0, pn = u.i1, h = 2 * pair + (pn >> 1), nt2 = pn & 1, c0 = wc * 32 + 8 * fq;
        const int colb = pair * 1024 + pn * 256 + c0;
        f32x4 gv[2][2];
        if (KIND == 0) {
#pragma unroll
            for (int bj = 0; bj < 2; ++bj)
#pragma unroll
                for (int n = 0; n < 2; ++n) gv[bj][n] = *(const f32x4*)(gng + colb + bj * 128 + 4 * n);
        }
#pragma unroll
        for (int ai = 0; ai < 2; ++ai)
#pragma unroll
            for (int m = 0; m < 4; ++m) {
                const int t = pm * 256 + ai * 128 + wr * 64 + m * 16 + fr;
                bf16_t* zp = Z + (size_t)t * 2048 + colb;
                if (KIND == 0) {
                    const f32x4* st = (const f32x4*)(ST + ((size_t)t * 4 + h) * 16);
                    const f32x4 a = st[0], b = st[1], c = st[2], d = st[3];
                    const float s = (a[0] + a[2]) + (b[0] + b[2]) + (c[0] + c[2]) + (d[0] + d[2]);
                    const float q = (a[1] + a[3]) + (b[1] + b[3]) + (c[1] + c[3]) + (d[1] + d[3]);
                    const float mu = s * (1.0f / 512.0f); const float var = fmaxf(q * (1.0f / 512.0f) - mu * mu, 0.f); const float rstd = rsqrtf(var + EPS);
#pragma unroll
                    for (int bj = 0; bj < 2; ++bj) { float y[8]; unpack8(*(const u32x4*)(zp + bj * 128), y); f32x4 o[2];
#pragma unroll
                        for (int n = 0; n < 2; ++n)
#pragma unroll
                            for (int e = 0; e < 4; ++e) o[n][e] = siluf(acc[ai][bj][m][n][e]) * (y[4 * n + e] - mu) * rstd * gv[bj][n][e];
                        *(u32x4*)(zp + bj * 128) = pack8(o[0], o[1]); }
                } else {
                    const f32x4 ps = *(const f32x4*)(PS + ((size_t)t * 4 + h) * 4);
                    const float den = (ps[0] + ps[1]) + (ps[2] + ps[3]) + XS[(size_t)h * S_ + t] * DC[(size_t)t * 4 + h];
                    const float inv = __builtin_amdgcn_rcpf(fmaxf(fabsf(den), EM[(size_t)h * S_ + t]));
                    float s = 0.f, q = 0.f;
#pragma unroll
                    for (int bj = 0; bj < 2; ++bj) { float y[8]; unpack8(*(const u32x4*)(zp + bj * 128), y); f32x4 o[2];
#pragma unroll
                        for (int n = 0; n < 2; ++n)
#pragma unroll
                            for (int e = 0; e < 4; ++e) { const float v = sigmf(acc[ai][bj][m][n][e]) * y[4 * n + e] * inv; o[n][e] = v; s += v; q += v * v; }
                        *(u32x4*)(zp + bj * 128) = pack8(o[0], o[1]); }
                    s += __shfl_xor(s, 16); s += __shfl_xor(s, 32); q += __shfl_xor(q, 16); q += __shfl_xor(q, 32);
                    if (fq == 0) { float* st = ST + (((size_t)t * 4 + h) * 8 + nt2 * 4 + wc) * 2; st[0] = s; st[1] = q; }
                }
            }
    }
};

struct EpiRes {
    static constexpr bool PERM = false; const float* base; float* out; const float* gate;
    __device__ __forceinline__ void mid(Acc&, const gm::U&, int, int, int, int) const {}
    __device__ __forceinline__ void operator()(const Acc& acc, const gm::U& u, int wr, int wc, int fr_, int fq_) const {
        int fr = fr_, fq = fq_; asm volatile("" : "+v"(fr), "+v"(fq));
        const int row0 = u.i0 * 256 + wr * 64 + fr, col0 = u.i1 * 256 + wc * 32 + 4 * fq;
        f32x4 gv[2][2];
#pragma unroll
        for (int bj = 0; bj < 2; ++bj)
#pragma unroll
            for (int n = 0; n < 2; ++n) gv[bj][n] = *(const f32x4*)(gate + col0 + bj * 128 + n * 16);
#pragma unroll
        for (int ai = 0; ai < 2; ++ai)
#pragma unroll
            for (int m = 0; m < 4; ++m) { const size_t ro = (size_t)(row0 + ai * 128 + m * 16) * 1024 + col0;
#pragma unroll
                for (int bj = 0; bj < 2; ++bj)
#pragma unroll
                    for (int n = 0; n < 2; ++n) { const size_t o = ro + bj * 128 + n * 16; const f32x4 b = *(const f32x4*)(base + o); *(f32x4*)(out + o) = b + gv[bj][n] * acc[ai][bj][m][n]; } }
    }
};

struct EpiUp {
    static constexpr bool PERM = true; bf16_t* act; bf16_t* fh; const float* cw; const float* cb;
    __device__ __forceinline__ void mid(Acc&, const gm::U&, int, int, int, int) const {}
    __device__ __forceinline__ void operator()(const Acc& acc, const gm::U& u, int wr, int wc, int fr_, int fq_) const {
        int fr = fr_, fq = fq_; asm volatile("" : "+v"(fr), "+v"(fq));
        const int pm = u.i0, pn = u.i1, c0 = wc * 32 + 8 * fq, lane = fq * 16 + fr;
        u32x2 pk0[2][4];
#pragma unroll
        for (int n = 0; n < 2; ++n) {
            f32x4 w0[2], w1[2], w2[2], bb[2];
#pragma unroll
            for (int bj = 0; bj < 2; ++bj) { const int chn = bj * DFF + pn * 128 + c0 + 4 * n;
                w0[bj] = *(const f32x4*)(cw + chn); w1[bj] = *(const f32x4*)(cw + 2 * DFF + chn); w2[bj] = *(const f32x4*)(cw + 4 * DFF + chn); bb[bj] = *(const f32x4*)(cb + chn); }
#pragma unroll
            for (int ai = 0; ai < 2; ++ai)
#pragma unroll
                for (int m = 0; m < 4; ++m) {
                    f32x4 uu[2];
#pragma unroll
                    for (int bj = 0; bj < 2; ++bj)
#pragma unroll
                        for (int e = 0; e < 4; ++e) {
                            const float cur = acc[ai][bj][m][n][e]; const float prv = acc[ai][bj][m > 0 ? m - 1 : 0][n][e];
                            const float mr = dpp_mirror(prv), mr2 = dpp_swap01(mr);
                            const float p1 = dpp_shr1(mr, cur), p2 = dpp_shr2(mr2, cur);
                            uu[bj][e] = bb[bj][e] + w0[bj][e] * p2 + w1[bj][e] * p1 + w2[bj][e] * cur; }
                    u32x2 pk; pk.x = cvt_pk_bf16(siluf(uu[0][0]) * uu[1][0], siluf(uu[0][1]) * uu[1][1]); pk.y = cvt_pk_bf16(siluf(uu[0][2]) * uu[1][2], siluf(uu[0][3]) * uu[1][3]);
                    if (n == 0) pk0[ai][m] = pk;
                    else { const int t = pm * 256 + ai * 128 + wr * 64 + m * 16 + fr; u32x4 w; w.x = pk0[ai][m].x; w.y = pk0[ai][m].y; w.z = pk.x; w.w = pk.y;
                        *(u32x4*)(act + (size_t)t * DFF + pn * 128 + c0) = w; }
                }
        }
#pragma unroll
        for (int ai = 0; ai < 2; ++ai) {
            const int gq = pm * 4 + ai * 2 + wr;
            if (fr >= 14) {
#pragma unroll
                for (int bj = 0; bj < 2; ++bj) *(u32x4*)(fh + ((size_t)gq * 4 + (fr - 14)) * (2 * DFF) + pn * 256 + bj * 128 + c0) = pack8(acc[ai][bj][3][0], acc[ai][bj][3][1]);
            }
            if (fr < 2) {
#pragma unroll
                for (int bj = 0; bj < 2; ++bj) *(u32x4*)(fh + ((size_t)gq * 4 + 2 + fr) * (2 * DFF) + pn * 256 + bj * 128 + c0) = pack8(acc[ai][bj][0][0], acc[ai][bj][0][1]);
            }
        }
    }
};

template <class E0, class E1, class E2> struct EpiMulti {
    static constexpr bool PERM = true; E0 e0; E1 e1; E2 e2;
    static_assert(E0::PERM && E1::PERM && E2::PERM, "mixed staging orders");
    __device__ __forceinline__ void mid(Acc&, const gm::U&, int, int, int, int) const {}
    __device__ __forceinline__ void operator()(const Acc& acc, const gm::U& u, int wr, int wc, int fr, int fq) const {
        if (u.i3 == 0) e0(acc, u, wr, wc, fr, fq); else if (u.i3 == 1) e1(acc, u, wr, wc, fr, fq); else e2(acc, u, wr, wc, fr, fq);
    }
};

struct SchedS { const char* Q; const char* K; int G, c;
    __device__ __forceinline__ bool next(int i, gm::U& u) const { const int L = i * G + c; if (L >= 128) return false; const int h2 = L & 1, ch = L >> 1;
        const size_t o = ((size_t)h2 * S_ + ch * 256) * 256 * 2; u.a1 = Q + o; u.b1 = K + o; u.a2 = u.a1; u.b2 = u.b1; u.co = 0; u.i0 = ch; u.i1 = h2; u.i2 = 0; u.i3 = 0; return true; } };
struct SchedKV { const char* VT; const char* KWT; int G, c;
    __device__ __forceinline__ bool next(int i, gm::U& u) const { const int L = i * G + c; if (L >= 256) return false; const int mt = L & 1, h2 = (L >> 1) & 1, ch = L >> 2;
        u.a1 = VT + ((size_t)(h2 * 64 + ch) * 512 + mt * 256) * 256 * 2; u.b1 = KWT + ((size_t)(h2 * 64 + ch) * 256) * 256 * 2; u.a2 = u.a1; u.b2 = u.b1;
        u.co = ((long)(h2 * 64 + ch) * 512 + mt * 256) * 256; u.i0 = ch; u.i1 = h2; u.i2 = mt; u.i3 = 0; return true; } };
struct SchedO { const char* Q; const char* KVT; const char* P; const char* VT; int G, c;
    __device__ __forceinline__ bool next(int i, gm::U& u) const { const int L = i * G + c; if (L >= 256) return false; const int nt2 = L & 1, h2 = (L >> 1) & 1, ch = L >> 2;
        u.a1 = Q + ((size_t)h2 * S_ + ch * 256) * 256 * 2; u.b1 = KVT + ((size_t)(h2 * 64 + ch) * 512 + nt2 * 256) * 256 * 2;
        u.a2 = P + ((size_t)(h2 * 64 + ch) * 65536) * 2; u.b2 = VT + ((size_t)(h2 * 64 + ch) * 512 + nt2 * 256) * 256 * 2;
        u.co = 0; u.i0 = ch; u.i1 = h2; u.i2 = nt2; u.i3 = 0; return true; } };

struct Frame { LAS unsigned char* lds; int G, bid, tid, wid, lane; };
__device__ __forceinline__ Frame fresh(const Frame& f) { Frame r = f; asm volatile("" : "+v"(r.tid)); r.lane = r.tid & 63; r.wid = __builtin_amdgcn_readfirstlane(r.tid >> 6); return r; }

struct TileD { const float* src; bf16_t* dst; int lds_, ldd; };
struct MixerTiles { const float* win; const float* wout; bf16_t* WIN; bf16_t* WOUT; int ldin;
    __device__ __forceinline__ TileD operator()(int u) const {
        if (u < 1536) { const int kt = u & 15, ct = u >> 4; return TileD{win + (size_t)kt * 64 * ldin + ct * 64, WIN + (size_t)ct * 64 * 1024 + kt * 64, ldin, 1024}; }
        const int v = u - 1536, kt = v & 31, ct = v >> 5; return TileD{wout + (size_t)kt * 64 * 1024 + ct * 64, WOUT + (size_t)ct * 64 * 2048 + kt * 64, 1024, 2048}; } };
struct FfnTiles { const float* wup; const float* wdn; bf16_t* WUP; bf16_t* WDN;
    __device__ __forceinline__ TileD operator()(int u) const {
        if (u < 1408) { const int kt = u & 15, ct = u >> 4, c0 = ct * 64;
            const int cc = c0 < DFF ? c0 : c0 - DFF; const int r0 = (cc >> 7) * 256 + (c0 < DFF ? 0 : 128) + (cc & 127);
            return TileD{wup + (size_t)kt * 64 * 5632 + c0, WUP + (size_t)r0 * 1024 + kt * 64, 5632, 1024}; }
        const int v = u - 1408, kt = v % 44, ct = v / 44; return TileD{wdn + (size_t)kt * 64 * 1024 + ct * 64, WDN + (size_t)ct * 64 * DFF + kt * 64, 1024, DFF}; } };
template <class TD> __device__ __forceinline__ void convert_tiles(const Frame& F, int ntiles, const TD& td) {
    LAS float* tile = (LAS float*)F.lds;
    const int tx = F.tid & 63, ty = F.tid >> 6, n = F.tid >> 3, kk = (F.tid & 7) * 8;
    for (int u0 = F.bid; u0 < ntiles; u0 += 4 * F.G) {
        float v[4][8];
#pragma unroll
        for (int j = 0; j < 4; ++j) { const int u = u0 + j * F.G; if (u < ntiles) { const TileD d = td(u);
#pragma unroll
                for (int i = 0; i < 8; ++i) v[j][i] = d.src[(size_t)(ty + 8 * i) * d.lds_ + tx]; } }
#pragma unroll
        for (int j = 0; j < 4; ++j) { if (u0 + j * F.G < ntiles) {
#pragma unroll
                for (int i = 0; i < 8; ++i) tile[j * 4160 + (ty + 8 * i) * 65 + tx] = v[j][i]; } }
        __syncthreads();
#pragma unroll
        for (int j = 0; j < 4; ++j) { const int u = u0 + j * F.G; if (u < ntiles) { const TileD d = td(u); const LAS float* t = tile + j * 4160;
                u32x4 w; w.x = cvt_pk_bf16(t[(kk + 0) * 65 + n], t[(kk + 1) * 65 + n]); w.y = cvt_pk_bf16(t[(kk + 2) * 65 + n], t[(kk + 3) * 65 + n]);
                w.z = cvt_pk_bf16(t[(kk + 4) * 65 + n], t[(kk + 5) * 65 + n]); w.w = cvt_pk_bf16(t[(kk + 6) * 65 + n], t[(kk + 7) * 65 + n]);
                *(u32x4*)(d.dst + (size_t)n * d.ldd + kk) = w; } }
        __syncthreads();
    }
}
__device__ __forceinline__ void convert_mixer_weights(const Frame& F, const Params& p, int layer) {
    const MixerTiles td{layer == 0 ? p.ret_w_in : p.ml_w_in, layer == 0 ? p.ret_w_out : p.ml_w_out, (bf16_t*)(p.ws + OFF_WIN), (bf16_t*)(p.ws + OFF_WOUT), layer == 0 ? 6144 : 6152};
    convert_tiles(F, 2048, td);
}
struct FfnTilesDn { FfnTiles t; __device__ __forceinline__ TileD operator()(int u) const { return t(u + 1408); } };
__device__ __forceinline__ void convert_ffn_weights(const Frame& F, const Params& p, int layer, int part) {
    const FfnTiles td{p.up_w + (size_t)layer * 1024 * 5632, p.dn_w + (size_t)layer * 2816 * 1024, (bf16_t*)(p.ws + OFF_WUP), (bf16_t*)(p.ws + OFF_WDN)};
    if (part == 0) convert_tiles(F, 1408, td); else { const FfnTilesDn tdn{td}; convert_tiles(F, 704, tdn); }
}

__device__ __forceinline__ void prologue_phase(const Frame& F, const Params& p) {
    float* MOD = (float*)(p.ws + OFF_SM + SM_MOD);
    LAS float* red = (LAS float*)F.lds;
    for (int u = F.bid; u < 192; u += F.G) {
        const int l = u / 96, cgp = u % 96, cq = F.tid & 15, kg = F.tid >> 4;
        const float* w = p.ada_w + (size_t)l * 1024 * 6144 + cgp * 64 + cq * 4;
        f32x4 a = {0.f, 0.f, 0.f, 0.f};
#pragma unroll 8
        for (int k = kg * 32; k < kg * 32 + 32; ++k) { const float cv = p.c[k]; const float ca = siluf(cv); a += ca * *(const f32x4*)(w + (size_t)k * 6144); }
        __syncthreads();
#pragma unroll
        for (int e = 0; e < 4; ++e) red[kg * 64 + cq * 4 + e] = a[e];
        __syncthreads();
        if (F.tid < 64) { float s = 0.f; for (int k = 0; k < 32; ++k) s += red[k * 64 + F.tid]; MOD[l * 6144 + cgp * 64 + F.tid] = s + p.ada_b[l * 6144 + cgp * 64 + F.tid]; }
    }
    const int gt = F.bid * 512 + F.tid, gn = F.G * 512;
    if (gt < 128) ((float*)(p.ws + OFF_SM + SM_IFQ))[gt] = powf(10000.0f, -(float)(2 * gt) / 256.0f);
    float* RB = (float*)(p.ws + OFF_SM + SM_RB); float* CB = (float*)(p.ws + OFF_SM + SM_CB); float* XS = (float*)(p.ws + OFF_SM + SM_XS); float* WK = (float*)(p.ws + OFF_SM + SM_WK);
    for (int e = gt; e < 4 * S_; e += gn) { const int h = e >> 14, t = e & (S_ - 1), i = t & 255; const float lg = logf(1.0f - exp2f(-5.0f - (float)h));
        RB[e] = (float)i * lg; CB[e] = -(float)i * lg; XS[e] = expf((float)(i + 1) * lg); WK[e] = expf((float)(255 - i) * lg); }
    if (gt < 256) { const int h = gt >> 6; const float lg = logf(1.0f - exp2f(-5.0f - (float)h)); ((float*)(p.ws + OFF_SM + SM_SCP))[gt] = expf(256.0f * lg); ((float*)(p.ws + OFF_SM + SM_SCN))[gt] = 1.0f; }
}

template <bool GATES> __device__ __forceinline__ void norm_phase(const Frame& F, const Params& p, const float* xin, const float* g, const float* sh, const float* sc) {
    bf16_t* H = (bf16_t*)(p.ws + OFF_H);
    LAS float* wg = (LAS float*)F.lds;
    if (GATES) { __syncthreads(); for (int e = F.tid; e < 8192; e += 512) wg[e] = p.ml_w_in[(size_t)(e >> 3) * 6152 + 6144 + (e & 7)]; __syncthreads(); }
    float* LI = (float*)(p.ws + OFF_SM + SM_LI); float* LF = (float*)(p.ws + OFF_SM + SM_LF);
    f32x4 gv[4], scv[4], shv[4];
#pragma unroll
    for (int j = 0; j < 4; ++j) { const int c = F.lane * 4 + 256 * j; gv[j] = *(const f32x4*)(g + c); scv[j] = *(const f32x4*)(sc + c); shv[j] = *(const f32x4*)(sh + c); }
    for (int row0 = (F.bid * 8 + F.wid) * 4; row0 < S_; row0 += F.G * 8 * 4) {
        f32x4 xa[4][4];
#pragma unroll
        for (int rr = 0; rr < 4; ++rr)
#pragma unroll
            for (int j = 0; j < 4; ++j) xa[rr][j] = *(const f32x4*)(xin + (size_t)(row0 + rr) * 1024 + F.lane * 4 + 256 * j);
#pragma unroll
        for (int rr = 0; rr < 4; ++rr) {
        const int row = row0 + rr; f32x4 xv[4]; float ss = 0.f;
#pragma unroll
        for (int j = 0; j < 4; ++j) { xv[j] = xa[rr][j]; ss += xv[j][0] * xv[j][0] + xv[j][1] * xv[j][1] + xv[j][2] * xv[j][2] + xv[j][3] * xv[j][3]; }
        ss = wave_sum(ss); const float rstd = rsqrtf(ss * (1.0f / 1024.0f) + EPS);
        float gp[8];
        if (GATES) {
#pragma unroll
            for (int k = 0; k < 8; ++k) gp[k] = 0.f; }
#pragma unroll
        for (int j = 0; j < 4; ++j) { f32x4 hv;
#pragma unroll
            for (int e = 0; e < 4; ++e) hv[e] = xv[j][e] * rstd * gv[j][e] * (1.0f + scv[j][e]) + shv[j][e];
            u32x2 w; w.x = cvt_pk_bf16(hv[0], hv[1]); w.y = cvt_pk_bf16(hv[2], hv[3]);
            *(u32x2*)(H + (size_t)row * 1024 + F.lane * 4 + 256 * j) = w;
            if (GATES) {
#pragma unroll
                for (int e = 0; e < 4; ++e) { const LAS float* wr_ = wg + (F.lane * 4 + 256 * j + e) * 8;
#pragma unroll
                    for (int k = 0; k < 8; ++k) gp[k] += hv[e] * wr_[k]; } } }
        if (GATES) {
#pragma unroll
            for (int k = 0; k < 8; ++k) gp[k] = wave_sum(gp[k]);
            if (F.lane == 0) {
#pragma unroll
                for (int k = 0; k < 4; ++k) { LI[(size_t)row * 4 + k] = gp[k] + p.ml_bg[k]; const float v = gp[4 + k] + p.ml_bg[4 + k]; LF[(size_t)row * 4 + k] = fminf(v, 0.f) - log1pf(expf(-fabsf(v))); } } }
        }
    }
}

__device__ __forceinline__ void prep_a(const Frame& F, const Params& p) {
    const float* LI = (const float*)(p.ws + OFF_SM + SM_LI); const float* LF = (const float*)(p.ws + OFF_SM + SM_LF);
    float* GG = (float*)(p.ws + OFF_SM + SM_GG); float* CB = (float*)(p.ws + OFF_SM + SM_CB); float* PM = (float*)(p.ws + OFF_SM + SM_PM); float* WK = (float*)(p.ws + OFF_SM + SM_WK);
    float* GL = (float*)(p.ws + OFF_SM + SM_GL); float* ML = (float*)(p.ws + OFF_SM + SM_ML);
    for (int u = F.bid; u < 256 && F.wid == 0; u += F.G) {
        const int h = u >> 6, ch = u & 63, t0 = ch * 256 + F.lane * 4;
        float g[4], cb[4], pm[4]; float run = 0.f;
#pragma unroll
        for (int e = 0; e < 4; ++e) { run += LF[(size_t)(t0 + e) * 4 + h]; g[e] = run; }
        float incl = run;
        for (int o = 1; o < 64; o <<= 1) { const float v = __shfl_up(incl, o); if (F.lane >= o) incl += v; }
        const float excl = incl - run;
        float lm = -INFINITY;
#pragma unroll
        for (int e = 0; e < 4; ++e) { g[e] += excl; cb[e] = LI[(size_t)(t0 + e) * 4 + h] - g[e]; lm = fmaxf(lm, cb[e]); pm[e] = lm; }
        float im = lm;
        for (int o = 1; o < 64; o <<= 1) { const float v = __shfl_up(im, o); if (F.lane >= o) im = fmaxf(im, v); }
        float em = __shfl_up(im, 1); if (F.lane == 0) em = -INFINITY;
#pragma unroll
        for (int e = 0; e < 4; ++e) pm[e] = fmaxf(pm[e], em);
        const float gL = __shfl(g[3], 63), pml = __shfl(pm[3], 63);
#pragma unroll
        for (int e = 0; e < 4; ++e) { const size_t o = (size_t)h * S_ + t0 + e; GG[o] = g[e]; CB[o] = cb[e]; PM[o] = pm[e]; WK[o] = expf(cb[e] - pml); }
        if (F.lane == 0) { GL[u] = gL; ML[u] = gL + pml; }
    }
}
__device__ __forceinline__ void prep_b(const Frame& F, const Params& p) {
    const float* GG = (const float*)(p.ws + OFF_SM + SM_GG); const float* PM = (const float*)(p.ws + OFF_SM + SM_PM);
    const float* GL = (const float*)(p.ws + OFF_SM + SM_GL); const float* ML = (const float*)(p.ws + OFF_SM + SM_ML);
    float* RB = (float*)(p.ws + OFF_SM + SM_RB); float* XS = (float*)(p.ws + OFF_SM + SM_XS); float* EM = (float*)(p.ws + OFF_SM + SM_EM);
    float* SCP = (float*)(p.ws + OFF_SM + SM_SCP); float* SCN = (float*)(p.ws + OFF_SM + SM_SCN);
    for (int u = F.bid; u < 256 && F.wid == 0; u += F.G) {
        const int h = u >> 6, ch = u & 63;
        const float glv = GL[h * 64 + F.lane], mlv = ML[h * 64 + F.lane];
        float m = 0.f;
#pragma unroll 8
        for (int c2 = 0; c2 < 64; ++c2) { const float gl = __shfl(glv, c2), ml = __shfl(mlv, c2); if (c2 < ch) m = fmaxf(gl + m, ml); }
#pragma unroll
        for (int e = 0; e < 4; ++e) { const size_t o = (size_t)h * S_ + ch * 256 + F.lane * 4 + e; const float mx = fmaxf(m, PM[o]); RB[o] = -mx; XS[o] = expf(m - mx); EM[o] = expf(-(GG[o] + mx)); }
        if (F.lane == 0) { const float mn = fmaxf(GL[u] + m, ML[u]); SCP[u] = expf(GL[u] + m - mn); SCN[u] = expf(ML[u] - mn); }
    }
}

template <int KIND> __device__ __forceinline__ void r3_pass(const Frame& F, const Params& p, int pair) {
    bf16_t* Qb = (bf16_t*)(p.ws + OFF_Q); bf16_t* Kb = (bf16_t*)(p.ws + OFF_K); bf16_t* KWT = (bf16_t*)(p.ws + OFF_KWT);
    const bf16_t* QKH = (const bf16_t*)(p.ws + OFF_SM + SM_QKH); const float* WK = (const float*)(p.ws + OFF_SM + SM_WK); float* NLOC = (float*)(p.ws + OFF_SM + SM_NLOC);
    LAS bf16_t* T = (LAS bf16_t*)F.lds;
    const int tr = F.tid >> 3, tc = (F.tid & 7) * 8;
    for (int u = F.bid; u < 1024; u += F.G) {
        const int ch = u >> 4, pc0 = (u & 15) * 64; const bool isk = pc0 >= 512;
        if (KIND == 0 && !isk) continue;
        const int bc0 = pc0 & 511, h2 = bc0 >> 8, h = 2 * pair + h2;
        bf16_t* buf = (isk ? Kb : Qb) + (size_t)h2 * S_ * 256 + (bc0 & 255) + tc;
        float cw[4][8], cbias[8];
        if (KIND == 1) { const int gc = (isk ? 1024 : 0) + pair * 512 + bc0 + tc;
#pragma unroll
            for (int j = 0; j < 4; ++j) { const f32x4 a = *(const f32x4*)(p.ml_cw + j * 2048 + gc), b = *(const f32x4*)(p.ml_cw + j * 2048 + gc + 4);
#pragma unroll
                for (int e = 0; e < 4; ++e) { cw[j][e] = a[e]; cw[j][4 + e] = b[e]; } }
            const f32x4 a = *(const f32x4*)(p.ml_cb + gc), b = *(const f32x4*)(p.ml_cb + gc + 4);
#pragma unroll
            for (int e = 0; e < 4; ++e) { cbias[e] = a[e]; cbias[4 + e] = b[e]; } }
        float nsum = 0.f;
        u32x4 nx[4]; float wkn = 0.f;
#define R3_LOAD(dst, s_) do { const int t_ = ch * 256 + (s_) * 64 + tr; dst[0] = *(const u32x4*)(buf + (size_t)t_ * 256); \
            if (KIND == 1) { _Pragma("unroll") for (int d = 1; d <= 3; ++d) { const int tt = t_ - d; u32x4 w_ = {0u, 0u, 0u, 0u}; \
                if (tr - d >= 0) w_ = *(const u32x4*)(buf + (size_t)tt * 256); \
                else if (tt >= 0) w_ = *(const u32x4*)(QKH + ((size_t)(tt >> 6) * 3 + ((tt & 63) - 61)) * 1024 + pc0 + tc); \
                dst[d] = w_; } } } while (0)
        R3_LOAD(nx, 0); if (isk) wkn = WK[(size_t)h * S_ + ch * 256 + tr];
        for (int s = 0; s < 4; ++s) {
            const int t = ch * 256 + s * 64 + tr;
            u32x4 cu[4];
#pragma unroll
            for (int d = 0; d < 4; ++d) cu[d] = nx[d];
            const float wk = wkn;
            if (s < 3) { R3_LOAD(nx, s + 1); if (isk) wkn = WK[(size_t)h * S_ + t + 64]; }
            float v[8]; unpack8(cu[0], v);
            if (KIND == 1) {
                float o[8];
#pragma unroll
                for (int e = 0; e < 8; ++e) o[e] = cbias[e] + cw[3][e] * v[e];
#pragma unroll
                for (int d = 1; d <= 3; ++d) { float x[8]; unpack8(cu[d], x);
#pragma unroll
                    for (int e = 0; e < 8; ++e) o[e] += cw[3 - d][e] * x[e]; }
#pragma unroll
                for (int e = 0; e < 8; ++e) { v[e] = siluf(o[e]); if (isk) v[e] *= 0.0625f; }
                __syncthreads();
                u32x4 w; w.x = cvt_pk_bf16(v[0], v[1]); w.y = cvt_pk_bf16(v[2], v[3]); w.z = cvt_pk_bf16(v[4], v[5]); w.w = cvt_pk_bf16(v[6], v[7]);
                *(u32x4*)(buf + (size_t)t * 256) = w;
            }
            if (isk) {
#pragma unroll
                for (int e = 0; e < 8; e += 2) { const unsigned w = cvt_pk_bf16(v[e] * wk, v[e + 1] * wk); T[(tc + e) * 72 + tr] = (bf16_t)(w & 0xffffu); T[(tc + e + 1) * 72 + tr] = (bf16_t)(w >> 16); }
                __syncthreads();
                const int col = F.tid >> 3, seg = F.tid & 7;
                const u32x4 w = *(const LAS u32x4*)(T + col * 72 + seg * 8);
                *(u32x4*)(KWT + ((size_t)(h2 * 64 + ch) * 256 + (bc0 & 255) + col) * 256 + s * 64 + seg * 8) = w;
                float x[8]; unpack8(w, x); nsum += ((x[0] + x[1]) + (x[2] + x[3])) + ((x[4] + x[5]) + (x[6] + x[7]));
                __syncthreads();
            }
        }
#undef R3_LOAD
        if (KIND == 1 && isk) { nsum += __shfl_xor(nsum, 1); nsum += __shfl_xor(nsum, 2); nsum += __shfl_xor(nsum, 4);
            if ((F.tid & 7) == 0) NLOC[((size_t)h * 64 + ch) * 256 + (bc0 & 255) + (F.tid >> 3)] = nsum; }
    }
}

template <int KIND> __device__ __forceinline__ void scan_phase(const Frame& F, const Params& p, int pair) {
    unsigned* KV = (unsigned*)(p.ws + OFF_KVT);
    const float* SCP = (const float*)(p.ws + OFF_SM + SM_SCP); const float* SCN = (const float*)(p.ws + OFF_SM + SM_SCN);
    for (int e0 = F.bid * 512; e0 < 131072; e0 += F.G * 512) {
        const int h2 = e0 >> 16, h = 2 * pair + h2; unsigned* base = KV + (size_t)h2 * 64 * 65536 + (e0 & 65535) + F.tid;
        float s0 = 0.f, s1 = 0.f;
#pragma unroll 1
        for (int cb = 0; cb < 64; cb += 64) {
            unsigned v[64];
#pragma unroll
            for (int c = 0; c < 64; ++c) v[c] = base[(size_t)(cb + c) * 65536];
#pragma unroll
            for (int c = 0; c < 64; ++c) { base[(size_t)(cb + c) * 65536] = cvt_pk_bf16(s0, s1); const float a = SCP[h * 64 + cb + c], b = SCN[h * 64 + cb + c]; s0 = a * s0 + b * bf_lo(v[c]); s1 = a * s1 + b * bf_hi(v[c]); }
        }
    }
    if (KIND == 1) {
        const float* NLOC = (const float*)(p.ws + OFF_SM + SM_NLOC); const bf16_t* Qb = (const bf16_t*)(p.ws + OFF_Q); float* DC = (float*)(p.ws + OFF_SM + SM_DC);
        LAS float* nv = (LAS float*)F.lds;
        for (int u = F.bid; u < 256; u += F.G) {
            const int h2 = u & 1, hv = (u >> 1) & 1, ch = u >> 2, h = 2 * pair + h2;
            __syncthreads();
            if (F.tid < 256) { float n = 0.f;
#pragma unroll 1
                for (int cb = 0; cb < 64; cb += 16) { if (cb >= ch) break; float x[16];
#pragma unroll
                    for (int c = 0; c < 16; ++c) x[c] = (cb + c < ch) ? NLOC[((size_t)h * 64 + cb + c) * 256 + F.tid] : 0.f;
#pragma unroll
                    for (int c = 0; c < 16; ++c) if (cb + c < ch) n = SCP[h * 64 + cb + c] * n + SCN[h * 64 + cb + c] * x[c]; }
                nv[F.tid] = n; }
            __syncthreads();
            const f32x4 nn = *(const LAS f32x4*)(nv + F.lane * 4);
#pragma unroll 1
            for (int r0 = 0; r0 < 16; r0 += 8) { const int t0 = ch * 256 + hv * 128 + F.wid * 16 + r0; u32x2 w[8];
#pragma unroll
                for (int r = 0; r < 8; ++r) w[r] = *(const u32x2*)(Qb + ((size_t)h2 * S_ + t0 + r) * 256 + F.lane * 4);
#pragma unroll
                for (int r = 0; r < 8; ++r) { float d = bf_lo(w[r].x) * nn[0] + bf_hi(w[r].x) * nn[1] + bf_lo(w[r].y) * nn[2] + bf_hi(w[r].y) * nn[3];
                    d = wave_sum(d); if (F.lane == 0) DC[(size_t)(t0 + r) * 4 + h] = d; } }
        }
    }
}

__device__ __forceinline__ void gn_pass(const Frame& F, const Params& p) {
    bf16_t* Z = (bf16_t*)(p.ws + OFF_Z); const float* ST = (const float*)(p.ws + OFF_SM + SM_ST);
    for (int u0 = (F.bid * 8 + F.wid) * 4; u0 < S_ * 4; u0 += F.G * 8 * 4) {
        f32x4 st[4][4]; u32x4 zz[4]; f32x4 g0[4], g1[4];
#pragma unroll
        for (int j = 0; j < 4; ++j) { const int u = u0 + j; const f32x4* sp = (const f32x4*)(ST + (size_t)u * 16);
            st[j][0] = sp[0]; st[j][1] = sp[1]; st[j][2] = sp[2]; st[j][3] = sp[3];
            zz[j] = *(const u32x4*)(Z + (size_t)(u >> 2) * 2048 + (u & 3) * 512 + F.lane * 8);
            g0[j] = *(const f32x4*)(p.ml_gn + (u & 3) * 512 + F.lane * 8); g1[j] = *(const f32x4*)(p.ml_gn + (u & 3) * 512 + F.lane * 8 + 4); }
#pragma unroll
        for (int j = 0; j < 4; ++j) { const int u = u0 + j; const f32x4 a = st[j][0], b = st[j][1], c = st[j][2], d = st[j][3];
            const float s = (a[0] + a[2]) + (b[0] + b[2]) + (c[0] + c[2]) + (d[0] + d[2]), q = (a[1] + a[3]) + (b[1] + b[3]) + (c[1] + c[3]) + (d[1] + d[3]);
            const float mu = s * (1.0f / 512.0f), rstd = rsqrtf(fmaxf(q * (1.0f / 512.0f) - mu * mu, 0.f) + EPS);
            float y[8]; unpack8(zz[j], y); f32x4 o0, o1;
#pragma unroll
            for (int e = 0; e < 4; ++e) { o0[e] = (y[e] - mu) * rstd * g0[j][e]; o1[e] = (y[4 + e] - mu) * rstd * g1[j][e]; }
            *(u32x4*)(Z + (size_t)(u >> 2) * 2048 + (u & 3) * 512 + F.lane * 8) = pack8(o0, o1); }
    }
}

__device__ __forceinline__ void ffn_fix_panel(const Frame& F, const Params& p, int layer, int pm) {
    const bf16_t* FH = (const bf16_t*)(p.ws + OFF_FH); bf16_t* ACT = (bf16_t*)(p.ws + OFF_ACT);
    const float* cw = p.fcw + (size_t)layer * 3 * 5632; const float* cb = p.fcb + (size_t)layer * 5632;
    if (F.tid < 352) {
        const int chn = F.tid * 8, pn = chn >> 7, cc = chn & 127;
        f32x4 bq[2][2], a0[2][2], a1[2][2], a2[2][2];
#pragma unroll
        for (int bj = 0; bj < 2; ++bj)
#pragma unroll
            for (int v = 0; v < 2; ++v) { const int wch = bj * DFF + chn + 4 * v;
                bq[bj][v] = *(const f32x4*)(cb + wch); a0[bj][v] = *(const f32x4*)(cw + wch); a1[bj][v] = *(const f32x4*)(cw + 5632 + wch); a2[bj][v] = *(const f32x4*)(cw + 2 * 5632 + wch); }
#pragma unroll 1
        for (int gb = 0; gb < 2; ++gb) {
            u32x4 h[2][2][4];
#pragma unroll
            for (int gi = 0; gi < 2; ++gi) { const int gq = pm * 4 + gb * 2 + gi;
#pragma unroll
                for (int bj = 0; bj < 2; ++bj) { const int col = pn * 256 + bj * 128 + cc; const u32x4 z = {0u, 0u, 0u, 0u};
                    h[gi][bj][0] = gq > 0 ? *(const u32x4*)(FH + ((size_t)(gq - 1) * 4 + 0) * 5632 + col) : z;
                    h[gi][bj][1] = gq > 0 ? *(const u32x4*)(FH + ((size_t)(gq - 1) * 4 + 1) * 5632 + col) : z;
                    h[gi][bj][2] = *(const u32x4*)(FH + ((size_t)gq * 4 + 2) * 5632 + col);
                    h[gi][bj][3] = *(const u32x4*)(FH + ((size_t)gq * 4 + 3) * 5632 + col); } }
#pragma unroll
            for (int gi = 0; gi < 2; ++gi) { const int gq = pm * 4 + gb * 2 + gi;
#pragma unroll
                for (int r = 0; r < 2; ++r) {
                    float ua[8], ub[8];
#pragma unroll
                    for (int bj = 0; bj < 2; ++bj) { float* uo = bj ? ub : ua; float x0[8], x1[8], x2[8];
                        unpack8(h[gi][bj][r], x0); unpack8(h[gi][bj][r + 1], x1); unpack8(h[gi][bj][r + 2], x2);
#pragma unroll
                        for (int v = 0; v < 2; ++v)
#pragma unroll
                            for (int e = 0; e < 4; ++e) uo[4 * v + e] = bq[bj][v][e] + a0[bj][v][e] * x0[4 * v + e] + a1[bj][v][e] * x1[4 * v + e] + a2[bj][v][e] * x2[4 * v + e]; }
                    f32x4 o0, o1;
#pragma unroll
                    for (int e = 0; e < 4; ++e) { o0[e] = siluf(ua[e]) * ub[e]; o1[e] = siluf(ua[4 + e]) * ub[4 + e]; }
                    *(u32x4*)(ACT + (size_t)(gq * 64 + r) * DFF + chn) = pack8(o0, o1); } }
        }
    }
}

__device__ __forceinline__ void final_norm(const Frame& F, const Params& p) {
    f32x4 g[4];
#pragma unroll
    for (int j = 0; j < 4; ++j) g[j] = *(const f32x4*)(p.fin_g + F.lane * 4 + 256 * j);
    for (int row0 = (F.bid * 8 + F.wid) * 8; row0 < S_; row0 += F.G * 8 * 8) {
        f32x4 xa[8][4];
#pragma unroll
        for (int rr = 0; rr < 8; ++rr)
#pragma unroll
            for (int j = 0; j < 4; ++j) xa[rr][j] = *(const f32x4*)(p.out + (size_t)(row0 + rr) * 1024 + F.lane * 4 + 256 * j);
#pragma unroll
        for (int rr = 0; rr < 8; ++rr) { float ss = 0.f;
#pragma unroll
            for (int j = 0; j < 4; ++j) ss += xa[rr][j][0] * xa[rr][j][0] + xa[rr][j][1] * xa[rr][j][1] + xa[rr][j][2] * xa[rr][j][2] + xa[rr][j][3] * xa[rr][j][3];
            ss = wave_sum(ss); const float rstd = rsqrtf(ss * (1.0f / 1024.0f) + EPS);
#pragma unroll
            for (int j = 0; j < 4; ++j) *(f32x4*)(p.out + (size_t)(row0 + rr) * 1024 + F.lane * 4 + 256 * j) = xa[rr][j] * rstd * g[j]; }
    }
}

#define XB_TMO      128
#define XB_XCNT(j)  (256  + 64 * (j))
#define XB_XSUB(j)  (1280 + 64 * (j))
#define XB_XGEN(j)  (2304 + 64 * (j))
#define XB_TOP      3328
#define XB_TOPGEN   3392
#define XCD_BAR_WORDS 3456
#define XB_SPIN_CAP (1u << 18)
__device__ __forceinline__ unsigned xb_ld(unsigned* p)              { return __hip_atomic_load(p, __ATOMIC_RELAXED, __HIP_MEMORY_SCOPE_AGENT); }
__device__ __forceinline__ unsigned xb_add(unsigned* p, unsigned v) { return __hip_atomic_fetch_add(p, v, __ATOMIC_RELAXED, __HIP_MEMORY_SCOPE_AGENT); }
__device__ __forceinline__ unsigned xb_xcc_id() { return (unsigned)__builtin_amdgcn_s_getreg((3 << 11) | 20) & 0xFu; }
#define XB_SPIN(cond, bar) do { unsigned _sp = 0; while (cond) { __builtin_amdgcn_s_sleep(1); \
    if ((++_sp & 255u) == 0u) { if (xb_ld(&(bar)[XB_TMO])) break; if (_sp > XB_SPIN_CAP) { atomicAdd(&(bar)[XB_TMO], 1u); break; } } } } while (0)
struct XcdBarrier { unsigned* bar; unsigned x; volatile LAS unsigned* st; };
__device__ __forceinline__ XcdBarrier xcd_barrier_post(unsigned* bar, volatile LAS unsigned* st) {
    XcdBarrier b; b.bar = bar; b.x = xb_xcc_id(); b.st = st;
    if (threadIdx.x == 0) (void)xb_add(&bar[XB_XCNT(b.x)], 1u);
    return b;
}
__device__ __forceinline__ void xcd_barrier_complete(unsigned* bar, unsigned x, unsigned& nloc, unsigned& nx) {
    const unsigned G = gridDim.x * gridDim.y * gridDim.z;
    unsigned sum, cnt, mine, sp = 0u;
    for (;;) {
        sum = 0u; cnt = 0u; mine = 0u;
#pragma unroll
        for (unsigned j = 0; j < 16; ++j) { const unsigned c = xb_ld(&bar[XB_XCNT(j)]); sum += c; cnt += (c > 0u) ? 1u : 0u; mine = (j == x) ? c : mine; }
        if (sum == G) break;
        __builtin_amdgcn_s_sleep(1);
        if ((++sp & 255u) == 0u) { if (xb_ld(&bar[XB_TMO])) break; if (sp > XB_SPIN_CAP) { atomicAdd(&bar[XB_TMO], 1u); break; } }
    }
    nloc = mine > 0u ? mine : 1u; nx = cnt > 0u ? cnt : 1u;
}
__device__ __forceinline__ void xcd_barrier(const XcdBarrier& b) {
    asm volatile("s_waitcnt vmcnt(0)" ::: "memory");
    __syncthreads();
    if (threadIdx.x == 0) {
        unsigned* bar = b.bar;
        __builtin_amdgcn_s_waitcnt(0);
        unsigned nloc = b.st[0], nx = b.st[1];
        if (nloc == 0u) { xcd_barrier_complete(bar, b.x, nloc, nx); b.st[0] = nloc; b.st[1] = nx; }
        const unsigned old = xb_add(&bar[XB_XSUB(b.x)], 1u);
        const unsigned gen = old / nloc;
        if (old + 1u == (gen + 1u) * nloc) {
            __builtin_amdgcn_fence(__ATOMIC_RELEASE, "agent");
            asm volatile("s_waitcnt vmcnt(0)" ::: "memory");
            const unsigned og = xb_add(&bar[XB_TOP], 1u);
            const unsigned tg = og / nx;
            if (og + 1u == (tg + 1u) * nx) xb_add(&bar[XB_TOPGEN], 1u);
            else XB_SPIN(xb_ld(&bar[XB_TOPGEN]) == tg, bar);
            __builtin_amdgcn_fence(__ATOMIC_ACQUIRE, "agent");
            xb_add(&bar[XB_XGEN(b.x)], 1u);
            asm volatile("s_waitcnt vmcnt(0)" ::: "memory");
        } else {
            XB_SPIN(xb_ld(&bar[XB_XGEN(b.x)]) == gen, bar);
            __builtin_amdgcn_fence(__ATOMIC_ACQUIRE, "agent");
            asm volatile("s_waitcnt vmcnt(0)" ::: "memory");
        }
    }
    __syncthreads();
}

constexpr int N_PHASES = 33;
#ifdef ONLY_PH
#define PH_ON(k) ((k) == ONLY_PH)
#else
#define PH_ON(k) (p.ph_lo <= (k) && (k) < p.ph_hi)
#endif
#ifndef PROBE_CAT
#define PROBE_CAT 0
#endif
#if PROBE_CAT
#define RT() __builtin_amdgcn_s_memrealtime()
#define PH_END(k) do { if ((k) + 1 < p.ph_hi) { __syncthreads(); const unsigned long long t0_ = RT(); xcd_barrier(xbar); if (PROBE_CAT == 2) tprobe += RT() - t0_; } } while (0)
#define GT0 const unsigned long long tg0_ = RT();
#define GT1(c) if (PROBE_CAT == 1 || PROBE_CAT == (c)) tprobe += RT() - tg0_;
#else
#define PH_END(k) do { if ((k) + 1 < p.ph_hi) xcd_barrier(xbar); } while (0)
#define GT0
#define GT1(c)
#endif

typedef gm::SchedPlain SP;
template <int KIND> __device__ __forceinline__ SP sched_qk(const Frame& F, const Params& p, int pair) {
    const char* H = (const char*)(p.ws + OFF_H); const char* WIN = (const char*)(p.ws + OFF_WIN);
    return SP{H, WIN + (size_t)(pair * 512) * 2048, WIN + (size_t)(1024 + pair * 512) * 2048, 64, 4, 2, F.G, F.bid, (size_t)256 * 2048, (size_t)256 * 2048, 256, 0}; }
__device__ __forceinline__ SP sched_vt(const Frame& F, const Params& p, int pair) {
    const char* H = (const char*)(p.ws + OFF_H); const char* WIN = (const char*)(p.ws + OFF_WIN);
    return SP{WIN + (size_t)(2048 + pair * 1024) * 2048, H, H, 4, 64, 64, F.G, F.bid, (size_t)256 * 2048, (size_t)256 * 2048, 256, 1}; }
__device__ __forceinline__ SP sched_g(const Frame& F, const Params& p, int pair) {
    const char* H = (const char*)(p.ws + OFF_H); const char* WIN = (const char*)(p.ws + OFF_WIN);
    return SP{H, WIN + (size_t)(4096 + pair * 1024) * 2048, WIN, 64, 4, 4, F.G, F.bid, (size_t)256 * 2048, (size_t)256 * 2048, 2048, 0}; }
template <int KIND> __device__ __forceinline__ EpiQK<KIND> epi_qk(const Params& p, int pair) {
    return EpiQK<KIND>{(bf16_t*)(p.ws + OFF_Q), (bf16_t*)(p.ws + OFF_K), p.pos, (const float*)(p.ws + OFF_SM + SM_IFQ), (bf16_t*)(p.ws + OFF_SM + SM_QKH), (bf16_t*)(p.ws + OFF_KWT), (const float*)(p.ws + OFF_SM + SM_WK), pair}; }
template <int KIND> __device__ __forceinline__ EpiG<KIND> epi_g(const Params& p, int pair) {
    return EpiG<KIND>{(bf16_t*)(p.ws + OFF_Z), (float*)(p.ws + OFF_SM + SM_ST), KIND == 0 ? p.ret_gn : p.ml_gn, (const float*)(p.ws + OFF_SM + SM_PS), (const float*)(p.ws + OFF_SM + SM_XS),
                      (const float*)(p.ws + OFF_SM + SM_DC), (const float*)(p.ws + OFF_SM + SM_EM), pair}; }

template <int KIND, int PAIR> __device__ __forceinline__ void pair_core(const Frame& F0, const Params& p, const XcdBarrier& xbar, int base, unsigned long long& tprobe) {
    unsigned char* ws = p.ws; constexpr int pair = PAIR; constexpr int R = (KIND == 1) ? 1 : 0;
    if (KIND == 1) { if (PH_ON(base + 0)) { const Frame F = fresh(F0);
        if (pair == 0) prep_b(F, p);
        { GT0 r3_pass<KIND>(F, p, pair); GT1(9) }
        PH_END(base + 0); } }
    if (PH_ON(base + R)) { const Frame F = fresh(F0);
        { SchedKV S{(const char*)(ws + OFF_VT), (const char*)(ws + OFF_KWT), F.G, F.bid}; EpiPlain E{(bf16_t*)(ws + OFF_KVT), 256};
          { GT0 gm::gemm_phase<EpiPlain, SchedKV, false>(F.lds, gm::GP{256, 256, 4, 4}, S, E); GT1(5) } }
        { SchedS S{(const char*)(ws + OFF_Q), (const char*)(ws + OFF_K), F.G, (F.bid + 128) % F.G};
          EpiS<KIND == 1> E{(bf16_t*)(ws + OFF_P), (const float*)(ws + OFF_SM + SM_RB), (const float*)(ws + OFF_SM + SM_CB), (float*)(ws + OFF_SM + SM_PS), pair};
          { GT0 gm::gemm_phase<EpiS<KIND == 1>, SchedS, false>(F.lds, gm::GP{256, 256, 4, 4}, S, E); GT1(5) } }
        PH_END(base + R); }
    if (PH_ON(base + R + 1)) { const Frame F = fresh(F0); { GT0 scan_phase<KIND>(F, p, pair); GT1(10) } PH_END(base + R + 1); }
    if (PH_ON(base + R + 2)) { const Frame F = fresh(F0);
        SchedO S{(const char*)(ws + OFF_Q), (const char*)(ws + OFF_KVT), (const char*)(ws + OFF_P), (const char*)(ws + OFF_VT), F.G, F.bid};
        EpiO<KIND == 0> E{(bf16_t*)(ws + OFF_Z), (const float*)(ws + OFF_SM + SM_XS), (float*)(ws + OFF_SM + SM_ST), pair};
        { GT0 gm::gemm_phase<EpiO<KIND == 0>, SchedO, true>(F.lds, gm::GP{256, 256, 4, 8}, S, E); GT1(5) }
        PH_END(base + R + 2); }
}

template <int KIND> __device__ __forceinline__ void layer_program(const Frame& F0, const Params& p, const XcdBarrier& xbar, int base, unsigned long long& tprobe) {
    constexpr int layer = KIND;
    unsigned char* ws = p.ws; const float* MOD = (const float*)(ws + OFF_SM + SM_MOD) + layer * 6144;
    const char* H = (const char*)(ws + OFF_H);
    if (PH_ON(base)) { const Frame F = fresh(F0);
        { GT0 convert_mixer_weights(F, p, layer); GT1(7) }
        { GT0 norm_phase<KIND == 1>(F, p, layer == 0 ? p.x : p.out, p.ntg + layer * 1024, MOD, MOD + 1024); GT1(8) }
        PH_END(base); }
    if (PH_ON(base + 1)) { const Frame F = fresh(F0);
        gm::SchedMulti S{sched_qk<KIND>(F, p, 0), sched_vt(F, p, 0), sched_vt(F, p, 0), 256, 256, 0, F.G, F.bid};
        EpiMulti<EpiQK<KIND>, EpiPlain, EpiPlain> E{epi_qk<KIND>(p, 0), EpiPlain{(bf16_t*)(ws + OFF_VT), 256}, EpiPlain{(bf16_t*)(ws + OFF_VT), 256}};
        { GT0 gm::gemm_phase<EpiMulti<EpiQK<KIND>, EpiPlain, EpiPlain>, gm::SchedMulti, false>(F.lds, gm::GP{1024, 1024, 16, 16}, S, E); GT1(4) }
        if (KIND == 1) prep_a(F, p);
        PH_END(base + 1); }
    constexpr int PC = (KIND == 1) ? 4 : 3;
    pair_core<KIND, 0>(F0, p, xbar, base + 2, tprobe);
    if (PH_ON(base + 2 + PC)) { const Frame F = fresh(F0);
        gm::SchedMulti S{sched_g(F, p, 0), sched_qk<KIND>(F, p, 1), sched_vt(F, p, 1), 256, 256, 256, F.G, F.bid};
        EpiMulti<EpiG<KIND>, EpiQK<KIND>, EpiPlain> E{epi_g<KIND>(p, 0), epi_qk<KIND>(p, 1), EpiPlain{(bf16_t*)(ws + OFF_VT), 256}};
        { GT0 gm::gemm_phase<EpiMulti<EpiG<KIND>, EpiQK<KIND>, EpiPlain>, gm::SchedMulti, false>(F.lds, gm::GP{1024, 1024, 16, 16}, S, E); GT1(4) }
        PH_END(base + 2 + PC); }
    pair_core<KIND, 1>(F0, p, xbar, base + 3 + PC, tprobe);
    if (PH_ON(base + 3 + 2 * PC)) { const Frame F = fresh(F0);
        SP S = sched_g(F, p, 1); EpiG<KIND> E = epi_g<KIND>(p, 1);
        { GT0 gm::gemm_phase<EpiG<KIND>, SP, false>(F.lds, gm::GP{1024, 1024, 16, 16}, S, E); GT1(4) }
        PH_END(base + 3 + 2 * PC); }
    int k = base + 4 + 2 * PC;
    if (KIND == 1) { if (PH_ON(k)) { const Frame F = fresh(F0); { GT0 gn_pass(F, p); GT1(11) } PH_END(k); } ++k; }
    if (PH_ON(k)) { const Frame F = fresh(F0);
        SP S{(const char*)(ws + OFF_Z), (const char*)(ws + OFF_WOUT), (const char*)(ws + OFF_WOUT), 64, 4, 4, F.G, F.bid, (size_t)256 * 4096, (size_t)256 * 4096, 1024, 0};
        EpiRes E{layer == 0 ? p.x : p.out, p.out, MOD + 2048};
        { GT0 gm::gemm_phase<EpiRes, SP, false>(F.lds, gm::GP{2048, 2048, 32, 32}, S, E); GT1(6) }
        { GT0 convert_ffn_weights(F, p, layer, 0); GT1(7) }
        PH_END(k); }
    ++k;
    if (PH_ON(k)) { const Frame F = fresh(F0); { GT0 convert_ffn_weights(F, p, layer, 1); GT1(7) } { GT0 norm_phase<false>(F, p, p.out, p.nfg + layer * 1024, MOD + 3072, MOD + 4096); GT1(8) } PH_END(k); }
    ++k;
    if (PH_ON(k)) { const Frame F = fresh(F0);
        SP S{H, (const char*)(ws + OFF_WUP), (const char*)(ws + OFF_WUP), 64, 22, 22, F.G, F.bid, (size_t)256 * 2048, (size_t)256 * 2048, DFF, 0};
        EpiUp E{(bf16_t*)(ws + OFF_ACT), (bf16_t*)(ws + OFF_FH), p.fcw + (size_t)layer * 3 * 5632, p.fcb + (size_t)layer * 5632};
        { GT0 gm::gemm_phase<EpiUp, SP, false>(F.lds, gm::GP{1024, 1024, 16, 16}, S, E); GT1(3) }
        PH_END(k); }
    ++k;
    if (PH_ON(k)) { const Frame F = fresh(F0);
        SP S{(const char*)(ws + OFF_ACT), (const char*)(ws + OFF_WDN), (const char*)(ws + OFF_WDN), 64, 4, 4, F.G, F.bid, (size_t)256 * DFF * 2, (size_t)256 * DFF * 2, 1024, 0};
        { GT0 gm::U u; for (int i = 0; S.next(i, u); ++i) ffn_fix_panel(F, p, layer, u.i0);
          asm volatile("s_waitcnt vmcnt(0)" ::: "memory"); __syncthreads(); GT1(11) }
        EpiRes E{p.out, p.out, MOD + 5120};
        { GT0 gm::gemm_phase<EpiRes, SP, false>(F.lds, gm::GP{DFF, DFF, 44, 44}, S, E); GT1(6) }
        PH_END(k); }
}

__global__ void __launch_bounds__(512, 2) fwd_kernel(Params p) {
    extern __shared__ __attribute__((aligned(16))) unsigned char smem[];
    Frame F0; F0.lds = (LAS unsigned char*)smem; F0.G = gridDim.x; F0.bid = blockIdx.x; F0.tid = threadIdx.x; F0.wid = 0; F0.lane = 0;
    cg::grid_group grid = cg::this_grid();
    if (p.ph_hi < 0) grid.sync();
    unsigned long long tprobe = 0;
    volatile LAS unsigned* xst = (volatile LAS unsigned*)(smem + gm::STAGE_BYTES);
    if (threadIdx.x < 4) xst[threadIdx.x] = 0u;
    __syncthreads();
    const XcdBarrier xbar = xcd_barrier_post((unsigned*)(p.ws + OFF_SM + SM_BAR), xst);
    if (PH_ON(0)) { const Frame F = fresh(F0); { GT0 prologue_phase(F, p); GT1(11) } PH_END(0); }
    layer_program<0>(F0, p, xbar, 1, tprobe);
    layer_program<1>(F0, p, xbar, 15, tprobe);
    if (PH_ON(32)) { const Frame F = fresh(F0); { GT0 final_norm(F, p); GT1(11) } }
#if PROBE_CAT
    if (blockIdx.x == 0) { const unsigned long long t0 = RT(); while (RT() - t0 < tprobe) __builtin_amdgcn_s_sleep(8); }
#endif
}

extern "C" void kernel_launch(void* const* d_in, const int* in_sizes, int n_in, void* d_out, int out_size, void* d_ws, size_t ws_size, hipStream_t stream) {
    static int grid_blocks = 0;
    constexpr int LDS_BYTES = gm::STAGE_BYTES + 16;
    if (!grid_blocks) {
        int dev = 0, cus = 0, per_cu = 0;
        (void)hipGetDevice(&dev); (void)hipDeviceGetAttribute(&cus, hipDeviceAttributeMultiprocessorCount, dev);
        (void)hipFuncSetAttribute((const void*)fwd_kernel, hipFuncAttributeMaxDynamicSharedMemorySize, LDS_BYTES);
        (void)hipOccupancyMaxActiveBlocksPerMultiprocessor(&per_cu, (const void*)fwd_kernel, 512, LDS_BYTES);
        if (per_cu < 1) per_cu = 1;
        grid_blocks = cus;
        if (ws_size < WS_END) fprintf(stderr, "kernel_launch: workspace too small: %zu < %zu\n", ws_size, (size_t)WS_END);
        (void)hipGetLastError();
    }
    Params p{};
    p.x = (const float*)d_in[0]; p.c = (const float*)d_in[1]; p.pos = (const int*)d_in[2]; p.ada_w = (const float*)d_in[3]; p.ada_b = (const float*)d_in[4];
    p.ntg = (const float*)d_in[5]; p.nfg = (const float*)d_in[6]; p.ret_w_in = (const float*)d_in[7]; p.ret_gn = (const float*)d_in[8]; p.ret_w_out = (const float*)d_in[9];
    p.ml_w_in = (const float*)d_in[10]; p.ml_bg = (const float*)d_in[11]; p.ml_cw = (const float*)d_in[12]; p.ml_cb = (const float*)d_in[13]; p.ml_gn = (const float*)d_in[14];
    p.ml_w_out = (const float*)d_in[15]; p.up_w = (const float*)d_in[16]; p.fcw = (const float*)d_in[17]; p.fcb = (const float*)d_in[18]; p.dn_w = (const float*)d_in[19];
    p.fin_g = (const float*)d_in[20]; p.out = (float*)d_out; p.ws = (unsigned char*)d_ws;
#if MULTI_LAUNCH
    for (int ph = 0; ph < N_PHASES; ++ph) { p.ph_lo = ph; p.ph_hi = ph + 1; hipLaunchKernelGGL(fwd_kernel, dim3(grid_blocks), dim3(512), LDS_BYTES, stream, p); }
#else
    p.ph_lo = 0; p.ph_hi = N_PHASES;
    (void)hipMemsetAsync((unsigned char*)d_ws + OFF_SM + SM_BAR, 0, XCD_BAR_WORDS * 4, stream);
    void* args[] = {&p};
    hipError_t e = hipLaunchCooperativeKernel((void*)fwd_kernel, dim3(grid_blocks), dim3(512), args, LDS_BYTES, stream);
    if (e != hipSuccess) fprintf(stderr, "cooperative launch failed: %s (grid %d)\n", hipGetErrorString(e), grid_blocks);
#endif
}
```

```cpp
#include <hip/hip_runtime.h>
#include <hip/hip_cooperative_groups.h>
#include <cstdio>
namespace cg = cooperative_groups;

#ifndef MULTI_LAUNCH
#define MULTI_LAUNCH 0
#endif

#define LAS __attribute__((address_space(3)))
typedef unsigned short bf16_t;
typedef short bf16x8 __attribute__((ext_vector_type(8)));
typedef float f32x4 __attribute__((ext_vector_type(4)));
typedef unsigned u32x4 __attribute__((ext_vector_type(4)));
typedef unsigned u32x2 __attribute__((ext_vector_type(2)));

constexpr int S_ = 16384, D_ = 1024, DFF = 2816;
constexpr float EPS = 1e-6f;

constexpr size_t OFF_W = 0;
constexpr size_t OFF_WIN = 0, OFF_WOUT = 12582912, OFF_WUP = 0, OFF_WDN = 11534336;
constexpr size_t OFF_H = 17301504;
constexpr size_t OFF_SM = OFF_H + 33554432;
constexpr size_t SM_MOD = 0;
constexpr size_t SM_IFQ = SM_MOD + 49152;
constexpr size_t SM_RB = SM_IFQ + 512;
constexpr size_t TBL = 262144;
constexpr size_t SM_CB = SM_RB + TBL, SM_XS = SM_CB + TBL, SM_WK = SM_XS + TBL, SM_EM = SM_WK + TBL, SM_GG = SM_EM + TBL, SM_PM = SM_GG + TBL;
constexpr size_t SM_GL = SM_PM + TBL;
constexpr size_t SM_ML = SM_GL + 1024, SM_SCP = SM_ML + 1024, SM_SCN = SM_SCP + 1024;
constexpr size_t SM_LI = SM_SCN + 1024;
constexpr size_t SM_LF = SM_LI + 262144;
constexpr size_t SM_PS = SM_LF + 262144;
constexpr size_t SM_DC = SM_PS + 1048576;
constexpr size_t SM_NLOC = SM_DC + 262144;
constexpr size_t SM_ST = SM_NLOC + 262144;
constexpr size_t SM_QKH = SM_ST + 4194304;
constexpr size_t SM_BAR = SM_QKH + 1572864;
constexpr size_t SM_END = SM_BAR + 16384;
constexpr size_t OFF_BIG = OFF_SM + 10485760;
static_assert(SM_END <= 10485760, "small region");
constexpr size_t OFF_Q = OFF_BIG, OFF_K = OFF_Q + 16777216, OFF_KWT = OFF_K + 16777216, OFF_VT = OFF_KWT + 16777216,
                 OFF_KVT = OFF_VT + 33554432, OFF_P = OFF_KVT + 33554432, OFF_Z = OFF_P + 16777216, WS_END = OFF_Z + 67108864;
constexpr size_t OFF_ACT = OFF_BIG, OFF_FH = OFF_ACT + 92274688;

struct Params {
    const float *x, *c; const int* pos; const float *ada_w, *ada_b, *ntg, *nfg, *ret_w_in, *ret_gn, *ret_w_out,
        *ml_w_in, *ml_bg, *ml_cw, *ml_cb, *ml_gn, *ml_w_out, *up_w, *fcw, *fcb, *dn_w, *fin_g;
    float* out; unsigned char* ws; int ph_lo, ph_hi;
};

__device__ __forceinline__ unsigned cvt_pk_bf16(float lo, float hi) { unsigned r; asm volatile("v_cvt_pk_bf16_f32 %0, %1, %2" : "=v"(r) : "v"(lo), "v"(hi)); return r; }
__device__ __forceinline__ float bf_lo(unsigned w) { return __uint_as_float(w << 16); }
__device__ __forceinline__ float bf_hi(unsigned w) { return __uint_as_float(w & 0xffff0000u); }
__device__ __forceinline__ float siluf(float v) { return v * __builtin_amdgcn_rcpf(1.0f + __expf(-v)); }
__device__ __forceinline__ float sigmf(float v) { return __builtin_amdgcn_rcpf(1.0f + __expf(-v)); }
__device__ __forceinline__ float dpp_shr1(float old, float x) { return __builtin_bit_cast(float, __builtin_amdgcn_update_dpp(__builtin_bit_cast(int, old), __builtin_bit_cast(int, x), 0x111, 0xf, 0xf, false)); }
__device__ __forceinline__ float dpp_shr2(float old, float x) { return __builtin_bit_cast(float, __builtin_amdgcn_update_dpp(__builtin_bit_cast(int, old), __builtin_bit_cast(int, x), 0x112, 0xf, 0xf, false)); }
__device__ __forceinline__ float dpp_ror1(float x) { return __builtin_bit_cast(float, __builtin_amdgcn_update_dpp(0, __builtin_bit_cast(int, x), 0x121, 0xf, 0xf, true)); }
__device__ __forceinline__ float dpp_ror2(float x) { return __builtin_bit_cast(float, __builtin_amdgcn_update_dpp(0, __builtin_bit_cast(int, x), 0x122, 0xf, 0xf, true)); }
__device__ __forceinline__ float dpp_mirror(float x) { return __builtin_bit_cast(float, __builtin_amdgcn_update_dpp(0, __builtin_bit_cast(int, x), 0x140, 0xf, 0xf, true)); }
__device__ __forceinline__ float dpp_swap01(float x) { return __builtin_bit_cast(float, __builtin_amdgcn_update_dpp(0, __builtin_bit_cast(int, x), 0xB1, 0xf, 0xf, true)); }
__device__ __forceinline__ float wave_sum(float v) { for (int o = 32; o >= 1; o >>= 1) v += __shfl_xor(v, o); return v; }
__device__ __forceinline__ u32x4 pack8(const f32x4 a, const f32x4 b) { u32x4 w; w.x = cvt_pk_bf16(a[0], a[1]); w.y = cvt_pk_bf16(a[2], a[3]); w.z = cvt_pk_bf16(b[0], b[1]); w.w = cvt_pk_bf16(b[2], b[3]); return w; }
__device__ __forceinline__ void unpack8(const u32x4 w, float (&f)[8]) { f[0] = bf_lo(w.x); f[1] = bf_hi(w.x); f[2] = bf_lo(w.y); f[3] = bf_hi(w.y); f[4] = bf_lo(w.z); f[5] = bf_hi(w.z); f[6] = bf_lo(w.w); f[7] = bf_hi(w.w); }

namespace gm {
constexpr int BM = 256, BK = 64, HALF = 128, HTB = HALF * BK * 2, STAGE_BYTES = 8 * HTB, NXCD = 8, WGM = 8;
__device__ __forceinline__ int lds_byte(int r, int c) { const int st = (r >> 4) * 2 + (c >> 5), rr = r & 15, cc = c & 31, ob = rr * 64 + cc * 2; return st * 1024 + (ob ^ (((ob >> 9) & 1) << 5)); }
__device__ __forceinline__ void stage_rc(int b, int& R, int& C) { const int st = b / 1024, sb = b % 1024, swz = sb ^ (((sb >> 9) & 1) << 5); R = (st >> 1) * 16 + swz / 64; C = (st & 1) * 32 + (swz % 64) / 2; }
__device__ __forceinline__ int perm32(int rho) { const int n = rho >> 4, i = rho & 15; return 8 * (i >> 2) + 4 * n + (i & 3); }

struct U { const char *a1, *b1, *a2, *b2; long co; int i0, i1, i2, i3; };
struct GP { int lda, ldb, n1, nt; };

struct SchedPlain {
    const char* A; const char* B; const char* B2; int nM, nN, nsplit, G, c; size_t ta, tb; long ldc; int vt;
    __device__ __forceinline__ bool next(int i, U& u) const { return at((long)i * G + c, u); }
    __device__ __forceinline__ bool at(long L, U& u) const {
        const int nwg = nM * nN; if (L >= nwg) return false;
        int wgid = (int)L; { const int q = nwg / NXCD, r = nwg % NXCD, xcd = wgid % NXCD, off = wgid / NXCD; wgid = (xcd < r ? xcd * (q + 1) : r * (q + 1) + (xcd - r) * q) + off; }
        const int nig = WGM * nN, gid = wgid / nig, fm = gid * WGM, gsz = (nM - fm) < WGM ? (nM - fm) : WGM;
        const int pm = fm + ((wgid % nig) % gsz), pn = (wgid % nig) / gsz;
        u.a1 = A + (size_t)pm * ta; u.b1 = pn < nsplit ? B + (size_t)pn * tb : B2 + (size_t)(pn - nsplit) * tb; u.a2 = u.a1; u.b2 = u.b1;
        u.co = vt ? ((long)((pm >> 1) * 64 + pn) * 512 + (pm & 1) * 256) * 256 : (long)pm * 256 * ldc + (long)pn * 256; u.i0 = pm; u.i1 = pn; u.i2 = 0; u.i3 = 0; return true;
    }
};

struct SchedMulti {
    SchedPlain s0, s1, s2; int n0, n1, n2, G, c;
    __device__ __forceinline__ bool next(int i, U& u) const {
        const long L = (long)i * G + c; bool ok; int w;
        if (L < n0) { ok = s0.at(L, u); w = 0; } else if (L < n0 + n1) { ok = s1.at(L - n0, u); w = 1; } else if (L < n0 + n1 + n2) { ok = s2.at(L - n0 - n1, u); w = 2; } else return false;
        u.i3 = w; return ok;
    }
};

template <class Epi, class Sched, bool TWOSEG>
__device__ __forceinline__ void gemm_phase(LAS unsigned char* lds, const GP g, const Sched& S, const Epi& E) {
    int tid = threadIdx.x; asm volatile("" : "+v"(tid));
    const int wid = __builtin_amdgcn_readfirstlane(tid >> 6), lane = tid & 63, wr = wid >> 2, wc = wid & 3, fr = lane & 15, fq = lane >> 4;
    const int nt = g.nt;
    unsigned voffA[2], voffB[2];
#pragma unroll
    for (int i = 0; i < 2; ++i) { int R, C; stage_rc(tid * 16 + i * 8192, R, C); const int Rb = Epi::PERM ? ((R & ~31) + perm32(R & 31)) : R;
        voffA[i] = (unsigned)(R * g.lda + C) * 2u; voffB[i] = (unsigned)(Rb * g.ldb + C) * 2u; }
    const size_t hsA1 = (size_t)HALF * g.lda * 2, hsB1 = (size_t)HALF * g.ldb * 2;
    const unsigned ldsw = (unsigned)wid * 1024u;
    const int aoff = lds_byte(wr * 64 + fr, fq * 8), boff = lds_byte(wc * 32 + fr, fq * 8);
#define G_SA(b, h) (((b) * 2 + (h)) * HTB)
#define G_SB(b, h) ((4 + (b) * 2 + (h)) * HTB)
#define G_STAGE(bufoff, gbase, voff) do { _Pragma("unroll") for (int _i = 0; _i < 2; ++_i) \
        __builtin_amdgcn_global_load_lds((const unsigned*)((const char*)(gbase) + (voff)[_i]), (LAS unsigned*)(lds + (bufoff) + ldsw + _i * 8192), 16, 0, 0); } while (0)
#define G_LDA(dst, b, h) do { _Pragma("unroll") for (int m = 0; m < 4; ++m) _Pragma("unroll") for (int k = 0; k < 2; ++k) dst[m][k] = *(const LAS bf16x8*)(lds + G_SA(b, h) + aoff + m * 2048 + k * 1024); } while (0)
#define G_LDB(dst, b, h) do { _Pragma("unroll") for (int n = 0; n < 2; ++n) _Pragma("unroll") for (int k = 0; k < 2; ++k) dst[n][k] = *(const LAS bf16x8*)(lds + G_SB(b, h) + boff + n * 2048 + k * 1024); } while (0)
#define G_MMA(ai, bj, At, Bt) do { __builtin_amdgcn_s_setprio(1); _Pragma("unroll") for (int m = 0; m < 4; ++m) _Pragma("unroll") for (int n = 0; n < 2; ++n) _Pragma("unroll") for (int k = 0; k < 2; ++k) \
        acc[ai][bj][m][n] = __builtin_amdgcn_mfma_f32_16x16x32_bf16(Bt[n][k], At[m][k], acc[ai][bj][m][n], 0, 0, 0); __builtin_amdgcn_s_setprio(0); } while (0)
#define G_WAIT_V(n) asm volatile("s_waitcnt vmcnt(" #n ")" ::: "memory")
#define G_WAIT_L(n) asm volatile("s_waitcnt lgkmcnt(" #n ")" ::: "memory")
#define G_BAR __builtin_amdgcn_s_barrier()
#define G_SCHED __builtin_amdgcn_sched_barrier(0)
    U cur, nxt; int ui = 0;
    if (!S.next(0, cur)) return;
    f32x4 acc[2][2][4][2];
#pragma unroll
    for (int a = 0; a < 2; ++a)
#pragma unroll
        for (int b = 0; b < 2; ++b)
#pragma unroll
            for (int m = 0; m < 4; ++m)
#pragma unroll
                for (int n = 0; n < 2; ++n) acc[a][b][m][n] = (f32x4){0.f, 0.f, 0.f, 0.f};
    bf16x8 At[4][2], B0[2][2], B1[2][2];
    G_STAGE(G_SB(0, 0), cur.b1, voffB); G_STAGE(G_SA(0, 0), cur.a1, voffA); G_STAGE(G_SB(0, 1), cur.b1 + hsB1, voffB); G_STAGE(G_SA(0, 1), cur.a1 + hsA1, voffA);
    if (wr == 1) G_BAR;
    G_WAIT_V(4); G_BAR;
    G_STAGE(G_SB(1, 0), cur.b1 + 128, voffB); G_STAGE(G_SA(1, 0), cur.a1 + 128, voffA); G_STAGE(G_SB(1, 1), cur.b1 + hsB1 + 128, voffB);
    G_WAIT_V(6); G_BAR;
    for (;;) {
        const bool has_next = S.next(ui + 1, nxt);
        const char* nA = has_next ? nxt.a1 : cur.a1; const char* nB = has_next ? nxt.b1 : cur.b1;
        for (int t = 0; t < nt; t += 2) {
            const bool last = (t == nt - 2);
            const bool sg1 = TWOSEG && (t >= g.n1);
            const bool sg2 = TWOSEG && !last && (t + 2 >= g.n1);
            const char* a1 = sg1 ? cur.a2 + (size_t)(t + 1 - g.n1) * 128 : cur.a1 + (size_t)(t + 1) * 128;
            const char* a2 = last ? nA : (sg2 ? cur.a2 + (size_t)(t + 2 - g.n1) * 128 : cur.a1 + (size_t)(t + 2) * 128);
            const char* b2 = last ? nB : (sg2 ? cur.b2 + (size_t)(t + 2 - g.n1) * 128 : cur.b1 + (size_t)(t + 2) * 128);
            const char* a3 = a2 + 128; const char* b3 = b2 + 128;
            if (TWOSEG) { if (t == g.n1) E.mid(acc, cur, wr, wc, fr, fq); }
            G_LDB(B0, 0, 0); G_SCHED; G_LDA(At, 0, 0); G_STAGE(G_SA(1, 1), a1 + hsA1, voffA);
            G_WAIT_L(8); G_BAR; G_WAIT_L(0); G_MMA(0, 0, At, B0); G_BAR; G_SCHED;
            G_LDB(B1, 0, 1); G_STAGE(G_SB(0, 0), b2, voffB);
            G_BAR; G_WAIT_L(0); G_MMA(0, 1, At, B1); G_BAR;
            G_LDA(At, 0, 1); G_STAGE(G_SA(0, 0), a2, voffA);
            G_BAR; G_WAIT_L(0); G_MMA(1, 0, At, B0); G_BAR; G_SCHED;
            G_STAGE(G_SB(0, 1), b2 + hsB1, voffB);
            G_WAIT_V(6); G_BAR; G_MMA(1, 1, At, B1); G_BAR;
            G_LDB(B0, 1, 0); G_SCHED; G_LDA(At, 1, 0); G_STAGE(G_SA(0, 1), a2 + hsA1, voffA);
            G_WAIT_L(8); G_BAR; G_WAIT_L(0); G_MMA(0, 0, At, B0); G_BAR; G_SCHED;
            G_LDB(B1, 1, 1); G_STAGE(G_SB(1, 0), b3, voffB);
            G_BAR; G_WAIT_L(0); G_MMA(0, 1, At, B1); G_BAR;
            G_LDA(At, 1, 1); G_STAGE(G_SA(1, 0), a3, voffA);
            G_BAR; G_WAIT_L(0); G_MMA(1, 0, At, B0); G_BAR; G_SCHED;
            G_STAGE(G_SB(1, 1), b3 + hsB1, voffB);
            G_WAIT_V(6); G_BAR; G_MMA(1, 1, At, B1); G_BAR;
        }
        E(acc, cur, wr, wc, fr, fq);
        if (!has_next) break;
#pragma unroll
        for (int a = 0; a < 2; ++a)
#pragma unroll
            for (int b = 0; b < 2; ++b)
#pragma unroll
                for (int m = 0; m < 4; ++m)
#pragma unroll
                    for (int n = 0; n < 2; ++n) acc[a][b][m][n] = (f32x4){0.f, 0.f, 0.f, 0.f};
        cur = nxt; ++ui;
    }
    G_WAIT_V(0);
    if (wr == 0) G_BAR;
    G_BAR;
#undef G_SA
#undef G_SB
#undef G_STAGE
#undef G_LDA
#undef G_LDB
#undef G_MMA
#undef G_WAIT_V
#undef G_WAIT_L
#undef G_BAR
#undef G_SCHED
}
}

typedef f32x4 Acc[2][2][4][2];

struct EpiPlain {
    static constexpr bool PERM = true; bf16_t* base; long ldc;
    __device__ __forceinline__ void mid(Acc&, const gm::U&, int, int, int, int) const {}
    __device__ __forceinline__ void operator()(const Acc& acc, const gm::U& u, int wr, int wc, int fr_, int fq_) const {
        int fr = fr_, fq = fq_; asm volatile("" : "+v"(fr), "+v"(fq));
        bf16_t* d = base + u.co + (long)(wr * 64 + fr) * ldc + wc * 32 + 8 * fq;
#pragma unroll
        for (int ai = 0; ai < 2; ++ai)
#pragma unroll
            for (int m = 0; m < 4; ++m)
#pragma unroll
                for (int bj = 0; bj < 2; ++bj) *(u32x4*)(d + (long)(ai * 128 + m * 16) * ldc + bj * 128) = pack8(acc[ai][bj][m][0], acc[ai][bj][m][1]);
    }
};

template <int KIND> struct EpiQK {
    static constexpr bool PERM = true; bf16_t* Q; bf16_t* K; const int* pos; const float* ifq; bf16_t* qkh; bf16_t* kwt; const float* wkt; int pair;
    __device__ __forceinline__ void mid(Acc&, const gm::U&, int, int, int, int) const {}
    __device__ __forceinline__ void operator()(const Acc& acc, const gm::U& u, int wr, int wc, int fr_, int fq_) const {
        int fr = fr_, fq = fq_; asm volatile("" : "+v"(fr), "+v"(fq));
        const int pm = u.i0, pn = u.i1, d0 = wc * 32 + 8 * fq;
        bf16_t* dst = (pn < 2 ? Q : K) + (size_t)(pn & 1) * S_ * 256 + d0;
        if (KIND == 0) {
            const float sc = pn < 2 ? 1.0f : 0.0625f;
            const f32x4 f0 = *(const f32x4*)(ifq + d0), f1 = *(const f32x4*)(ifq + d0 + 4);
#pragma unroll
            for (int ai = 0; ai < 2; ++ai)
#pragma unroll
                for (int m = 0; m < 4; ++m) {
                    const int t = pm * 256 + ai * 128 + wr * 64 + m * 16 + fr; const float pf = (float)pos[t];
                    f32x4 o1[2], o2[2];
#pragma unroll
                    for (int n = 0; n < 2; ++n)
#pragma unroll
                        for (int e = 0; e < 4; ++e) {
                            const float ang = pf * (n ? f1[e] : f0[e]);
                            const double rev = (double)ang * 0.15915494309189535; const float fx = (float)(rev - __builtin_rint(rev));
                            const float sn = __builtin_amdgcn_sinf(fx), cs = __builtin_amdgcn_cosf(fx);
                            const float t1 = acc[ai][0][m][n][e], t2 = acc[ai][1][m][n][e];
                            o1[n][e] = (t1 * cs - t2 * sn) * sc; o2[n][e] = (t1 * sn + t2 * cs) * sc; }
                    *(u32x4*)(dst + (size_t)t * 256) = pack8(o1[0], o1[1]); *(u32x4*)(dst + (size_t)t * 256 + 128) = pack8(o2[0], o2[1]);
                    if (pn >= 2) {
                        const int h2 = pn & 1, tl = ai * 128 + wr * 64 + m * 16 + fr; const float wk = wkt[(size_t)(2 * pair + h2) * S_ + t];
                        bf16_t* kp = kwt + ((size_t)(h2 * 64 + pm) * 256 + d0) * 256 + tl;
#pragma unroll
                        for (int n = 0; n < 2; ++n)
#pragma unroll
                            for (int e = 0; e < 4; e += 2) { const unsigned w1 = cvt_pk_bf16(o1[n][e] * wk, o1[n][e + 1] * wk), w2 = cvt_pk_bf16(o2[n][e] * wk, o2[n][e + 1] * wk);
                                kp[(size_t)(4 * n + e) * 256] = (bf16_t)(w1 & 0xffffu); kp[(size_t)(4 * n + e + 1) * 256] = (bf16_t)(w1 >> 16);
                                kp[(size_t)(128 + 4 * n + e) * 256] = (bf16_t)(w2 & 0xffffu); kp[(size_t)(128 + 4 * n + e + 1) * 256] = (bf16_t)(w2 >> 16); } } }
        } else {
#pragma unroll
            for (int ai = 0; ai < 2; ++ai)
#pragma unroll
                for (int m = 0; m < 4; ++m) {
                    const int t = pm * 256 + ai * 128 + wr * 64 + m * 16 + fr;
#pragma unroll
                    for (int bj = 0; bj < 2; ++bj) { const u32x4 w = pack8(acc[ai][bj][m][0], acc[ai][bj][m][1]);
                        *(u32x4*)(dst + (size_t)t * 256 + bj * 128) = w;
                        if (m == 3 && fr >= 13) { const int gq = pm * 4 + ai * 2 + wr; *(u32x4*)(qkh + ((size_t)gq * 3 + (fr - 13)) * 1024 + pn * 256 + bj * 128 + d0) = w; } } }
        }
    }
};

template <bool PSUM> struct EpiS {
    static constexpr bool PERM = true; bf16_t* P; const float* RB; const float* CB; float* PS; int pair;
    __device__ __forceinline__ void mid(Acc&, const gm::U&, int, int, int, int) const {}
    __device__ __forceinline__ void operator()(const Acc& acc, const gm::U& u, int wr, int wc, int fr_, int fq_) const {
        int fr = fr_, fq = fq_; asm volatile("" : "+v"(fr), "+v"(fq));
        const int ch = u.i0, h2 = u.i1, h = 2 * pair + h2, c0 = wc * 32 + 8 * fq;
        const float* rb = RB + (size_t)h * S_ + ch * 256 + wr * 64 + fr; const float* cb = CB + (size_t)h * S_ + ch * 256 + c0;
        bf16_t* d = P + ((size_t)(h2 * 64 + ch) * 256 + wr * 64 + fr) * 256 + c0;
        float rbv[2][4], rs[2][4];
#pragma unroll
        for (int ai = 0; ai < 2; ++ai)
#pragma unroll
            for (int m = 0; m < 4; ++m) { rbv[ai][m] = rb[ai * 128 + m * 16]; rs[ai][m] = 0.f; }
#pragma unroll
        for (int bj = 0; bj < 2; ++bj)
#pragma unroll
            for (int n = 0; n < 2; ++n) {
                const f32x4 cbv = *(const f32x4*)(cb + bj * 128 + 4 * n);
#pragma unroll
                for (int ai = 0; ai < 2; ++ai)
#pragma unroll
                    for (int m = 0; m < 4; ++m) {
                        const int dij = (ai * 128 + wr * 64 + m * 16 + fr) - (bj * 128 + c0 + 4 * n);
                        f32x4 v;
#pragma unroll
                        for (int e = 0; e < 4; ++e) { const float w = (dij - e >= 0) ? acc[ai][bj][m][n][e] * __builtin_amdgcn_exp2f((rbv[ai][m] + cbv[e]) * 1.44269504f) : 0.f; v[e] = w; rs[ai][m] += w; }
                        u32x2 pk; pk.x = cvt_pk_bf16(v[0], v[1]); pk.y = cvt_pk_bf16(v[2], v[3]);
                        *(u32x2*)(d + (size_t)(ai * 128 + m * 16) * 256 + bj * 128 + 4 * n) = pk; }
            }
        if (PSUM) {
#pragma unroll
            for (int ai = 0; ai < 2; ++ai)
#pragma unroll
                for (int m = 0; m < 4; ++m) { float r = rs[ai][m]; r += __shfl_xor(r, 16); r += __shfl_xor(r, 32);
                    if (fq == 0) PS[((size_t)(ch * 256 + ai * 128 + wr * 64 + m * 16 + fr) * 4 + h) * 4 + wc] = r; } }
    }
};

template <bool STATS> struct EpiO {
    static constexpr bool PERM = true; bf16_t* Z; const float* XS; float* ST; int pair;
    __device__ __forceinline__ void mid(Acc& acc, const gm::U& u, int wr, int wc, int fr, int fq) const {
        const int ch = u.i0, h = 2 * pair + u.i1; const float* xs = XS + (size_t)h * S_ + ch * 256 + wr * 64 + fr;
#pragma unroll
        for (int ai = 0; ai < 2; ++ai)
#pragma unroll
            for (int m = 0; m < 4; ++m) { const float x = xs[ai * 128 + m * 16];
#pragma unroll
                for (int bj = 0; bj < 2; ++bj)
#pragma unroll
                    for (int n = 0; n < 2; ++n) acc[ai][bj][m][n] *= x; }
    }
    __device__ __forceinline__ void operator()(const Acc& acc, const gm::U& u, int wr, int wc, int fr_, int fq_) const {
        int fr = fr_, fq = fq_; asm volatile("" : "+v"(fr), "+v"(fq));
        const int ch = u.i0, h = 2 * pair + u.i1, nt2 = u.i2, c0 = wc * 32 + 8 * fq;
        bf16_t* d = Z + (size_t)(ch * 256) * 2048 + h * 512 + nt2 * 256 + c0;
#pragma unroll
        for (int ai = 0; ai < 2; ++ai)
#pragma unroll
            for (int m = 0; m < 4; ++m) {
                const int i = ai * 128 + wr * 64 + m * 16 + fr; float s = 0.f, q = 0.f;
#pragma unroll
                for (int bj = 0; bj < 2; ++bj) { *(u32x4*)(d + (size_t)i * 2048 + bj * 128) = pack8(acc[ai][bj][m][0], acc[ai][bj][m][1]);
                    if (STATS) {
#pragma unroll
                        for (int n = 0; n < 2; ++n)
#pragma unroll
                            for (int e = 0; e < 4; ++e) { const float v = acc[ai][bj][m][n][e]; s += v; q += v * v; } } }
                if (STATS) { s += __shfl_xor(s, 16); s += __shfl_xor(s, 32); q += __shfl_xor(q, 16); q += __shfl_xor(q, 32);
                    if (fq == 0) { float* st = ST + (((size_t)(ch * 256 + i) * 4 + h) * 8 + nt2 * 4 + wc) * 2; st[0] = s; st[1] = q; } } }
    }
};

template <int KIND> struct EpiG {
    static constexpr bool PERM = true; bf16_t* Z; float* ST; const float* gng; const float* PS; const float* XS; const float* DC; const float* EM; int pair;
    __device__ __forceinline__ void mid(Acc&, const gm::U&, int, int, int, int) const {}
    __device__ __forceinline__ void operator()(const Acc& acc, const gm::U& u, int wr, int wc, int fr_, int fq_) const {
        int fr = fr_, fq = fq_; asm volatile("" : "+v"(fr), "+v"(fq));
        const int pm = u.i0, pn = u.i1, h = 2 * pair + (pn >> 1), nt2 = pn & 1, c0 = wc * 32 + 8 * fq;
        const int colb = pair * 1024 + pn * 256 + c0;
        f32x4 gv[2][2];
        if (KIND == 0) {
#pragma unroll
            for (int bj = 0; bj < 2; ++bj)
#pragma unroll
                for (int n = 0; n < 2; ++n) gv[bj][n] = *(const f32x4*)(gng + colb + bj * 128 + 4 * n);
        }
#pragma unroll
        for (int ai = 0; ai < 2; ++ai)
#pragma unroll
            for (int m = 0; m < 4; ++m) {
                const int t = pm * 256 + ai * 128 + wr * 64 + m * 16 + fr;
                bf16_t* zp = Z + (size_t)t * 2048 + colb;
                if (KIND == 0) {
                    const f32x4* st = (const f32x4*)(ST + ((size_t)t * 4 + h) * 16);
                    const f32x4 a = st[0], b = st[1], c = st[2], d = st[3];
                    const float s = (a[0] + a[2]) + (b[0] + b[2]) + (c[0] + c[2]) + (d[0] + d[2]);
                    const float q = (a[1] + a[3]) + (b[1] + b[3]) + (c[1] + c[3]) + (d[1] + d[3]);
                    const float mu = s * (1.0f / 512.0f); const float var = fmaxf(q * (1.0f / 512.0f) - mu * mu, 0.f); const float rstd = rsqrtf(var + EPS);
#pragma unroll
                    for (int bj = 0; bj < 2; ++bj) { float y[8]; unpack8(*(const u32x4*)(zp + bj * 128), y); f32x4 o[2];
#pragma unroll
                        for (int n = 0; n < 2; ++n)
#pragma unroll
                            for (int e = 0; e < 4; ++e) o[n][e] = siluf(acc[ai][bj][m][n][e]) * (y[4 * n + e] - mu) * rstd * gv[bj][n][e];
                        *(u32x4*)(zp + bj * 128) = pack8(o[0], o[1]); }
                } else {
                    const f32x4 ps = *(const f32x4*)(PS + ((size_t)t * 4 + h) * 4);
                    const float den = (ps[0] + ps[1]) + (ps[2] + ps[3]) + XS[(size_t)h * S_ + t] * DC[(size_t)t * 4 + h];
                    const float inv = __builtin_amdgcn_rcpf(fmaxf(fabsf(den), EM[(size_t)h * S_ + t]));
                    float s = 0.f, q = 0.f;
#pragma unroll
                    for (int bj = 0; bj < 2; ++bj) { float y[8]; unpack8(*(const u32x4*)(zp + bj * 128), y); f32x4 o[2];
#pragma unroll
                        for (int n = 0; n < 2; ++n)
#pragma unroll
                            for (int e = 0; e < 4; ++e) { const float v = sigmf(acc[ai][bj][m][n][e]) * y[4 * n + e] * inv; o[n][e] = v; s += v; q += v * v; }
                        *(u32x4*)(zp + bj * 128) = pack8(o[0], o[1]); }
                    s += __shfl_xor(s, 16); s += __shfl_xor(s, 32); q += __shfl_xor(q, 16); q += __shfl_xor(q, 32);
                    if (fq == 0) { float* st = ST + (((size_t)t * 4 + h) * 8 + nt2 * 4 + wc) * 2; st[0] = s; st[1] = q; }
                }
            }
    }
};

struct EpiRes {
    static constexpr bool PERM = false; const float* base; float* out; const float* gate;
    __device__ __forceinline__ void mid(Acc&, const gm::U&, int, int, int, int) const {}
    __device__ __forceinline__ void operator()(const Acc& acc, const gm::U& u, int wr, int wc, int fr_, int fq_) const {
        int fr = fr_, fq = fq_; asm volatile("" : "+v"(fr), "+v"(fq));
        const int row0 = u.i0 * 256 + wr * 64 + fr, col0 = u.i1 * 256 + wc * 32 + 4 * fq;
        f32x4 gv[2][2];
#pragma unroll
        for (int bj = 0; bj < 2; ++bj)
#pragma unroll
            for (int n = 0; n < 2; ++n) gv[bj][n] = *(const f32x4*)(gate + col0 + bj * 128 + n * 16);
#pragma unroll
        for (int ai = 0; ai < 2; ++ai)
#pragma unroll
            for (int m = 0; m < 4; ++m) { const size_t ro = (size_t)(row0 + ai * 128 + m * 16) * 1024 + col0;
#pragma unroll
                for (int bj = 0; bj < 2; ++bj)
#pragma unroll
                    for (int n = 0; n < 2; ++n) { const size_t o = ro + bj * 128 + n * 16; const f32x4 b = *(const f32x4*)(base + o); *(f32x4*)(out + o) = b + gv[bj][n] * acc[ai][bj][m][n]; } }
    }
};

struct EpiUp {
    static constexpr bool PERM = true; bf16_t* act; bf16_t* fh; const float* cw; const float* cb;
    __device__ __forceinline__ void mid(Acc&, const gm::U&, int, int, int, int) const {}
    __device__ __forceinline__ void operator()(const Acc& acc, const gm::U& u, int wr, int wc, int fr_, int fq_) const {
        int fr = fr_, fq = fq_; asm volatile("" : "+v"(fr), "+v"(fq));
        const int pm = u.i0, pn = u.i1, c0 = wc * 32 + 8 * fq, lane = fq * 16 + fr;
        u32x2 pk0[2][4];
#pragma unroll
        for (int n = 0; n < 2; ++n) {
            f32x4 w0[2], w1[2], w2[2], bb[2];
#pragma unroll
            for (int bj = 0; bj < 2; ++bj) { const int chn = bj * DFF + pn * 128 + c0 + 4 * n;
                w0[bj] = *(const f32x4*)(cw + chn); w1[bj] = *(const f32x4*)(cw + 2 * DFF + chn); w2[bj] = *(const f32x4*)(cw + 4 * DFF + chn); bb[bj] = *(const f32x4*)(cb + chn); }
#pragma unroll
            for (int ai = 0; ai < 2; ++ai)
#pragma unroll
                for (int m = 0; m < 4; ++m) {
                    f32x4 uu[2];
#pragma unroll
                    for (int bj = 0; bj < 2; ++bj)
#pragma unroll
                        for (int e = 0; e < 4; ++e) {
                            const float cur = acc[ai][bj][m][n][e]; const float prv = acc[ai][bj][m > 0 ? m - 1 : 0][n][e];
                            const float mr = dpp_mirror(prv), mr2 = dpp_swap01(mr);
                            const float p1 = dpp_shr1(mr, cur), p2 = dpp_shr2(mr2, cur);
                            uu[bj][e] = bb[bj][e] + w0[bj][e] * p2 + w1[bj][e] * p1 + w2[bj][e] * cur; }
                    u32x2 pk; pk.x = cvt_pk_bf16(siluf(uu[0][0]) * uu[1][0], siluf(uu[0][1]) * uu[1][1]); pk.y = cvt_pk_bf16(siluf(uu[0][2]) * uu[1][2], siluf(uu[0][3]) * uu[1][3]);
                    if (n == 0) pk0[ai][m] = pk;
                    else { const int t = pm * 256 + ai * 128 + wr * 64 + m * 16 + fr; u32x4 w; w.x = pk0[ai][m].x; w.y = pk0[ai][m].y; w.z = pk.x; w.w = pk.y;
                        *(u32x4*)(act + (size_t)t * DFF + pn * 128 + c0) = w; }
                }
        }
#pragma unroll
        for (int ai = 0; ai < 2; ++ai) {
            const int gq = pm * 4 + ai * 2 + wr;
            if (fr >= 14) {
#pragma unroll
                for (int bj = 0; bj < 2; ++bj) *(u32x4*)(fh + ((size_t)gq * 4 + (fr - 14)) * (2 * DFF) + pn * 256 + bj * 128 + c0) = pack8(acc[ai][bj][3][0], acc[ai][bj][3][1]);
            }
            if (fr < 2) {
#pragma unroll
                for (int bj = 0; bj < 2; ++bj) *(u32x4*)(fh + ((size_t)gq * 4 + 2 + fr) * (2 * DFF) + pn * 256 + bj * 128 + c0) = pack8(acc[ai][bj][0][0], acc[ai][bj][0][1]);
            }
        }
    }
};

template <class E0, class E1, class E2> struct EpiMulti {
    static constexpr bool PERM = true; E0 e0; E1 e1; E2 e2;
    static_assert(E0::PERM && E1::PERM && E2::PERM, "mixed staging orders");
    __device__ __forceinline__ void mid(Acc&, const gm::U&, int, int, int, int) const {}
    __device__ __forceinline__ void operator()(const Acc& acc, const gm::U& u, int wr, int wc, int fr, int fq) const {
        if (u.i3 == 0) e0(acc, u, wr, wc, fr, fq); else if (u.i3 == 1) e1(acc, u, wr, wc, fr, fq); else e2(acc, u, wr, wc, fr, fq);
    }
};

struct SchedS { const char* Q; const char* K; int G, c;
    __device__ __forceinline__ bool next(int i, gm::U& u) const { const int L = i * G + c; if (L >= 128) return false; const int h2 = L & 1, ch = L >> 1;
        const size_t o = ((size_t)h2 * S_ + ch * 256) * 256 * 2; u.a1 = Q + o; u.b1 = K + o; u.a2 = u.a1; u.b2 = u.b1; u.co = 0; u.i0 = ch; u.i1 = h2; u.i2 = 0; u.i3 = 0; return true; } };
struct SchedKV { const char* VT; const char* KWT; int G, c;
    __device__ __forceinline__ bool next(int i, gm::U& u) const { const int L = i * G + c; if (L >= 256) return false; const int mt = L & 1, h2 = (L >> 1) & 1, ch = L >> 2;
        u.a1 = VT + ((size_t)(h2 * 64 + ch) * 512 + mt * 256) * 256 * 2; u.b1 = KWT + ((size_t)(h2 * 64 + ch) * 256) * 256 * 2; u.a2 = u.a1; u.b2 = u.b1;
        u.co = ((long)(h2 * 64 + ch) * 512 + mt * 256) * 256; u.i0 = ch; u.i1 = h2; u.i2 = mt; u.i3 = 0; return true; } };
struct SchedO { const char* Q; const char* KVT; const char* P; const char* VT; int G, c;
    __device__ __forceinline__ bool next(int i, gm::U& u) const { const int L = i * G + c; if (L >= 256) return false; const int nt2 = L & 1, h2 = (L >> 1) & 1, ch = L >> 2;
        u.a1 = Q + ((size_t)h2 * S_ + ch * 256) * 256 * 2; u.b1 = KVT + ((size_t)(h2 * 64 + ch) * 512 + nt2 * 256) * 256 * 2;
        u.a2 = P + ((size_t)(h2 * 64 + ch) * 65536) * 2; u.b2 = VT + ((size_t)(h2 * 64 + ch) * 512 + nt2 * 256) * 256 * 2;
        u.co = 0; u.i0 = ch; u.i1 = h2; u.i2 = nt2; u.i3 = 0; return true; } };

struct Frame { LAS unsigned char* lds; int G, bid, tid, wid, lane; };
__device__ __forceinline__ Frame fresh(const Frame& f) { Frame r = f; asm volatile("" : "+v"(r.tid)); r.lane = r.tid & 63; r.wid = __builtin_amdgcn_readfirstlane(r.tid >> 6); return r; }

struct TileD { const float* src; bf16_t* dst; int lds_, ldd; };
struct MixerTiles { const float* win; const float* wout; bf16_t* WIN; bf16_t* WOUT; int ldin;
    __device__ __forceinline__ TileD operator()(int u) const {
        if (u < 1536) { const int kt = u & 15, ct = u >> 4; return TileD{win + (size_t)kt * 64 * ldin + ct * 64, WIN + (size_t)ct * 64 * 1024 + kt * 64, ldin, 1024}; }
        const int v = u - 1536, kt = v & 31, ct = v >> 5; return TileD{wout + (size_t)kt * 64 * 1024 + ct * 64, WOUT + (size_t)ct * 64 * 2048 + kt * 64, 1024, 2048}; } };
struct FfnTiles { const float* wup; const float* wdn; bf16_t* WUP; bf16_t* WDN;
    __device__ __forceinline__ TileD operator()(int u) const {
        if (u < 1408) { const int kt = u & 15, ct = u >> 4, c0 = ct * 64;
            const int cc = c0 < DFF ? c0 : c0 - DFF; const int r0 = (cc >> 7) * 256 + (c0 < DFF ? 0 : 128) + (cc & 127);
            return TileD{wup + (size_t)kt * 64 * 5632 + c0, WUP + (size_t)r0 * 1024 + kt * 64, 5632, 1024}; }
        const int v = u - 1408, kt = v % 44, ct = v / 44; return TileD{wdn + (size_t)kt * 64 * 1024 + ct * 64, WDN + (size_t)ct * 64 * DFF + kt * 64, 1024, DFF}; } };
template <class TD> __device__ __forceinline__ void convert_tiles(const Frame& F, int ntiles, const TD& td) {
    LAS float* tile = (LAS float*)F.lds;
    const int tx = F.tid & 63, ty = F.tid >> 6, n = F.tid >> 3, kk = (F.tid & 7) * 8;
    for (int u0 = F.bid; u0 < ntiles; u0 += 4 * F.G) {
        float v[4][8];
#pragma unroll
        for (int j = 0; j < 4; ++j) { const int u = u0 + j * F.G; if (u < ntiles) { const TileD d = td(u);
#pragma unroll
                for (int i = 0; i < 8; ++i) v[j][i] = d.src[(size_t)(ty + 8 * i) * d.lds_ + tx]; } }
#pragma unroll
        for (int j = 0; j < 4; ++j) { if (u0 + j * F.G < ntiles) {
#pragma unroll
                for (int i = 0; i < 8; ++i) tile[j * 4160 + (ty + 8 * i) * 65 + tx] = v[j][i]; } }
        __syncthreads();
#pragma unroll
        for (int j = 0; j < 4; ++j) { const int u = u0 + j * F.G; if (u < ntiles) { const TileD d = td(u); const LAS float* t = tile + j * 4160;
                u32x4 w; w.x = cvt_pk_bf16(t[(kk + 0) * 65 + n], t[(kk + 1) * 65 + n]); w.y = cvt_pk_bf16(t[(kk + 2) * 65 + n], t[(kk + 3) * 65 + n]);
                w.z = cvt_pk_bf16(t[(kk + 4) * 65 + n], t[(kk + 5) * 65 + n]); w.w = cvt_pk_bf16(t[(kk + 6) * 65 + n], t[(kk + 7) * 65 + n]);
                *(u32x4*)(d.dst + (size_t)n * d.ldd + kk) = w; } }
        __syncthreads();
    }
}
__device__ __forceinline__ void convert_mixer_weights(const Frame& F, const Params& p, int layer) {
    const MixerTiles td{layer == 0 ? p.ret_w_in : p.ml_w_in, layer == 0 ? p.ret_w_out : p.ml_w_out, (bf16_t*)(p.ws + OFF_WIN), (bf16_t*)(p.ws + OFF_WOUT), layer == 0 ? 6144 : 6152};
    convert_tiles(F, 2048, td);
}
struct FfnTilesDn { FfnTiles t; __device__ __forceinline__ TileD operator()(int u) const { return t(u + 1408); } };
__device__ __forceinline__ void convert_ffn_weights(const Frame& F, const Params& p, int layer, int part) {
    const FfnTiles td{p.up_w + (size_t)layer * 1024 * 5632, p.dn_w + (size_t)layer * 2816 * 1024, (bf16_t*)(p.ws + OFF_WUP), (bf16_t*)(p.ws + OFF_WDN)};
    if (part == 0) convert_tiles(F, 1408, td); else { const FfnTilesDn tdn{td}; convert_tiles(F, 704, tdn); }
}

__device__ __forceinline__ void prologue_phase(const Frame& F, const Params& p) {
    float* MOD = (float*)(p.ws + OFF_SM + SM_MOD);
    LAS float* red = (LAS float*)F.lds;
    for (int u = F.bid; u < 192; u += F.G) {
        const int l = u / 96, cgp = u % 96, cq = F.tid & 15, kg = F.tid >> 4;
        const float* w = p.ada_w + (size_t)l * 1024 * 6144 + cgp * 64 + cq * 4;
        f32x4 a = {0.f, 0.f, 0.f, 0.f};
#pragma unroll 8
        for (int k = kg * 32; k < kg * 32 + 32; ++k) { const float cv = p.c[k]; const float ca = siluf(cv); a += ca * *(const f32x4*)(w + (size_t)k * 6144); }
        __syncthreads();
#pragma unroll
        for (int e = 0; e < 4; ++e) red[kg * 64 + cq * 4 + e] = a[e];
        __syncthreads();
        if (F.tid < 64) { float s = 0.f; for (int k = 0; k < 32; ++k) s += red[k * 64 + F.tid]; MOD[l * 6144 + cgp * 64 + F.tid] = s + p.ada_b[l * 6144 + cgp * 64 + F.tid]; }
    }
    const int gt = F.bid * 512 + F.tid, gn = F.G * 512;
    if (gt < 128) ((float*)(p.ws + OFF_SM + SM_IFQ))[gt] = powf(10000.0f, -(float)(2 * gt) / 256.0f);
    float* RB = (float*)(p.ws + OFF_SM + SM_RB); float* CB = (float*)(p.ws + OFF_SM + SM_CB); float* XS = (float*)(p.ws + OFF_SM + SM_XS); float* WK = (float*)(p.ws + OFF_SM + SM_WK);
    for (int e = gt; e < 4 * S_; e += gn) { const int h = e >> 14, t = e & (S_ - 1), i = t & 255; const float lg = logf(1.0f - exp2f(-5.0f - (float)h));
        RB[e] = (float)i * lg; CB[e] = -(float)i * lg; XS[e] = expf((float)(i + 1) * lg); WK[e] = expf((float)(255 - i) * lg); }
    if (gt < 256) { const int h = gt >> 6; const float lg = logf(1.0f - exp2f(-5.0f - (float)h)); ((float*)(p.ws + OFF_SM + SM_SCP))[gt] = expf(256.0f * lg); ((float*)(p.ws + OFF_SM + SM_SCN))[gt] = 1.0f; }
}

template <bool GATES> __device__ __forceinline__ void norm_phase(const Frame& F, const Params& p, const float* xin, const float* g, const float* sh, const float* sc) {
    bf16_t* H = (bf16_t*)(p.ws + OFF_H);
    LAS float* wg = (LAS float*)F.lds;
    if (GATES) { __syncthreads(); for (int e = F.tid; e < 8192; e += 512) wg[e] = p.ml_w_in[(size_t)(e >> 3) * 6152 + 6144 + (e & 7)]; __syncthreads(); }
    float* LI = (float*)(p.ws + OFF_SM + SM_LI); float* LF = (float*)(p.ws + OFF_SM + SM_LF);
    f32x4 gv[4], scv[4], shv[4];
#pragma unroll
    for (int j = 0; j < 4; ++j) { const int c = F.lane * 4 + 256 * j; gv[j] = *(const f32x4*)(g + c); scv[j] = *(const f32x4*)(sc + c); shv[j] = *(const f32x4*)(sh + c); }
    for (int row0 = (F.bid * 8 + F.wid) * 4; row0 < S_; row0 += F.G * 8 * 4) {
        f32x4 xa[4][4];
#pragma unroll
        for (int rr = 0; rr < 4; ++rr)
#pragma unroll
            for (int j = 0; j < 4; ++j) xa[rr][j] = *(const f32x4*)(xin + (size_t)(row0 + rr) * 1024 + F.lane * 4 + 256 * j);
#pragma unroll
        for (int rr = 0; rr < 4; ++rr) {
        const int row = row0 + rr; f32x4 xv[4]; float ss = 0.f;
#pragma unroll
        for (int j = 0; j < 4; ++j) { xv[j] = xa[rr][j]; ss += xv[j][0] * xv[j][0] + xv[j][1] * xv[j][1] + xv[j][2] * xv[j][2] + xv[j][3] * xv[j][3]; }
        ss = wave_sum(ss); const float rstd = rsqrtf(ss * (1.0f / 1024.0f) + EPS);
        float gp[8];
        if (GATES) {
#pragma unroll
            for (int k = 0; k < 8; ++k) gp[k] = 0.f; }
#pragma unroll
        for (int j = 0; j < 4; ++j) { f32x4 hv;
#pragma unroll
            for (int e = 0; e < 4; ++e) hv[e] = xv[j][e] * rstd * gv[j][e] * (1.0f + scv[j][e]) + shv[j][e];
            u32x2 w; w.x = cvt_pk_bf16(hv[0], hv[1]); w.y = cvt_pk_bf16(hv[2], hv[3]);
            *(u32x2*)(H + (size_t)row * 1024 + F.lane * 4 + 256 * j) = w;
            if (GATES) {
#pragma unroll
                for (int e = 0; e < 4; ++e) { const LAS float* wr_ = wg + (F.lane * 4 + 256 * j + e) * 8;
#pragma unroll
                    for (int k = 0; k < 8; ++k) gp[k] += hv[e] * wr_[k]; } } }
        if (GATES) {
#pragma unroll
            for (int k = 0; k < 8; ++k) gp[k] = wave_sum(gp[k]);
            if (F.lane == 0) {
#pragma unroll
                for (int k = 0; k < 4; ++k) { LI[(size_t)row * 4 + k] = gp[k] + p.ml_bg[k]; const float v = gp[4 + k] + p.ml_bg[4 + k]; LF[(size_t)row * 4 + k] = fminf(v, 0.f) - log1pf(expf(-fabsf(v))); } } }
        }
    }
}

__device__ __forceinline__ void prep_a(const Frame& F, const Params& p) {
    const float* LI = (const float*)(p.ws + OFF_SM + SM_LI); const float* LF = (const float*)(p.ws + OFF_SM + SM_LF);
    float* GG = (float*)(p.ws + OFF_SM + SM_GG); float* CB = (float*)(p.ws + OFF_SM + SM_CB); float* PM = (float*)(p.ws + OFF_SM + SM_PM); float* WK = (float*)(p.ws + OFF_SM + SM_WK);
    float* GL = (float*)(p.ws + OFF_SM + SM_GL); float* ML = (float*)(p.ws + OFF_SM + SM_ML);
    for (int u = F.bid; u < 256 && F.wid == 0; u += F.G) {
        const int h = u >> 6, ch = u & 63, t0 = ch * 256 + F.lane * 4;
        float g[4], cb[4], pm[4]; float run = 0.f;
#pragma unroll
        for (int e = 0; e < 4; ++e) { run += LF[(size_t)(t0 + e) * 4 + h]; g[e] = run; }
        float incl = run;
        for (int o = 1; o < 64; o <<= 1) { const float v = __shfl_up(incl, o); if (F.lane >= o) incl += v; }
        const float excl = incl - run;
        float lm = -INFINITY;
#pragma unroll
        for (int e = 0; e < 4; ++e) { g[e] += excl; cb[e] = LI[(size_t)(t0 + e) * 4 + h] - g[e]; lm = fmaxf(lm, cb[e]); pm[e] = lm; }
        float im = lm;
        for (int o = 1; o < 64; o <<= 1) { const float v = __shfl_up(im, o); if (F.lane >= o) im = fmaxf(im, v); }
        float em = __shfl_up(im, 1); if (F.lane == 0) em = -INFINITY;
#pragma unroll
        for (int e = 0; e < 4; ++e) pm[e] = fmaxf(pm[e], em);
        const float gL = __shfl(g[3], 63), pml = __shfl(pm[3], 63);
#pragma unroll
        for (int e = 0; e < 4; ++e) { const size_t o = (size_t)h * S_ + t0 + e; GG[o] = g[e]; CB[o] = cb[e]; PM[o] = pm[e]; WK[o] = expf(cb[e] - pml); }
        if (F.lane == 0) { GL[u] = gL; ML[u] = gL + pml; }
    }
}
__device__ __forceinline__ void prep_b(const Frame& F, const Params& p) {
    const float* GG = (const float*)(p.ws + OFF_SM + SM_GG); const float* PM = (const float*)(p.ws + OFF_SM + SM_PM);
    const float* GL = (const float*)(p.ws + OFF_SM + SM_GL); const float* ML = (const float*)(p.ws + OFF_SM + SM_ML);
    float* RB = (float*)(p.ws + OFF_SM + SM_RB); float* XS = (float*)(p.ws + OFF_SM + SM_XS); float* EM = (float*)(p.ws + OFF_SM + SM_EM);
    float* SCP = (float*)(p.ws + OFF_SM + SM_SCP); float* SCN = (float*)(p.ws + OFF_SM + SM_SCN);
    for (int u = F.bid; u < 256 && F.wid == 0; u += F.G) {
        const int h = u >> 6, ch = u & 63;
        const float glv = GL[h * 64 + F.lane], mlv = ML[h * 64 + F.lane];
        float m = 0.f;
#pragma unroll 8
        for (int c2 = 0; c2 < 64; ++c2) { const float gl = __shfl(glv, c2), ml = __shfl(mlv, c2); if (c2 < ch) m = fmaxf(gl + m, ml); }
#pragma unroll
        for (int e = 0; e < 4; ++e) { const size_t o = (size_t)h * S_ + ch * 256 + F.lane * 4 + e; const float mx = fmaxf(m, PM[o]); RB[o] = -mx; XS[o] = expf(m - mx); EM[o] = expf(-(GG[o] + mx)); }
        if (F.lane == 0) { const float mn = fmaxf(GL[u] + m, ML[u]); SCP[u] = expf(GL[u] + m - mn); SCN[u] = expf(ML[u] - mn); }
    }
}

template <int KIND> __device__ __forceinline__ void r3_pass(const Frame& F, const Params& p, int pair) {
    bf16_t* Qb = (bf16_t*)(p.ws + OFF_Q); bf16_t* Kb = (bf16_t*)(p.ws + OFF_K); bf16_t* KWT = (bf16_t*)(p.ws + OFF_KWT);
    const bf16_t* QKH = (const bf16_t*)(p.ws + OFF_SM + SM_QKH); const float* WK = (const float*)(p.ws + OFF_SM + SM_WK); float* NLOC = (float*)(p.ws + OFF_SM + SM_NLOC);
    LAS bf16_t* T = (LAS bf16_t*)F.lds;
    const int tr = F.tid >> 3, tc = (F.tid & 7) * 8;
    for (int u = F.bid; u < 1024; u += F.G) {
        const int ch = u >> 4, pc0 = (u & 15) * 64; const bool isk = pc0 >= 512;
        if (KIND == 0 && !isk) continue;
        const int bc0 = pc0 & 511, h2 = bc0 >> 8, h = 2 * pair + h2;
        bf16_t* buf = (isk ? Kb : Qb) + (size_t)h2 * S_ * 256 + (bc0 & 255) + tc;
        float cw[4][8], cbias[8];
        if (KIND == 1) { const int gc = (isk ? 1024 : 0) + pair * 512 + bc0 + tc;
#pragma unroll
            for (int j = 0; j < 4; ++j) { const f32x4 a = *(const f32x4*)(p.ml_cw + j * 2048 + gc), b = *(const f32x4*)(p.ml_cw + j * 2048 + gc + 4);
#pragma unroll
                for (int e = 0; e < 4; ++e) { cw[j][e] = a[e]; cw[j][4 + e] = b[e]; } }
            const f32x4 a = *(const f32x4*)(p.ml_cb + gc), b = *(const f32x4*)(p.ml_cb + gc + 4);
#pragma unroll
            for (int e = 0; e < 4; ++e) { cbias[e] = a[e]; cbias[4 + e] = b[e]; } }
        float nsum = 0.f;
        u32x4 nx[4]; float wkn = 0.f;
#define R3_LOAD(dst, s_) do { const int t_ = ch * 256 + (s_) * 64 + tr; dst[0] = *(const u32x4*)(buf + (size_t)t_ * 256); \
            if (KIND == 1) { _Pragma("unroll") for (int d = 1; d <= 3; ++d) { const int tt = t_ - d; u32x4 w_ = {0u, 0u, 0u, 0u}; \
                if (tr - d >= 0) w_ = *(const u32x4*)(buf + (size_t)tt * 256); \
                else if (tt >= 0) w_ = *(const u32x4*)(QKH + ((size_t)(tt >> 6) * 3 + ((tt & 63) - 61)) * 1024 + pc0 + tc); \
                dst[d] = w_; } } } while (0)
        R3_LOAD(nx, 0); if (isk) wkn = WK[(size_t)h * S_ + ch * 256 + tr];
        for (int s = 0; s < 4; ++s) {
            const int t = ch * 256 + s * 64 + tr;
            u32x4 cu[4];
#pragma unroll
            for (int d = 0; d < 4; ++d) cu[d] = nx[d];
            const float wk = wkn;
            if (s < 3) { R3_LOAD(nx, s + 1); if (isk) wkn = WK[(size_t)h * S_ + t + 64]; }
            float v[8]; unpack8(cu[0], v);
            if (KIND == 1) {
                float o[8];
#pragma unroll
                for (int e = 0; e < 8; ++e) o[e] = cbias[e] + cw[3][e] * v[e];
#pragma unroll
                for (int d = 1; d <= 3; ++d) { float x[8]; unpack8(cu[d], x);
#pragma unroll
                    for (int e = 0; e < 8; ++e) o[e] += cw[3 - d][e] * x[e]; }
#pragma unroll
                for (int e = 0; e < 8; ++e) { v[e] = siluf(o[e]); if (isk) v[e] *= 0.0625f; }
                __syncthreads();
                u32x4 w; w.x = cvt_pk_bf16(v[0], v[1]); w.y = cvt_pk_bf16(v[2], v[3]); w.z = cvt_pk_bf16(v[4], v[5]); w.w = cvt_pk_bf16(v[6], v[7]);
                *(u32x4*)(buf + (size_t)t * 256) = w;
            }
            if (isk) {
#pragma unroll
                for (int e = 0; e < 8; e += 2) { const unsigned w = cvt_pk_bf16(v[e] * wk, v[e + 1] * wk); T[(tc + e) * 72 + tr] = (bf16_t)(w & 0xffffu); T[(tc + e + 1) * 72 + tr] = (bf16_t)(w >> 16); }
                __syncthreads();
                const int col = F.tid >> 3, seg = F.tid & 7;
                const u32x4 w = *(const LAS u32x4*)(T + col * 72 + seg * 8);
                *(u32x4*)(KWT + ((size_t)(h2 * 64 + ch) * 256 + (bc0 & 255) + col) * 256 + s * 64 + seg * 8) = w;
                float x[8]; unpack8(w, x); nsum += ((x[0] + x[1]) + (x[2] + x[3])) + ((x[4] + x[5]) + (x[6] + x[7]));
                __syncthreads();
            }
        }
#undef R3_LOAD
        if (KIND == 1 && isk) { nsum += __shfl_xor(nsum, 1); nsum += __shfl_xor(nsum, 2); nsum += __shfl_xor(nsum, 4);
            if ((F.tid & 7) == 0) NLOC[((size_t)h * 64 + ch) * 256 + (bc0 & 255) + (F.tid >> 3)] = nsum; }
    }
}

template <int KIND> __device__ __forceinline__ void scan_phase(const Frame& F, const Params& p, int pair) {
    unsigned* KV = (unsigned*)(p.ws + OFF_KVT);
    const float* SCP = (const float*)(p.ws + OFF_SM + SM_SCP); const float* SCN = (const float*)(p.ws + OFF_SM + SM_SCN);
    for (int e0 = F.bid * 512; e0 < 131072; e0 += F.G * 512) {
        const int h2 = e0 >> 16, h = 2 * pair + h2; unsigned* base = KV + (size_t)h2 * 64 * 65536 + (e0 & 65535) + F.tid;
        float s0 = 0.f, s1 = 0.f;
#pragma unroll 1
        for (int cb = 0; cb < 64; cb += 64) {
            unsigned v[64];
#pragma unroll
            for (int c = 0; c < 64; ++c) v[c] = base[(size_t)(cb + c) * 65536];
#pragma unroll
            for (int c = 0; c < 64; ++c) { base[(size_t)(cb + c) * 65536] = cvt_pk_bf16(s0, s1); const float a = SCP[h * 64 + cb + c], b = SCN[h * 64 + cb + c]; s0 = a * s0 + b * bf_lo(v[c]); s1 = a * s1 + b * bf_hi(v[c]); }
        }
    }
    if (KIND == 1) {
        const float* NLOC = (const float*)(p.ws + OFF_SM + SM_NLOC); const bf16_t* Qb = (const bf16_t*)(p.ws + OFF_Q); float* DC = (float*)(p.ws + OFF_SM + SM_DC);
        LAS float* nv = (LAS float*)F.lds;
        for (int u = F.bid; u < 256; u += F.G) {
            const int h2 = u & 1, hv = (u >> 1) & 1, ch = u >> 2, h = 2 * pair + h2;
            __syncthreads();
            if (F.tid < 256) { float n = 0.f;
#pragma unroll 1
                for (int cb = 0; cb < 64; cb += 16) { if (cb >= ch) break; float x[16];
#pragma unroll
                    for (int c = 0; c < 16; ++c) x[c] = (cb + c < ch) ? NLOC[((size_t)h * 64 + cb + c) * 256 + F.tid] : 0.f;
#pragma unroll
                    for (int c = 0; c < 16; ++c) if (cb + c < ch) n = SCP[h * 64 + cb + c] * n + SCN[h * 64 + cb + c] * x[c]; }
                nv[F.tid] = n; }
            __syncthreads();
            const f32x4 nn = *(const LAS f32x4*)(nv + F.lane * 4);
#pragma unroll 1
            for (int r0 = 0; r0 < 16; r0 += 8) { const int t0 = ch * 256 + hv * 128 + F.wid * 16 + r0; u32x2 w[8];
#pragma unroll
                for (int r = 0; r < 8; ++r) w[r] = *(const u32x2*)(Qb + ((size_t)h2 * S_ + t0 + r) * 256 + F.lane * 4);
#pragma unroll
                for (int r = 0; r < 8; ++r) { float d = bf_lo(w[r].x) * nn[0] + bf_hi(w[r].x) * nn[1] + bf_lo(w[r].y) * nn[2] + bf_hi(w[r].y) * nn[3];
                    d = wave_sum(d); if (F.lane == 0) DC[(size_t)(t0 + r) * 4 + h] = d; } }
        }
    }
}

__device__ __forceinline__ void gn_pass(const Frame& F, const Params& p) {
    bf16_t* Z = (bf16_t*)(p.ws + OFF_Z); const float* ST = (const float*)(p.ws + OFF_SM + SM_ST);
    for (int u0 = (F.bid * 8 + F.wid) * 4; u0 < S_ * 4; u0 += F.G * 8 * 4) {
        f32x4 st[4][4]; u32x4 zz[4]; f32x4 g0[4], g1[4];
#pragma unroll
        for (int j = 0; j < 4; ++j) { const int u = u0 + j; const f32x4* sp = (const f32x4*)(ST + (size_t)u * 16);
            st[j][0] = sp[0]; st[j][1] = sp[1]; st[j][2] = sp[2]; st[j][3] = sp[3];
            zz[j] = *(const u32x4*)(Z + (size_t)(u >> 2) * 2048 + (u & 3) * 512 + F.lane * 8);
            g0[j] = *(const f32x4*)(p.ml_gn + (u & 3) * 512 + F.lane * 8); g1[j] = *(const f32x4*)(p.ml_gn + (u & 3) * 512 + F.lane * 8 + 4); }
#pragma unroll
        for (int j = 0; j < 4; ++j) { const int u = u0 + j; const f32x4 a = st[j][0], b = st[j][1], c = st[j][2], d = st[j][3];
            const float s = (a[0] + a[2]) + (b[0] + b[2]) + (c[0] + c[2]) + (d[0] + d[2]), q = (a[1] + a[3]) + (b[1] + b[3]) + (c[1] + c[3]) + (d[1] + d[3]);
            const float mu = s * (1.0f / 512.0f), rstd = rsqrtf(fmaxf(q * (1.0f / 512.0f) - mu * mu, 0.f) + EPS);
            float y[8]; unpack8(zz[j], y); f32x4 o0, o1;
#pragma unroll
            for (int e = 0; e < 4; ++e) { o0[e] = (y[e] - mu) * rstd * g0[j][e]; o1[e] = (y[4 + e] - mu) * rstd * g1[j][e]; }
            *(u32x4*)(Z + (size_t)(u >> 2) * 2048 + (u & 3) * 512 + F.lane * 8) = pack8(o0, o1); }
    }
}

__device__ __forceinline__ void ffn_fix_panel(const Frame& F, const Params& p, int layer, int pm) {
    const bf16_t* FH = (const bf16_t*)(p.ws + OFF_FH); bf16_t* ACT = (bf16_t*)(p.ws + OFF_ACT);
    const float* cw = p.fcw + (size_t)layer * 3 * 5632; const float* cb = p.fcb + (size_t)layer * 5632;
    if (F.tid < 352) {
        const int chn = F.tid * 8, pn = chn >> 7, cc = chn & 127;
        f32x4 bq[2][2], a0[2][2], a1[2][2], a2[2][2];
#pragma unroll
        for (int bj = 0; bj < 2; ++bj)
#pragma unroll
            for (int v = 0; v < 2; ++v) { const int wch = bj * DFF + chn + 4 * v;
                bq[bj][v] = *(const f32x4*)(cb + wch); a0[bj][v] = *(const f32x4*)(cw + wch); a1[bj][v] = *(const f32x4*)(cw + 5632 + wch); a2[bj][v] = *(const f32x4*)(cw + 2 * 5632 + wch); }
#pragma unroll 1
        for (int gb = 0; gb < 2; ++gb) {
            u32x4 h[2][2][4];
#pragma unroll
            for (int gi = 0; gi < 2; ++gi) { const int gq = pm * 4 + gb * 2 + gi;
#pragma unroll
                for (int bj = 0; bj < 2; ++bj) { const int col = pn * 256 + bj * 128 + cc; const u32x4 z = {0u, 0u, 0u, 0u};
                    h[gi][bj][0] = gq > 0 ? *(const u32x4*)(FH + ((size_t)(gq - 1) * 4 + 0) * 5632 + col) : z;
                    h[gi][bj][1] = gq > 0 ? *(const u32x4*)(FH + ((size_t)(gq - 1) * 4 + 1) * 5632 + col) : z;
                    h[gi][bj][2] = *(const u32x4*)(FH + ((size_t)gq * 4 + 2) * 5632 + col);
                    h[gi][bj][3] = *(const u32x4*)(FH + ((size_t)gq * 4 + 3) * 5632 + col); } }
#pragma unroll
            for (int gi = 0; gi < 2; ++gi) { const int gq = pm * 4 + gb * 2 + gi;
#pragma unroll
                for (int r = 0; r < 2; ++r) {
                    float ua[8], ub[8];
#pragma unroll
                    for (int bj = 0; bj < 2; ++bj) { float* uo = bj ? ub : ua; float x0[8], x1[8], x2[8];
                        unpack8(h[gi][bj][r], x0); unpack8(h[gi][bj][r + 1], x1); unpack8(h[gi][bj][r + 2], x2);
#pragma unroll
                        for (int v = 0; v < 2; ++v)
#pragma unroll
                            for (int e = 0; e < 4; ++e) uo[4 * v + e] = bq[bj][v][e] + a0[bj][v][e] * x0[4 * v + e] + a1[bj][v][e] * x1[4 * v + e] + a2[bj][v][e] * x2[4 * v + e]; }
                    f32x4 o0, o1;
#pragma unroll
                    for (int e = 0; e < 4; ++e) { o0[e] = siluf(ua[e]) * ub[e]; o1[e] = siluf(ua[4 + e]) * ub[4 + e]; }
                    *(u32x4*)(ACT + (size_t)(gq * 64 + r) * DFF + chn) = pack8(o0, o1); } }
        }
    }
}

__device__ __forceinline__ void final_norm(const Frame& F, const Params& p) {
    f32x4 g[4];
#pragma unroll
    for (int j = 0; j < 4; ++j) g[j] = *(const f32x4*)(p.fin_g + F.lane * 4 + 256 * j);
    for (int row0 = (F.bid * 8 + F.wid) * 8; row0 < S_; row0 += F.G * 8 * 8) {
        f32x4 xa[8][4];
#pragma unroll
        for (int rr = 0; rr < 8; ++rr)
#pragma unroll
            for (int j = 0; j < 4; ++j) xa[rr][j] = *(const f32x4*)(p.out + (size_t)(row0 + rr) * 1024 + F.lane * 4 + 256 * j);
#pragma unroll
        for (int rr = 0; rr < 8; ++rr) { float ss = 0.f;
#pragma unroll
            for (int j = 0; j < 4; ++j) ss += xa[rr][j][0] * xa[rr][j][0] + xa[rr][j][1] * xa[rr][j][1] + xa[rr][j][2] * xa[rr][j][2] + xa[rr][j][3] * xa[rr][j][3];
            ss = wave_sum(ss); const float rstd = rsqrtf(ss * (1.0f / 1024.0f) + EPS);
#pragma unroll
            for (int j = 0; j < 4; ++j) *(f32x4*)(p.out + (size_t)(row0 + rr) * 1024 + F.lane * 4 + 256 * j) = xa[rr][j] * rstd * g[j]; }
    }
}

#define XB_TMO      128
#define XB_XCNT(j)  (256  + 64 * (j))
#define XB_XSUB(j)  (1280 + 64 * (j))
#define XB_XGEN(j)  (2304 + 64 * (j))
#define XB_TOP      3328
#define XB_TOPGEN   3392
#define XCD_BAR_WORDS 3456
#define XB_SPIN_CAP (1u << 18)
__device__ __forceinline__ unsigned xb_ld(unsigned* p)              { return __hip_atomic_load(p, __ATOMIC_RELAXED, __HIP_MEMORY_SCOPE_AGENT); }
__device__ __forceinline__ unsigned xb_add(unsigned* p, unsigned v) { return __hip_atomic_fetch_add(p, v, __ATOMIC_RELAXED, __HIP_MEMORY_SCOPE_AGENT); }
__device__ __forceinline__ unsigned xb_xcc_id() { return (unsigned)__builtin_amdgcn_s_getreg((3 << 11) | 20) & 0xFu; }
#define XB_SPIN(cond, bar) do { unsigned _sp = 0; while (cond) { __builtin_amdgcn_s_sleep(1); \
    if ((++_sp & 255u) == 0u) { if (xb_ld(&(bar)[XB_TMO])) break; if (_sp > XB_SPIN_CAP) { atomicAdd(&(bar)[XB_TMO], 1u); break; } } } } while (0)
struct XcdBarrier { unsigned* bar; unsigned x; volatile LAS unsigned* st; };
__device__ __forceinline__ XcdBarrier xcd_barrier_post(unsigned* bar, volatile LAS unsigned* st) {
    XcdBarrier b; b.bar = bar; b.x = xb_xcc_id(); b.st = st;
    if (threadIdx.x == 0) (void)xb_add(&bar[XB_XCNT(b.x)], 1u);
    return b;
}
__device__ __forceinline__ void xcd_barrier_complete(unsigned* bar, unsigned x, unsigned& nloc, unsigned& nx) {
    const unsigned G = gridDim.x * gridDim.y * gridDim.z;
    unsigned sum, cnt, mine, sp = 0u;
    for (;;) {
        sum = 0u; cnt = 0u; mine = 0u;
#pragma unroll
        for (unsigned j = 0; j < 16; ++j) { const unsigned c = xb_ld(&bar[XB_XCNT(j)]); sum += c; cnt += (c > 0u) ? 1u : 0u; mine = (j == x) ? c : mine; }
        if (sum == G) break;
        __builtin_amdgcn_s_sleep(1);
        if ((++sp & 255u) == 0u) { if (xb_ld(&bar[XB_TMO])) break; if (sp > XB_SPIN_CAP) { atomicAdd(&bar[XB_TMO], 1u); break; } }
    }
    nloc = mine > 0u ? mine : 1u; nx = cnt > 0u ? cnt : 1u;
}
__device__ __forceinline__ void xcd_barrier(const XcdBarrier& b) {
    asm volatile("s_waitcnt vmcnt(0)" ::: "memory");
    __syncthreads();
    if (threadIdx.x == 0) {
        unsigned* bar = b.bar;
        __builtin_amdgcn_s_waitcnt(0);
        unsigned nloc = b.st[0], nx = b.st[1];
        if (nloc == 0u) { xcd_barrier_complete(bar, b.x, nloc, nx); b.st[0] = nloc; b.st[1] = nx; }
        const unsigned old = xb_add(&bar[XB_XSUB(b.x)], 1u);
        const unsigned gen = old / nloc;
        if (old + 1u == (gen + 1u) * nloc) {
            __builtin_amdgcn_fence(__ATOMIC_RELEASE, "agent");
            asm volatile("s_waitcnt vmcnt(0)" ::: "memory");
            const unsigned og = xb_add(&bar[XB_TOP], 1u);
            const unsigned tg = og / nx;
            if (og + 1u == (tg + 1u) * nx) xb_add(&bar[XB_TOPGEN], 1u);
            else XB_SPIN(xb_ld(&bar[XB_TOPGEN]) == tg, bar);
            __builtin_amdgcn_fence(__ATOMIC_ACQUIRE, "agent");
            asm volatile("s_waitcnt vmcnt(0)" ::: "memory");
        } else {
            XB_SPIN(xb_ld(&bar[XB_TOPGEN]) == gen, bar);
            __builtin_amdgcn_fence(__ATOMIC_ACQUIRE, "agent");
            asm volatile("s_waitcnt vmcnt(0)" ::: "memory");
        }
    }
    __syncthreads();
}

constexpr int N_PHASES = 33;
#ifdef ONLY_PH
#define PH_ON(k) ((k) == ONLY_PH)
#else
#define PH_ON(k) (p.ph_lo <= (k) && (k) < p.ph_hi)
#endif
#ifndef PROBE_CAT
#define PROBE_CAT 0
#endif
#if PROBE_CAT
#define RT() __builtin_amdgcn_s_memrealtime()
#define PH_END(k) do { if ((k) + 1 < p.ph_hi) { __syncthreads(); const unsigned long long t0_ = RT(); xcd_barrier(xbar); if (PROBE_CAT == 2) tprobe += RT() - t0_; } } while (0)
#define GT0 const unsigned long long tg0_ = RT();
#define GT1(c) if (PROBE_CAT == 1 || PROBE_CAT == (c)) tprobe += RT() - tg0_;
#else
#define PH_END(k) do { if ((k) + 1 < p.ph_hi) xcd_barrier(xbar); } while (0)
#define GT0
#define GT1(c)
#endif

typedef gm::SchedPlain SP;
template <int KIND> __device__ __forceinline__ SP sched_qk(const Frame& F, const Params& p, int pair) {
    const char* H = (const char*)(p.ws + OFF_H); const char* WIN = (const char*)(p.ws + OFF_WIN);
    return SP{H, WIN + (size_t)(pair * 512) * 2048, WIN + (size_t)(1024 + pair * 512) * 2048, 64, 4, 2, F.G, F.bid, (size_t)256 * 2048, (size_t)256 * 2048, 256, 0}; }
__device__ __forceinline__ SP sched_vt(const Frame& F, const Params& p, int pair) {
    const char* H = (const char*)(p.ws + OFF_H); const char* WIN = (const char*)(p.ws + OFF_WIN);
    return SP{WIN + (size_t)(2048 + pair * 1024) * 2048, H, H, 4, 64, 64, F.G, F.bid, (size_t)256 * 2048, (size_t)256 * 2048, 256, 1}; }
__device__ __forceinline__ SP sched_g(const Frame& F, const Params& p, int pair) {
    const char* H = (const char*)(p.ws + OFF_H); const char* WIN = (const char*)(p.ws + OFF_WIN);
    return SP{H, WIN + (size_t)(4096 + pair * 1024) * 2048, WIN, 64, 4, 4, F.G, F.bid, (size_t)256 * 2048, (size_t)256 * 2048, 2048, 0}; }
template <int KIND> __device__ __forceinline__ EpiQK<KIND> epi_qk(const Params& p, int pair) {
    return EpiQK<KIND>{(bf16_t*)(p.ws + OFF_Q), (bf16_t*)(p.ws + OFF_K), p.pos, (const float*)(p.ws + OFF_SM + SM_IFQ), (bf16_t*)(p.ws + OFF_SM + SM_QKH), (bf16_t*)(p.ws + OFF_KWT), (const float*)(p.ws + OFF_SM + SM_WK), pair}; }
template <int KIND> __device__ __forceinline__ EpiG<KIND> epi_g(const Params& p, int pair) {
    return EpiG<KIND>{(bf16_t*)(p.ws + OFF_Z), (float*)(p.ws + OFF_SM + SM_ST), KIND == 0 ? p.ret_gn : p.ml_gn, (const float*)(p.ws + OFF_SM + SM_PS), (const float*)(p.ws + OFF_SM + SM_XS),
                      (const float*)(p.ws + OFF_SM + SM_DC), (const float*)(p.ws + OFF_SM + SM_EM), pair}; }

template <int KIND, int PAIR> __device__ __forceinline__ void pair_core(const Frame& F0, const Params& p, const XcdBarrier& xbar, int base, unsigned long long& tprobe) {
    unsigned char* ws = p.ws; constexpr int pair = PAIR; constexpr int R = (KIND == 1) ? 1 : 0;
    if (KIND == 1) { if (PH_ON(base + 0)) { const Frame F = fresh(F0);
        if (pair == 0) prep_b(F, p);
        { GT0 r3_pass<KIND>(F, p, pair); GT1(9) }
        PH_END(base + 0); } }
    if (PH_ON(base + R)) { const Frame F = fresh(F0);
        { SchedKV S{(const char*)(ws + OFF_VT), (const char*)(ws + OFF_KWT), F.G, F.bid}; EpiPlain E{(bf16_t*)(ws + OFF_KVT), 256};
          { GT0 gm::gemm_phase<EpiPlain, SchedKV, false>(F.lds, gm::GP{256, 256, 4, 4}, S, E); GT1(5) } }
        { SchedS S{(const char*)(ws + OFF_Q), (const char*)(ws + OFF_K), F.G, (F.bid + 128) % F.G};
          EpiS<KIND == 1> E{(bf16_t*)(ws + OFF_P), (const float*)(ws + OFF_SM + SM_RB), (const float*)(ws + OFF_SM + SM_CB), (float*)(ws + OFF_SM + SM_PS), pair};
          { GT0 gm::gemm_phase<EpiS<KIND == 1>, SchedS, false>(F.lds, gm::GP{256, 256, 4, 4}, S, E); GT1(5) } }
        PH_END(base + R); }
    if (PH_ON(base + R + 1)) { const Frame F = fresh(F0); { GT0 scan_phase<KIND>(F, p, pair); GT1(10) } PH_END(base + R + 1); }
    if (PH_ON(base + R + 2)) { const Frame F = fresh(F0);
        SchedO S{(const char*)(ws + OFF_Q), (const char*)(ws + OFF_KVT), (const char*)(ws + OFF_P), (const char*)(ws + OFF_VT), F.G, F.bid};
        EpiO<KIND == 0> E{(bf16_t*)(ws + OFF_Z), (const float*)(ws + OFF_SM + SM_XS), (float*)(ws + OFF_SM + SM_ST), pair};
        { GT0 gm::gemm_phase<EpiO<KIND == 0>, SchedO, true>(F.lds, gm::GP{256, 256, 4, 8}, S, E); GT1(5) }
        PH_END(base + R + 2); }
}

template <int KIND> __device__ __forceinline__ void layer_program(const Frame& F0, const Params& p, const XcdBarrier& xbar, int base, unsigned long long& tprobe) {
    constexpr int layer = KIND;
    unsigned char* ws = p.ws; const float* MOD = (const float*)(ws + OFF_SM + SM_MOD) + layer * 6144;
    const char* H = (const char*)(ws + OFF_H);
    if (PH_ON(base)) { const Frame F = fresh(F0);
        { GT0 convert_mixer_weights(F, p, layer); GT1(7) }
        { GT0 norm_phase<KIND == 1>(F, p, layer == 0 ? p.x : p.out, p.ntg + layer * 1024, MOD, MOD + 1024); GT1(8) }
        PH_END(base); }
    if (PH_ON(base + 1)) { const Frame F = fresh(F0);
        gm::SchedMulti S{sched_qk<KIND>(F, p, 0), sched_vt(F, p, 0), sched_vt(F, p, 0), 256, 256, 0, F.G, F.bid};
        EpiMulti<EpiQK<KIND>, EpiPlain, EpiPlain> E{epi_qk<KIND>(p, 0), EpiPlain{(bf16_t*)(ws + OFF_VT), 256}, EpiPlain{(bf16_t*)(ws + OFF_VT), 256}};
        { GT0 gm::gemm_phase<EpiMulti<EpiQK<KIND>, EpiPlain, EpiPlain>, gm::SchedMulti, false>(F.lds, gm::GP{1024, 1024, 16, 16}, S, E); GT1(4) }
        if (KIND == 1) prep_a(F, p);
        PH_END(base + 1); }
    constexpr int PC = (KIND == 1) ? 4 : 3;
    pair_core<KIND, 0>(F0, p, xbar, base + 2, tprobe);
    if (PH_ON(base + 2 + PC)) { const Frame F = fresh(F0);
        gm::SchedMulti S{sched_g(F, p, 0), sched_qk<KIND>(F, p, 1), sched_vt(F, p, 1), 256, 256, 256, F.G, F.bid};
        EpiMulti<EpiG<KIND>, EpiQK<KIND>, EpiPlain> E{epi_g<KIND>(p, 0), epi_qk<KIND>(p, 1), EpiPlain{(bf16_t*)(ws + OFF_VT), 256}};
        { GT0 gm::gemm_phase<EpiMulti<EpiG<KIND>, EpiQK<KIND>, EpiPlain>, gm::SchedMulti, false>(F.lds, gm::GP{1024, 1024, 16, 16}, S, E); GT1(4) }
        PH_END(base + 2 + PC); }
    pair_core<KIND, 1>(F0, p, xbar, base + 3 + PC, tprobe);
    if (PH_ON(base + 3 + 2 * PC)) { const Frame F = fresh(F0);
        SP S = sched_g(F, p, 1); EpiG<KIND> E = epi_g<KIND>(p, 1);
        { GT0 gm::gemm_phase<EpiG<KIND>, SP, false>(F.lds, gm::GP{1024, 1024, 16, 16}, S, E); GT1(4) }
        PH_END(base + 3 + 2 * PC); }
    int k = base + 4 + 2 * PC;
    if (KIND == 1) { if (PH_ON(k)) { const Frame F = fresh(F0); { GT0 gn_pass(F, p); GT1(11) } PH_END(k); } ++k; }
    if (PH_ON(k)) { const Frame F = fresh(F0);
        SP S{(const char*)(ws + OFF_Z), (const char*)(ws + OFF_WOUT), (const char*)(ws + OFF_WOUT), 64, 4, 4, F.G, F.bid, (size_t)256 * 4096, (size_t)256 * 4096, 1024, 0};
        EpiRes E{layer == 0 ? p.x : p.out, p.out, MOD + 2048};
        { GT0 gm::gemm_phase<EpiRes, SP, false>(F.lds, gm::GP{2048, 2048, 32, 32}, S, E); GT1(6) }
        { GT0 convert_ffn_weights(F, p, layer, 0); GT1(7) }
        PH_END(k); }
    ++k;
    if (PH_ON(k)) { const Frame F = fresh(F0); { GT0 convert_ffn_weights(F, p, layer, 1); GT1(7) } { GT0 norm_phase<false>(F, p, p.out, p.nfg + layer * 1024, MOD + 3072, MOD + 4096); GT1(8) } PH_END(k); }
    ++k;
    if (PH_ON(k)) { const Frame F = fresh(F0);
        SP S{H, (const char*)(ws + OFF_WUP), (const char*)(ws + OFF_WUP), 64, 22, 22, F.G, F.bid, (size_t)256 * 2048, (size_t)256 * 2048, DFF, 0};
        EpiUp E{(bf16_t*)(ws + OFF_ACT), (bf16_t*)(ws + OFF_FH), p.fcw + (size_t)layer * 3 * 5632, p.fcb + (size_t)layer * 5632};
        { GT0 gm::gemm_phase<EpiUp, SP, false>(F.lds, gm::GP{1024, 1024, 16, 16}, S, E); GT1(3) }
        PH_END(k); }
    ++k;
    if (PH_ON(k)) { const Frame F = fresh(F0);
        SP S{(const char*)(ws + OFF_ACT), (const char*)(ws + OFF_WDN), (const char*)(ws + OFF_WDN), 64, 4, 4, F.G, F.bid, (size_t)256 * DFF * 2, (size_t)256 * DFF * 2, 1024, 0};
        { GT0 gm::U u; for (int i = 0; S.next(i, u); ++i) ffn_fix_panel(F, p, layer, u.i0);
          asm volatile("s_waitcnt vmcnt(0)" ::: "memory"); __syncthreads(); GT1(11) }
        EpiRes E{p.out, p.out, MOD + 5120};
        { GT0 gm::gemm_phase<EpiRes, SP, false>(F.lds, gm::GP{DFF, DFF, 44, 44}, S, E); GT1(6) }
        PH_END(k); }
}

__global__ void __launch_bounds__(512, 2) fwd_kernel(Params p) {
    extern __shared__ __attribute__((aligned(16))) unsigned char smem[];
    Frame F0; F0.lds = (LAS unsigned char*)smem; F0.G = gridDim.x; F0.bid = blockIdx.x; F0.tid = threadIdx.x; F0.wid = 0; F0.lane = 0;
    cg::grid_group grid = cg::this_grid();
    if (p.ph_hi < 0) grid.sync();
    unsigned long long tprobe = 0;
    volatile LAS unsigned* xst = (volatile LAS unsigned*)(smem + gm::STAGE_BYTES);
    if (threadIdx.x < 4) xst[threadIdx.x] = 0u;
    __syncthreads();
    const XcdBarrier xbar = xcd_barrier_post((unsigned*)(p.ws + OFF_SM + SM_BAR), xst);
    if (PH_ON(0)) { const Frame F = fresh(F0); { GT0 prologue_phase(F, p); GT1(11) } PH_END(0); }
    layer_program<0>(F0, p, xbar, 1, tprobe);
    layer_program<1>(F0, p, xbar, 15, tprobe);
    if (PH_ON(32)) { const Frame F = fresh(F0); { GT0 final_norm(F, p); GT1(11) } }
#if PROBE_CAT
    if (blockIdx.x == 0) { const unsigned long long t0 = RT(); while (RT() - t0 < tprobe) __builtin_amdgcn_s_sleep(8); }
#endif
}

extern "C" void kernel_launch(void* const* d_in, const int* in_sizes, int n_in, void* d_out, int out_size, void* d_ws, size_t ws_size, hipStream_t stream) {
    static int grid_blocks = 0;
    constexpr int LDS_BYTES = gm::STAGE_BYTES + 16;
    if (!grid_blocks) {
        int dev = 0, cus = 0, per_cu = 0;
        (void)hipGetDevice(&dev); (void)hipDeviceGetAttribute(&cus, hipDeviceAttributeMultiprocessorCount, dev);
        (void)hipFuncSetAttribute((const void*)fwd_kernel, hipFuncAttributeMaxDynamicSharedMemorySize, LDS_BYTES);
        (void)hipOccupancyMaxActiveBlocksPerMultiprocessor(&per_cu, (const void*)fwd_kernel, 512, LDS_BYTES);
        if (per_cu < 1) per_cu = 1;
        grid_blocks = cus;
        if (ws_size < WS_END) fprintf(stderr, "kernel_launch: workspace too small: %zu < %zu\n", ws_size, (size_t)WS_END);
        (void)hipGetLastError();
    }
    Params p{};
    p.x = (const float*)d_in[0]; p.c = (const float*)d_in[1]; p.pos = (const int*)d_in[2]; p.ada_w = (const float*)d_in[3]; p.ada_b = (const float*)d_in[4];
    p.ntg = (const float*)d_in[5]; p.nfg = (const float*)d_in[6]; p.ret_w_in = (const float*)d_in[7]; p.ret_gn = (const float*)d_in[8]; p.ret_w_out = (const float*)d_in[9];
    p.ml_w_in = (const float*)d_in[10]; p.ml_bg = (const float*)d_in[11]; p.ml_cw = (const float*)d_in[12]; p.ml_cb = (const float*)d_in[13]; p.ml_gn = (const float*)d_in[14];
    p.ml_w_out = (const float*)d_in[15]; p.up_w = (const float*)d_in[16]; p.fcw = (const float*)d_in[17]; p.fcb = (const float*)d_in[18]; p.dn_w = (const float*)d_in[19];
    p.fin_g = (const float*)d_in[20]; p.out = (float*)d_out; p.ws = (unsigned char*)d_ws;
#if MULTI_LAUNCH
    for (int ph = 0; ph < N_PHASES; ++ph) { p.ph_lo = ph; p.ph_hi = ph + 1; hipLaunchKernelGGL(fwd_kernel, dim3(grid_blocks), dim3(512), LDS_BYTES, stream, p); }
#else
    p.ph_lo = 0; p.ph_hi = N_PHASES;
    (void)hipMemsetAsync((unsigned char*)d_ws + OFF_SM + SM_BAR, 0, XCD_BAR_WORDS * 4, stream);
    void* args[] = {&p};
    hipError_t e = hipLaunchCooperativeKernel((void*)fwd_kernel, dim3(grid_blocks), dim3(512), args, LDS_BYTES, stream);
    if (e != hipSuccess) fprintf(stderr, "cooperative launch failed: %s (grid %d)\n", hipGetErrorString(e), grid_blocks);
#endif
}
```

```cpp
#include <hip/hip_runtime.h>
#include <hip/hip_cooperative_groups.h>
#include <cstdio>
namespace cg = cooperative_groups;

#ifndef MULTI_LAUNCH
#define MULTI_LAUNCH 0
#endif

#define LAS __attribute__((address_space(3)))
typedef unsigned short bf16_t;
typedef short bf16x8 __attribute__((ext_vector_type(8)));
typedef float f32x4 __attribute__((ext_vector_type(4)));
typedef unsigned u32x4 __attribute__((ext_vector_type(4)));
typedef unsigned u32x2 __attribute__((ext_vector_type(2)));

constexpr int S_ = 16384, D_ = 1024, DFF = 2816;
constexpr float EPS = 1e-6f;

constexpr size_t OFF_W = 0;
constexpr size_t OFF_WIN = 0, OFF_WOUT = 12582912, OFF_WUP = 0, OFF_WDN = 11534336;
constexpr size_t OFF_H = 17301504;
constexpr size_t OFF_SM = OFF_H + 33554432;
constexpr size_t SM_MOD = 0;
constexpr size_t SM_IFQ = SM_MOD + 49152;
constexpr size_t SM_RB = SM_IFQ + 512;
constexpr size_t TBL = 262144;
constexpr size_t SM_CB = SM_RB + TBL, SM_XS = SM_CB + TBL, SM_WK = SM_XS + TBL, SM_EM = SM_WK + TBL, SM_GG = SM_EM + TBL, SM_PM = SM_GG + TBL;
constexpr size_t SM_GL = SM_PM + TBL;
constexpr size_t SM_ML = SM_GL + 1024, SM_SCP = SM_ML + 1024, SM_SCN = SM_SCP + 1024;
constexpr size_t SM_LI = SM_SCN + 1024;
constexpr size_t SM_LF = SM_LI + 262144;
constexpr size_t SM_PS = SM_LF + 262144;
constexpr size_t SM_DC = SM_PS + 1048576;
constexpr size_t SM_NLOC = SM_DC + 262144;
constexpr size_t SM_ST = SM_NLOC + 262144;
constexpr size_t SM_QKH = SM_ST + 4194304;
constexpr size_t SM_BAR = SM_QKH + 1572864;
constexpr size_t SM_END = SM_BAR + 16384;
constexpr size_t OFF_BIG = OFF_SM + 10485760;
static_assert(SM_END <= 10485760, "small region");
constexpr size_t OFF_Q = OFF_BIG, OFF_K = OFF_Q + 16777216, OFF_KWT = OFF_K + 16777216, OFF_VT = OFF_KWT + 16777216,
                 OFF_KVT = OFF_VT + 33554432, OFF_P = OFF_KVT + 33554432, OFF_Z = OFF_P + 16777216, WS_END = OFF_Z + 67108864;
constexpr size_t OFF_ACT = OFF_BIG, OFF_FH = OFF_ACT + 92274688;

struct Params {
    const float *x, *c; const int* pos; const float *ada_w, *ada_b, *ntg, *nfg, *ret_w_in, *ret_gn, *ret_w_out,
        *ml_w_in, *ml_bg, *ml_cw, *ml_cb, *ml_gn, *ml_w_out, *up_w, *fcw, *fcb, *dn_w, *fin_g;
    float* out; unsigned char* ws; int ph_lo, ph_hi;
};

__device__ __forceinline__ unsigned cvt_pk_bf16(float lo, float hi) { unsigned r; asm volatile("v_cvt_pk_bf16_f32 %0, %1, %2" : "=v"(r) : "v"(lo), "v"(hi)); return r; }
__device__ __forceinline__ float bf_lo(unsigned w) { return __uint_as_float(w << 16); }
__device__ __forceinline__ float bf_hi(unsigned w) { return __uint_as_float(w & 0xffff0000u); }
__device__ __forceinline__ float siluf(float v) { return v * __builtin_amdgcn_rcpf(1.0f + __expf(-v)); }
__device__ __forceinline__ float sigmf(float v) { return __builtin_amdgcn_rcpf(1.0f + __expf(-v)); }
__device__ __forceinline__ float dpp_shr1(float old, float x) { return __builtin_bit_cast(float, __builtin_amdgcn_update_dpp(__builtin_bit_cast(int, old), __builtin_bit_cast(int, x), 0x111, 0xf, 0xf, false)); }
__device__ __forceinline__ float dpp_shr2(float old, float x) { return __builtin_bit_cast(float, __builtin_amdgcn_update_dpp(__builtin_bit_cast(int, old), __builtin_bit_cast(int, x), 0x112, 0xf, 0xf, false)); }
__device__ __forceinline__ float dpp_ror1(float x) { return __builtin_bit_cast(float, __builtin_amdgcn_update_dpp(0, __builtin_bit_cast(int, x), 0x121, 0xf, 0xf, true)); }
__device__ __forceinline__ float dpp_ror2(float x) { return __builtin_bit_cast(float, __builtin_amdgcn_update_dpp(0, __builtin_bit_cast(int, x), 0x122, 0xf, 0xf, true)); }
__device__ __forceinline__ float dpp_mirror(float x) { return __builtin_bit_cast(float, __builtin_amdgcn_update_dpp(0, __builtin_bit_cast(int, x), 0x140, 0xf, 0xf, true)); }
__device__ __forceinline__ float dpp_swap01(float x) { return __builtin_bit_cast(float, __builtin_amdgcn_update_dpp(0, __builtin_bit_cast(int, x), 0xB1, 0xf, 0xf, true)); }
__device__ __forceinline__ float wave_sum(float v) { for (int o = 32; o >= 1; o >>= 1) v += __shfl_xor(v, o); return v; }
__device__ __forceinline__ u32x4 pack8(const f32x4 a, const f32x4 b) { u32x4 w; w.x = cvt_pk_bf16(a[0], a[1]); w.y = cvt_pk_bf16(a[2], a[3]); w.z = cvt_pk_bf16(b[0], b[1]); w.w = cvt_pk_bf16(b[2], b[3]); return w; }
__device__ __forceinline__ void unpack8(const u32x4 w, float (&f)[8]) { f[0] = bf_lo(w.x); f[1] = bf_hi(w.x); f[2] = bf_lo(w.y); f[3] = bf_hi(w.y); f[4] = bf_lo(w.z); f[5] = bf_hi(w.z); f[6] = bf_lo(w.w); f[7] = bf_hi(w.w); }

namespace gm {
constexpr int BM = 256, BK = 64, HALF = 128, HTB = HALF * BK * 2, STAGE_BYTES = 8 * HTB, NXCD = 8, WGM = 8;
__device__ __forceinline__ int lds_byte(int r, int c) { const int st = (r >> 4) * 2 + (c >> 5), rr = r & 15, cc = c & 31, ob = rr * 64 + cc * 2; return st * 1024 + (ob ^ (((ob >> 9) & 1) << 5)); }
__device__ __forceinline__ void stage_rc(int b, int& R, int& C) { const int st = b / 1024, sb = b % 1024, swz = sb ^ (((sb >> 9) & 1) << 5); R = (st >> 1) * 16 + swz / 64; C = (st & 1) * 32 + (swz % 64) / 2; }
__device__ __forceinline__ int perm32(int rho) { const int n = rho >> 4, i = rho & 15; return 8 * (i >> 2) + 4 * n + (i & 3); }

struct U { const char *a1, *b1, *a2, *b2; long co; int i0, i1, i2, i3; };
struct GP { int lda, ldb, n1, nt; };

struct SchedPlain {
    const char* A; const char* B; const char* B2; int nM, nN, nsplit, G, c; size_t ta, tb; long ldc; int vt;
    __device__ __forceinline__ bool next(int i, U& u) const { return at((long)i * G + c, u); }
    __device__ __forceinline__ bool at(long L, U& u) const {
        const int nwg = nM * nN; if (L >= nwg) return false;
        int wgid = (int)L; { const int q = nwg / NXCD, r = nwg % NXCD, xcd = wgid % NXCD, off = wgid / NXCD; wgid = (xcd < r ? xcd * (q + 1) : r * (q + 1) + (xcd - r) * q) + off; }
        const int nig = WGM * nN, gid = wgid / nig, fm = gid * WGM, gsz = (nM - fm) < WGM ? (nM - fm) : WGM;
        const int pm = fm + ((wgid % nig) % gsz), pn = (wgid % nig) / gsz;
        u.a1 = A + (size_t)pm * ta; u.b1 = pn < nsplit ? B + (size_t)pn * tb : B2 + (size_t)(pn - nsplit) * tb; u.a2 = u.a1; u.b2 = u.b1;
        u.co = vt ? ((long)((pm >> 1) * 64 + pn) * 512 + (pm & 1) * 256) * 256 : (long)pm * 256 * ldc + (long)pn * 256; u.i0 = pm; u.i1 = pn; u.i2 = 0; u.i3 = 0; return true;
    }
};

struct SchedMulti {
    SchedPlain s0, s1, s2; int n0, n1, n2, G, c;
    __device__ __forceinline__ bool next(int i, U& u) const {
        const long L = (long)i * G + c; bool ok; int w;
        if (L < n0) { ok = s0.at(L, u); w = 0; } else if (L < n0 + n1) { ok = s1.at(L - n0, u); w = 1; } else if (L < n0 + n1 + n2) { ok = s2.at(L - n0 - n1, u); w = 2; } else return false;
        u.i3 = w; return ok;
    }
};

template <class Epi, class Sched, bool TWOSEG>
__device__ __forceinline__ void gemm_phase(LAS unsigned char* lds, const GP g, const Sched& S, const Epi& E) {
    int tid = threadIdx.x; asm volatile("" : "+v"(tid));
    const int wid = __builtin_amdgcn_readfirstlane(tid >> 6), lane = tid & 63, wr = wid >> 2, wc = wid & 3, fr = lane & 15, fq = lane >> 4;
    const int nt = g.nt;
    unsigned voffA[2], voffB[2];
#pragma unroll
    for (int i = 0; i < 2; ++i) { int R, C; stage_rc(tid * 16 + i * 8192, R, C); const int Rb = Epi::PERM ? ((R & ~31) + perm32(R & 31)) : R;
        voffA[i] = (unsigned)(R * g.lda + C) * 2u; voffB[i] = (unsigned)(Rb * g.ldb + C) * 2u; }
    const size_t hsA1 = (size_t)HALF * g.lda * 2, hsB1 = (size_t)HALF * g.ldb * 2;
    const unsigned ldsw = (unsigned)wid * 1024u;
    const int aoff = lds_byte(wr * 64 + fr, fq * 8), boff = lds_byte(wc * 32 + fr, fq * 8);
#define G_SA(b, h) (((b) * 2 + (h)) * HTB)
#define G_SB(b, h) ((4 + (b) * 2 + (h)) * HTB)
#define G_STAGE(bufoff, gbase, voff) do { _Pragma("unroll") for (int _i = 0; _i < 2; ++_i) \
        __builtin_amdgcn_global_load_lds((const unsigned*)((const char*)(gbase) + (voff)[_i]), (LAS unsigned*)(lds + (bufoff) + ldsw + _i * 8192), 16, 0, 0); } while (0)
#define G_LDA(dst, b, h) do { _Pragma("unroll") for (int m = 0; m < 4; ++m) _Pragma("unroll") for (int k = 0; k < 2; ++k) dst[m][k] = *(const LAS bf16x8*)(lds + G_SA(b, h) + aoff + m * 2048 + k * 1024); } while (0)
#define G_LDB(dst, b, h) do { _Pragma("unroll") for (int n = 0; n < 2; ++n) _Pragma("unroll") for (int k = 0; k < 2; ++k) dst[n][k] = *(const LAS bf16x8*)(lds + G_SB(b, h) + boff + n * 2048 + k * 1024); } while (0)
#define G_MMA(ai, bj, At, Bt) do { __builtin_amdgcn_s_setprio(1); _Pragma("unroll") for (int m = 0; m < 4; ++m) _Pragma("unroll") for (int n = 0; n < 2; ++n) _Pragma("unroll") for (int k = 0; k < 2; ++k) \
        acc[ai][bj][m][n] = __builtin_amdgcn_mfma_f32_16x16x32_bf16(Bt[n][k], At[m][k], acc[ai][bj][m][n], 0, 0, 0); __builtin_amdgcn_s_setprio(0); } while (0)
#define G_WAIT_V(n) asm volatile("s_waitcnt vmcnt(" #n ")" ::: "memory")
#define G_WAIT_L(n) asm volatile("s_waitcnt lgkmcnt(" #n ")" ::: "memory")
#define G_BAR __builtin_amdgcn_s_barrier()
#define G_SCHED __builtin_amdgcn_sched_barrier(0)
    U cur, nxt; int ui = 0;
    if (!S.next(0, cur)) return;
    f32x4 acc[2][2][4][2];
#pragma unroll
    for (int a = 0; a < 2; ++a)
#pragma unroll
        for (int b = 0; b < 2; ++b)
#pragma unroll
            for (int m = 0; m < 4; ++m)
#pragma unroll
                for (int n = 0; n < 2; ++n) acc[a][b][m][n] = (f32x4){0.f, 0.f, 0.f, 0.f};
    bf16x8 At[4][2], B0[2][2], B1[2][2];
    G_STAGE(G_SB(0, 0), cur.b1, voffB); G_STAGE(G_SA(0, 0), cur.a1, voffA); G_STAGE(G_SB(0, 1), cur.b1 + hsB1, voffB); G_STAGE(G_SA(0, 1), cur.a1 + hsA1, voffA);
    if (wr == 1) G_BAR;
    G_WAIT_V(4); G_BAR;
    G_STAGE(G_SB(1, 0), cur.b1 + 128, voffB); G_STAGE(G_SA(1, 0), cur.a1 + 128, voffA); G_STAGE(G_SB(1, 1), cur.b1 + hsB1 + 128, voffB);
    G_WAIT_V(6); G_BAR;
    for (;;) {
        const bool has_next = S.next(ui + 1, nxt);
        const char* nA = has_next ? nxt.a1 : cur.a1; const char* nB = has_next ? nxt.b1 : cur.b1;
        for (int t = 0; t < nt; t += 2) {
            const bool last = (t == nt - 2);
            const bool sg1 = TWOSEG && (t >= g.n1);
            const bool sg2 = TWOSEG && !last && (t + 2 >= g.n1);
            const char* a1 = sg1 ? cur.a2 + (size_t)(t + 1 - g.n1) * 128 : cur.a1 + (size_t)(t + 1) * 128;
            const char* a2 = last ? nA : (sg2 ? cur.a2 + (size_t)(t + 2 - g.n1) * 128 : cur.a1 + (size_t)(t + 2) * 128);
            const char* b2 = last ? nB : (sg2 ? cur.b2 + (size_t)(t + 2 - g.n1) * 128 : cur.b1 + (size_t)(t + 2) * 128);
            const char* a3 = a2 + 128; const char* b3 = b2 + 128;
            if (TWOSEG) { if (t == g.n1) E.mid(acc, cur, wr, wc, fr, fq); }
            G_LDB(B0, 0, 0); G_SCHED; G_LDA(At, 0, 0); G_STAGE(G_SA(1, 1), a1 + hsA1, voffA);
            G_WAIT_L(8); G_BAR; G_WAIT_L(0); G_MMA(0, 0, At, B0); G_BAR; G_SCHED;
            G_LDB(B1, 0, 1); G_STAGE(G_SB(0, 0), b2, voffB);
            G_BAR; G_WAIT_L(0); G_MMA(0, 1, At, B1); G_BAR;
            G_LDA(At, 0, 1); G_STAGE(G_SA(0, 0), a2, voffA);
            G_BAR; G_WAIT_L(0); G_MMA(1, 0, At, B0); G_BAR; G_SCHED;
            G_STAGE(G_SB(0, 1), b2 + hsB1, voffB);
            G_WAIT_V(6); G_BAR; G_MMA(1, 1, At, B1); G_BAR;
            G_LDB(B0, 1, 0); G_SCHED; G_LDA(At, 1, 0); G_STAGE(G_SA(0, 1), a2 + hsA1, voffA);
            G_WAIT_L(8); G_BAR; G_WAIT_L(0); G_MMA(0, 0, At, B0); G_BAR; G_SCHED;
            G_LDB(B1, 1, 1); G_STAGE(G_SB(1, 0), b3, voffB);
            G_BAR; G_WAIT_L(0); G_MMA(0, 1, At, B1); G_BAR;
            G_LDA(At, 1, 1); G_STAGE(G_SA(1, 0), a3, voffA);
            G_BAR; G_WAIT_L(0); G_MMA(1, 0, At, B0); G_BAR; G_SCHED;
            G_STAGE(G_SB(1, 1), b3 + hsB1, voffB);
            G_WAIT_V(6); G_BAR; G_MMA(1, 1, At, B1); G_BAR;
        }
        E(acc, cur, wr, wc, fr, fq);
        if (!has_next) break;
#pragma unroll
        for (int a = 0; a < 2; ++a)
#pragma unroll
            for (int b = 0; b < 2; ++b)
#pragma unroll
                for (int m = 0; m < 4; ++m)
#pragma unroll
                    for (int n = 0; n < 2; ++n) acc[a][b][m][n] = (f32x4){0.f, 0.f, 0.f, 0.f};
        cur = nxt; ++ui;
    }
    G_WAIT_V(0);
    if (wr == 0) G_BAR;
    G_BAR;
#undef G_SA
#undef G_SB
#undef G_STAGE
#undef G_LDA
#undef G_LDB
#undef G_MMA
#undef G_WAIT_V
#undef G_WAIT_L
#undef G_BAR
#undef G_SCHED
}
}

typedef f32x4 Acc[2][2][4][2];

struct EpiPlain {
    static constexpr bool PERM = true; bf16_t* base; long ldc;
    __device__ __forceinline__ void mid(Acc&, const gm::U&, int, int, int, int) const {}
    __device__ __forceinline__ void operator()(const Acc& acc, const gm::U& u, int wr, int wc, int fr_, int fq_) const {
        int fr = fr_, fq = fq_; asm volatile("" : "+v"(fr), "+v"(fq));
        bf16_t* d = base + u.co + (long)(wr * 64 + fr) * ldc + wc * 32 + 8 * fq;
#pragma unroll
        for (int ai = 0; ai < 2; ++ai)
#pragma unroll
            for (int m = 0; m < 4; ++m)
#pragma unroll
                for (int bj = 0; bj < 2; ++bj) *(u32x4*)(d + (long)(ai * 128 + m * 16) * ldc + bj * 128) = pack8(acc[ai][bj][m][0], acc[ai][bj][m][1]);
    }
};

template <int KIND> struct EpiQK {
    static constexpr bool PERM = true; bf16_t* Q; bf16_t* K; const int* pos; const float* ifq; bf16_t* qkh; bf16_t* kwt; const float* wkt; int pair;
    __device__ __forceinline__ void mid(Acc&, const gm::U&, int, int, int, int) const {}
    __device__ __forceinline__ void operator()(const Acc& acc, const gm::U& u, int wr, int wc, int fr_, int fq_) const {
        int fr = fr_, fq = fq_; asm volatile("" : "+v"(fr), "+v"(fq));
        const int pm = u.i0, pn = u.i1, d0 = wc * 32 + 8 * fq;
        bf16_t* dst = (pn < 2 ? Q : K) + (size_t)(pn & 1) * S_ * 256 + d0;
        if (KIND == 0) {
            const float sc = pn < 2 ? 1.0f : 0.0625f;
            const f32x4 f0 = *(const f32x4*)(ifq + d0), f1 = *(const f32x4*)(ifq + d0 + 4);
#pragma unroll
            for (int ai = 0; ai < 2; ++ai)
#pragma unroll
                for (int m = 0; m < 4; ++m) {
                    const int t = pm * 256 + ai * 128 + wr * 64 + m * 16 + fr; const float pf = (float)pos[t];
                    f32x4 o1[2], o2[2];
#pragma unroll
                    for (int n = 0; n < 2; ++n)
#pragma unroll
                        for (int e = 0; e < 4; ++e) {
                            const float ang = pf * (n ? f1[e] : f0[e]);
                            const double rev = (double)ang * 0.15915494309189535; const float fx = (float)(rev - __builtin_rint(rev));
                            const float sn = __builtin_amdgcn_sinf(fx), cs = __builtin_amdgcn_cosf(fx);
                            const float t1 = acc[ai][0][m][n][e], t2 = acc[ai][1][m][n][e];
                            o1[n][e] = (t1 * cs - t2 * sn) * sc; o2[n][e] = (t1 * sn + t2 * cs) * sc; }
                    *(u32x4*)(dst + (size_t)t * 256) = pack8(o1[0], o1[1]); *(u32x4*)(dst + (size_t)t * 256 + 128) = pack8(o2[0], o2[1]);
                    if (pn >= 2) {
                        const int h2 = pn & 1, tl = ai * 128 + wr * 64 + m * 16 + fr; const float wk = wkt[(size_t)(2 * pair + h2) * S_ + t];
                        bf16_t* kp = kwt + ((size_t)(h2 * 64 + pm) * 256 + d0) * 256 + tl;
#pragma unroll
                        for (int n = 0; n < 2; ++n)
#pragma unroll
                            for (int e = 0; e < 4; e += 2) { const unsigned w1 = cvt_pk_bf16(o1[n][e] * wk, o1[n][e + 1] * wk), w2 = cvt_pk_bf16(o2[n][e] * wk, o2[n][e + 1] * wk);
                                kp[(size_t)(4 * n + e) * 256] = (bf16_t)(w1 & 0xffffu); kp[(size_t)(4 * n + e + 1) * 256] = (bf16_t)(w1 >> 16);
                                kp[(size_t)(128 + 4 * n + e) * 256] = (bf16_t)(w2 & 0xffffu); kp[(size_t)(128 + 4 * n + e + 1) * 256] = (bf16_t)(w2 >> 16); } } }
        } else {
#pragma unroll
            for (int ai = 0; ai < 2; ++ai)
#pragma unroll
                for (int m = 0; m < 4; ++m) {
                    const int t = pm * 256 + ai * 128 + wr * 64 + m * 16 + fr;
#pragma unroll
                    for (int bj = 0; bj < 2; ++bj) { const u32x4 w = pack8(acc[ai][bj][m][0], acc[ai][bj][m][1]);
                        *(u32x4*)(dst + (size_t)t * 256 + bj * 128) = w;
                        if (m == 3 && fr >= 13) { const int gq = pm * 4 + ai * 2 + wr; *(u32x4*)(qkh + ((size_t)gq * 3 + (fr - 13)) * 1024 + pn * 256 + bj * 128 + d0) = w; } } }
        }
    }
};

template <bool PSUM> struct EpiS {
    static constexpr bool PERM = true; bf16_t* P; const float* RB; const float* CB; float* PS; int pair;
    __device__ __forceinline__ void mid(Acc&, const gm::U&, int, int, int, int) const {}
    __device__ __forceinline__ void operator()(const Acc& acc, const gm::U& u, int wr, int wc, int fr_, int fq_) const {
        int fr = fr_, fq = fq_; asm volatile("" : "+v"(fr), "+v"(fq));
        const int ch = u.i0, h2 = u.i1, h = 2 * pair + h2, c0 = wc * 32 + 8 * fq;
        const float* rb = RB + (size_t)h * S_ + ch * 256 + wr * 64 + fr; const float* cb = CB + (size_t)h * S_ + ch * 256 + c0;
        bf16_t* d = P + ((size_t)(h2 * 64 + ch) * 256 + wr * 64 + fr) * 256 + c0;
        float rbv[2][4], rs[2][4];
#pragma unroll
        for (int ai = 0; ai < 2; ++ai)
#pragma unroll
            for (int m = 0; m < 4; ++m) { rbv[ai][m] = rb[ai * 128 + m * 16]; rs[ai][m] = 0.f; }
#pragma unroll
        for (int bj = 0; bj < 2; ++bj)
#pragma unroll
            for (int n = 0; n < 2; ++n) {
                const f32x4 cbv = *(const f32x4*)(cb + bj * 128 + 4 * n);
#pragma unroll
                for (int ai = 0; ai < 2; ++ai)
#pragma unroll
                    for (int m = 0; m < 4; ++m) {
                        const int dij = (ai * 128 + wr * 64 + m * 16 + fr) - (bj * 128 + c0 + 4 * n);
                        f32x4 v;
#pragma unroll
                        for (int e = 0; e < 4; ++e) { const float w = (dij - e >= 0) ? acc[ai][bj][m][n][e] * __builtin_amdgcn_exp2f((rbv[ai][m] + cbv[e]) * 1.44269504f) : 0.f; v[e] = w; rs[ai][m] += w; }
                        u32x2 pk; pk.x = cvt_pk_bf16(v[0], v[1]); pk.y = cvt_pk_bf16(v[2], v[3]);
                        *(u32x2*)(d + (size_t)(ai * 128 + m * 16) * 256 + bj * 128 + 4 * n) = pk; }
            }
        if (PSUM) {
#pragma unroll
            for (int ai = 0; ai < 2; ++ai)
#pragma unroll
                for (int m = 0; m < 4; ++m) { float r = rs[ai][m]; r += __shfl_xor(r, 16); r += __shfl_xor(r, 32);
                    if (fq == 0) PS[((size_t)(ch * 256 + ai * 128 + wr * 64 + m * 16 + fr) * 4 + h) * 4 + wc] = r; } }
    }
};

template <bool STATS> struct EpiO {
    static constexpr bool PERM = true; bf16_t* Z; const float* XS; float* ST; int pair;
    __device__ __forceinline__ void mid(Acc& acc, const gm::U& u, int wr, int wc, int fr, int fq) const {
        const int ch = u.i0, h = 2 * pair + u.i1; const float* xs = XS + (size_t)h * S_ + ch * 256 + wr * 64 + fr;
#pragma unroll
        for (int ai = 0; ai < 2; ++ai)
#pragma unroll
            for (int m = 0; m < 4; ++m) { const float x = xs[ai * 128 + m * 16];
#pragma unroll
                for (int bj = 0; bj < 2; ++bj)
#pragma unroll
                    for (int n = 0; n < 2; ++n) acc[ai][bj][m][n] *= x; }
    }
    __device__ __forceinline__ void operator()(const Acc& acc, const gm::U& u, int wr, int wc, int fr_, int fq_) const {
        int fr = fr_, fq = fq_; asm volatile("" : "+v"(fr), "+v"(fq));
        const int ch = u.i0, h = 2 * pair + u.i1, nt2 = u.i2, c0 = wc * 32 + 8 * fq;
        bf16_t* d = Z + (size_t)(ch * 256) * 2048 + h * 512 + nt2 * 256 + c0;
#pragma unroll
        for (int ai = 0; ai < 2; ++ai)
#pragma unroll
            for (int m = 0; m < 4; ++m) {
                const int i = ai * 128 + wr * 64 + m * 16 + fr; float s = 0.f, q = 0.f;
#pragma unroll
                for (int bj = 0; bj < 2; ++bj) { *(u32x4*)(d + (size_t)i * 2048 + bj * 128) = pack8(acc[ai][bj][m][0], acc[ai][bj][m][1]);
                    if (STATS) {
#pragma unroll
                        for (int n = 0; n < 2; ++n)
#pragma unroll
                            for (int e = 0; e < 4; ++e) { const float v = acc[ai][bj][m][n][e]; s += v; q += v * v; } } }
                if (STATS) { s += __shfl_xor(s, 16); s += __shfl_xor(s, 32); q += __shfl_xor(q, 16); q += __shfl_xor(q, 32);
                    if (fq == 0) { float* st = ST + (((size_t)(ch * 256 + i) * 4 + h) * 8 + nt2 * 4 + wc) * 2; st[0] = s; st[1] = q; } } }
    }
};

template <int KIND> struct EpiG {
    static constexpr bool PERM = true; bf16_t* Z; float* ST; const float* gng; const float* PS; const float* XS; const float* DC; const float* EM; int pair;
    __device__ __forceinline__ void mid(Acc&, const gm::U&, int, int, int, int) const {}
    __device__ __forceinline__ void operator()(const Acc& acc, const gm::U& u, int wr, int wc, int fr_, int fq_) const {
        int fr = fr_, fq = fq_; asm volatile("" : "+v"(fr), "+v"(fq));
        const int pm = u.i0, pn = u.i1, h = 2 * pair + (pn >> 1), nt2 = pn & 1, c0 = wc * 32 + 8 * fq;
        const int colb = pair * 1024 + pn * 256 + c0;
        f32x4 gv[2][2];
        if (KIND == 0) {
#pragma unroll
            for (int bj = 0; bj < 2; ++bj)
#pragma unroll
                for (int n = 0; n < 2; ++n) gv[bj][n] = *(const f32x4*)(gng + colb + bj * 128 + 4 * n);
        }
#pragma unroll
        for (int ai = 0; ai < 2; ++ai)
#pragma unroll
            for (int m = 0; m < 4; ++m) {
                const int t = pm * 256 + ai * 128 + wr * 64 + m * 16 + fr;
                bf16_t* zp = Z + (size_t)t * 2048 + colb;
                if (KIND == 0) {
                    const f32x4* st = (const f32x4*)(ST + ((size_t)t * 4 + h) * 16);
                    const f32x4 a = st[0], b = st[1], c = st[2], d = st[3];
                    const float s = (a[0] + a[2]) + (b[0] + b[2]) + (c[0] + c[2]) + (d[0] + d[2]);
                    const float q = (a[1] + a[3]) + (b[1] + b[3]) + (c[1] + c[3]) + (d[1] + d[3]);
                    const float mu = s * (1.0f / 512.0f); const float var = fmaxf(q * (1.0f / 512.0f) - mu * mu, 0.f); const float rstd = rsqrtf(var + EPS);
#pragma unroll
                    for (int bj = 0; bj < 2; ++bj) { float y[8]; unpack8(*(const u32x4*)(zp + bj * 128), y); f32x4 o[2];
#pragma unroll
                        for (int n = 0; n < 2; ++n)
#pragma unroll
                            for (int e = 0; e < 4; ++e) o[n][e] = siluf(acc[ai][bj][m][n][e]) * (y[4 * n + e] - mu) * rstd * gv[bj][n][e];
                        *(u32x4*)(zp + bj * 128) = pack8(o[0], o[1]); }
                } else {
                    const f32x4 ps = *(const f32x4*)(PS + ((size_t)t * 4 + h) * 4);
                    const float den = (ps[0] + ps[1]) + (ps[2] + ps[3]) + XS[(size_t)h * S_ + t] * DC[(size_t)t * 4 + h];
                    const float inv = __builtin_amdgcn_rcpf(fmaxf(fabsf(den), EM[(size_t)h * S_ + t]));
                    float s = 0.f, q = 0.f;
#pragma unroll
                    for (int bj = 0; bj < 2; ++bj) { float y[8]; unpack8(*(const u32x4*)(zp + bj * 128), y); f32x4 o[2];
#pragma unroll
                        for (int n = 0; n < 2; ++n)
#pragma unroll
                            for (int e = 0; e < 4; ++e) { const float v = sigmf(acc[ai][bj][m][n][e]) * y[4 * n + e] * inv; o[n][e] = v; s += v; q += v * v; }
                        *(u32x4*)(zp + bj * 128) = pack8(o[0], o[1]); }
                    s += __shfl_xor(s, 16); s += __shfl_xor(s, 32); q += __shfl_xor(q, 16); q += __shfl_xor(q, 32);
                    if (fq == 0) { float* st = ST + (((size_t)t * 4 + h) * 8 + nt2 * 4 + wc) * 2; st[0] = s; st[1] = q; }
                }
            }
    }
};

struct EpiRes {
    static constexpr bool PERM = false; const float* base; float* out; const float* gate;
    __device__ __forceinline__ void mid(Acc&, const gm::U&, int, int, int, int) const {}
    __device__ __forceinline__ void operator()(const Acc& acc, const gm::U& u, int wr, int wc, int fr_, int fq_) const {
        int fr = fr_, fq = fq_; asm volatile("" : "+v"(fr), "+v"(fq));
        const int row0 = u.i0 * 256 + wr * 64 + fr, col0 = u.i1 * 256 + wc * 32 + 4 * fq;
        f32x4 gv[2][2];
#pragma unroll
        for (int bj = 0; bj < 2; ++bj)
#pragma unroll
            for (int n = 0; n < 2; ++n) gv[bj][n] = *(const f32x4*)(gate + col0 + bj * 128 + n * 16);
#pragma unroll
        for (int ai = 0; ai < 2; ++ai)
#pragma unroll
            for (int m = 0; m < 4; ++m) { const size_t ro = (size_t)(row0 + ai * 128 + m * 16) * 1024 + col0;
#pragma unroll
                for (int bj = 0; bj < 2; ++bj)
#pragma unroll
                    for (int n = 0; n < 2; ++n) { const size_t o = ro + bj * 128 + n * 16; const f32x4 b = *(const f32x4*)(base + o); *(f32x4*)(out + o) = b + gv[bj][n] * acc[ai][bj][m][n]; } }
    }
};

struct EpiUp {
    static constexpr bool PERM = true; bf16_t* act; bf16_t* fh; const float* cw; const float* cb;
    __device__ __forceinline__ void mid(Acc&, const gm::U&, int, int, int, int) const {}
    __device__ __forceinline__ void operator()(const Acc& acc, const gm::U& u, int wr, int wc, int fr_, int fq_) const {
        int fr = fr_, fq = fq_; asm volatile("" : "+v"(fr), "+v"(fq));
        const int pm = u.i0, pn = u.i1, c0 = wc * 32 + 8 * fq, lane = fq * 16 + fr;
        u32x2 pk0[2][4];
#pragma unroll
        for (int n = 0; n < 2; ++n) {
            f32x4 w0[2], w1[2], w2[2], bb[2];
#pragma unroll
            for (int bj = 0; bj < 2; ++bj) { const int chn = bj * DFF + pn * 128 + c0 + 4 * n;
                w0[bj] = *(const f32x4*)(cw + chn); w1[bj] = *(const f32x4*)(cw + 2 * DFF + chn); w2[bj] = *(const f32x4*)(cw + 4 * DFF + chn); bb[bj] = *(const f32x4*)(cb + chn); }
#pragma unroll
            for (int ai = 0; ai < 2; ++ai)
#pragma unroll
                for (int m = 0; m < 4; ++m) {
                    f32x4 uu[2];
#pragma unroll
                    for (int bj = 0; bj < 2; ++bj)
#pragma unroll
                        for (int e = 0; e < 4; ++e) {
                            const float cur = acc[ai][bj][m][n][e]; const float prv = acc[ai][bj][m > 0 ? m - 1 : 0][n][e];
                            const float mr = dpp_mirror(prv), mr2 = dpp_swap01(mr);
                            const float p1 = dpp_shr1(mr, cur), p2 = dpp_shr2(mr2, cur);
                            uu[bj][e] = bb[bj][e] + w0[bj][e] * p2 + w1[bj][e] * p1 + w2[bj][e] * cur; }
                    u32x2 pk; pk.x = cvt_pk_bf16(siluf(uu[0][0]) * uu[1][0], siluf(uu[0][1]) * uu[1][1]); pk.y = cvt_pk_bf16(siluf(uu[0][2]) * uu[1][2], siluf(uu[0][3]) * uu[1][3]);
                    if (n == 0) pk0[ai][m] = pk;
                    else { const int t = pm * 256 + ai * 128 + wr * 64 + m * 16 + fr; u32x4 w; w.x = pk0[ai][m].x; w.y = pk0[ai][m].y; w.z = pk.x; w.w = pk.y;
                        *(u32x4*)(act + (size_t)t * DFF + pn * 128 + c0) = w; }
                }
        }
#pragma unroll
        for (int ai = 0; ai < 2; ++ai) {
            const int gq = pm * 4 + ai * 2 + wr;
            if (fr >= 14) {
#pragma unroll
                for (int bj = 0; bj < 2; ++bj) *(u32x4*)(fh + ((size_t)gq * 4 + (fr - 14)) * (2 * DFF) + pn * 256 + bj * 128 + c0) = pack8(acc[ai][bj][3][0], acc[ai][bj][3][1]);
            }
            if (fr < 2) {
#pragma unroll
                for (int bj = 0; bj < 2; ++bj) *(u32x4*)(fh + ((size_t)gq * 4 + 2 + fr) * (2 * DFF) + pn * 256 + bj * 128 + c0) = pack8(acc[ai][bj][0][0], acc[ai][bj][0][1]);
            }
        }
    }
};

template <class E0, class E1, class E2> struct EpiMulti {
    static constexpr bool PERM = true; E0 e0; E1 e1; E2 e2;
    static_assert(E0::PERM && E1::PERM && E2::PERM, "mixed staging orders");
    __device__ __forceinline__ void mid(Acc&, const gm::U&, int, int, int, int) const {}
    __device__ __forceinline__ void operator()(const Acc& acc, const gm::U& u, int wr, int wc, int fr, int fq) const {
        if (u.i3 == 0) e0(acc, u, wr, wc, fr, fq); else if (u.i3 == 1) e1(acc, u, wr, wc, fr, fq); else e2(acc, u, wr, wc, fr, fq);
    }
};

struct SchedS { const char* Q; const char* K; int G, c;
    __device__ __forceinline__ bool next(int i, gm::U& u) const { const int L = i * G + c; if (L >= 128) return false; const int h2 = L & 1, ch = L >> 1;
        const size_t o = ((size_t)h2 * S_ + ch * 256) * 256 * 2; u.a1 = Q + o; u.b1 = K + o; u.a2 = u.a1; u.b2 = u.b1; u.co = 0; u.i0 = ch; u.i1 = h2; u.i2 = 0; u.i3 = 0; return true; } };
struct SchedKV { const char* VT; const char* KWT; int G, c;
    __device__ __forceinline__ bool next(int i, gm::U& u) const { const int L = i * G + c; if (L >= 256) return false; const int mt = L & 1, h2 = (L >> 1) & 1, ch = L >> 2;
        u.a1 = VT + ((size_t)(h2 * 64 + ch) * 512 + mt * 256) * 256 * 2; u.b1 = KWT + ((size_t)(h2 * 64 + ch) * 256) * 256 * 2; u.a2 = u.a1; u.b2 = u.b1;
        u.co = ((long)(h2 * 64 + ch) * 512 + mt * 256) * 256; u.i0 = ch; u.i1 = h2; u.i2 = mt; u.i3 = 0; return true; } };
struct SchedO { const char* Q; const char* KVT; const char* P; const char* VT; int G, c;
    __device__ __forceinline__ bool next(int i, gm::U& u) const { const int L = i * G + c; if (L >= 256) return false; const int nt2 = L & 1, h2 = (L >> 1) & 1, ch = L >> 2;
        u.a1 = Q + ((size_t)h2 * S_ + ch * 256) * 256 * 2; u.b1 = KVT + ((size_t)(h2 * 64 + ch) * 512 + nt2 * 256) * 256 * 2;
        u.a2 = P + ((size_t)(h2 * 64 + ch) * 65536) * 2; u.b2 = VT + ((size_t)(h2 * 64 + ch) * 512 + nt2 * 256) * 256 * 2;
        u.co = 0; u.i0 = ch; u.i1 = h2; u.i2 = nt2; u.i3 = 0; return true; } };

struct Frame { LAS unsigned char* lds; int G, bid, tid, wid, lane; };
__device__ __forceinline__ Frame fresh(const Frame& f) { Frame r = f; asm volatile("" : "+v"(r.tid)); r.lane = r.tid & 63; r.wid = __builtin_amdgcn_readfirstlane(r.tid >> 6); return r; }

struct TileD { const float* src; bf16_t* dst; int lds_, ldd; };
struct MixerTiles { const float* win; const float* wout; bf16_t* WIN; bf16_t* WOUT; int ldin;
    __device__ __forceinline__ TileD operator()(int u) const {
        if (u < 1536) { const int kt = u & 15, ct = u >> 4; return TileD{win + (size_t)kt * 64 * ldin + ct * 64, WIN + (size_t)ct * 64 * 1024 + kt * 64, ldin, 1024}; }
        const int v = u - 1536, kt = v & 31, ct = v >> 5; return TileD{wout + (size_t)kt * 64 * 1024 + ct * 64, WOUT + (size_t)ct * 64 * 2048 + kt * 64, 1024, 2048}; } };
struct FfnTiles { const float* wup; const float* wdn; bf16_t* WUP; bf16_t* WDN;
    __device__ __forceinline__ TileD operator()(int u) const {
        if (u < 1408) { const int kt = u & 15, ct = u >> 4, c0 = ct * 64;
            const int cc = c0 < DFF ? c0 : c0 - DFF; const int r0 = (cc >> 7) * 256 + (c0 < DFF ? 0 : 128) + (cc & 127);
            return TileD{wup + (size_t)kt * 64 * 5632 + c0, WUP + (size_t)r0 * 1024 + kt * 64, 5632, 1024}; }
        const int v = u - 1408, kt = v % 44, ct = v / 44; return TileD{wdn + (size_t)kt * 64 * 1024 + ct * 64, WDN + (size_t)ct * 64 * DFF + kt * 64, 1024, DFF}; } };
template <class TD> __device__ __forceinline__ void convert_tiles(const Frame& F, int ntiles, const TD& td) {
    LAS float* tile = (LAS float*)F.lds;
    const int tx = F.tid & 63, ty = F.tid >> 6, n = F.tid >> 3, kk = (F.tid & 7) * 8;
    for (int u0 = F.bid; u0 < ntiles; u0 += 4 * F.G) {
        float v[4][8];
#pragma unroll
        for (int j = 0; j < 4; ++j) { const int u = u0 + j * F.G; if (u < ntiles) { const TileD d = td(u);
#pragma unroll
                for (int i = 0; i < 8; ++i) v[j][i] = d.src[(size_t)(ty + 8 * i) * d.lds_ + tx]; } }
#pragma unroll
        for (int j = 0; j < 4; ++j) { if (u0 + j * F.G < ntiles) {
#pragma unroll
                for (int i = 0; i < 8; ++i) tile[j * 4160 + (ty + 8 * i) * 65 + tx] = v[j][i]; } }
        __syncthreads();
#pragma unroll
        for (int j = 0; j < 4; ++j) { const int u = u0 + j * F.G; if (u < ntiles) { const TileD d = td(u); const LAS float* t = tile + j * 4160;
                u32x4 w; w.x = cvt_pk_bf16(t[(kk + 0) * 65 + n], t[(kk + 1) * 65 + n]); w.y = cvt_pk_bf16(t[(kk + 2) * 65 + n], t[(kk + 3) * 65 + n]);
                w.z = cvt_pk_bf16(t[(kk + 4) * 65 + n], t[(kk + 5) * 65 + n]); w.w = cvt_pk_bf16(t[(kk + 6) * 65 + n], t[(kk + 7) * 65 + n]);
                *(u32x4*)(d.dst + (size_t)n * d.ldd + kk) = w; } }
        __syncthreads();
    }
}
struct MixerTilesHi { MixerTiles t; __device__ __forceinline__ TileD operator()(int u) const { return t(u + 1408); } };
__device__ __forceinline__ void convert_mixer_weights(const Frame& F, const Params& p, int layer, int part = 2) {
    const MixerTiles td{layer == 0 ? p.ret_w_in : p.ml_w_in, layer == 0 ? p.ret_w_out : p.ml_w_out, (bf16_t*)(p.ws + OFF_WIN), (bf16_t*)(p.ws + OFF_WOUT), layer == 0 ? 6144 : 6152};
    if (part == 2) convert_tiles(F, 2048, td); else if (part == 0) convert_tiles(F, 1408, td); else { const MixerTilesHi th{td}; convert_tiles(F, 640, th); }
}
struct FfnTilesDn { FfnTiles t; __device__ __forceinline__ TileD operator()(int u) const { return t(u + 1408); } };
__device__ __forceinline__ void convert_ffn_weights(const Frame& F, const Params& p, int layer, int part) {
    const FfnTiles td{p.up_w + (size_t)layer * 1024 * 5632, p.dn_w + (size_t)layer * 2816 * 1024, (bf16_t*)(p.ws + OFF_WUP), (bf16_t*)(p.ws + OFF_WDN)};
    if (part == 0) convert_tiles(F, 1408, td); else { const FfnTilesDn tdn{td}; convert_tiles(F, 704, tdn); }
}

__device__ __forceinline__ void prologue_phase(const Frame& F, const Params& p) {
    float* MOD = (float*)(p.ws + OFF_SM + SM_MOD);
    LAS float* red = (LAS float*)F.lds;
    for (int u = F.bid; u < 192; u += F.G) {
        const int l = u / 96, cgp = u % 96, cq = F.tid & 15, kg = F.tid >> 4;
        const float* w = p.ada_w + (size_t)l * 1024 * 6144 + cgp * 64 + cq * 4;
        f32x4 a = {0.f, 0.f, 0.f, 0.f};
#pragma unroll 8
        for (int k = kg * 32; k < kg * 32 + 32; ++k) { const float cv = p.c[k]; const float ca = siluf(cv); a += ca * *(const f32x4*)(w + (size_t)k * 6144); }
        __syncthreads();
#pragma unroll
        for (int e = 0; e < 4; ++e) red[kg * 64 + cq * 4 + e] = a[e];
        __syncthreads();
        if (F.tid < 64) { float s = 0.f; for (int k = 0; k < 32; ++k) s += red[k * 64 + F.tid]; MOD[l * 6144 + cgp * 64 + F.tid] = s + p.ada_b[l * 6144 + cgp * 64 + F.tid]; }
    }
    const int gt = F.bid * 512 + F.tid, gn = F.G * 512;
    if (gt < 128) ((float*)(p.ws + OFF_SM + SM_IFQ))[gt] = powf(10000.0f, -(float)(2 * gt) / 256.0f);
    float* RB = (float*)(p.ws + OFF_SM + SM_RB); float* CB = (float*)(p.ws + OFF_SM + SM_CB); float* XS = (float*)(p.ws + OFF_SM + SM_XS); float* WK = (float*)(p.ws + OFF_SM + SM_WK);
    for (int e = gt; e < 4 * S_; e += gn) { const int h = e >> 14, t = e & (S_ - 1), i = t & 255; const float lg = logf(1.0f - exp2f(-5.0f - (float)h));
        RB[e] = (float)i * lg; CB[e] = -(float)i * lg; XS[e] = expf((float)(i + 1) * lg); WK[e] = expf((float)(255 - i) * lg); }
    if (gt < 256) { const int h = gt >> 6; const float lg = logf(1.0f - exp2f(-5.0f - (float)h)); ((float*)(p.ws + OFF_SM + SM_SCP))[gt] = expf(256.0f * lg); ((float*)(p.ws + OFF_SM + SM_SCN))[gt] = 1.0f; }
}

template <bool GATES> __device__ __forceinline__ void norm_phase(const Frame& F, const Params& p, const float* xin, const float* g, const float* sh, const float* sc) {
    bf16_t* H = (bf16_t*)(p.ws + OFF_H);
    LAS float* wg = (LAS float*)F.lds;
    if (GATES) { __syncthreads(); for (int e = F.tid; e < 8192; e += 512) wg[e] = p.ml_w_in[(size_t)(e >> 3) * 6152 + 6144 + (e & 7)]; __syncthreads(); }
    float* LI = (float*)(p.ws + OFF_SM + SM_LI); float* LF = (float*)(p.ws + OFF_SM + SM_LF);
    f32x4 gv[4], scv[4], shv[4];
#pragma unroll
    for (int j = 0; j < 4; ++j) { const int c = F.lane * 4 + 256 * j; gv[j] = *(const f32x4*)(g + c); scv[j] = *(const f32x4*)(sc + c); shv[j] = *(const f32x4*)(sh + c); }
    for (int row0 = (F.bid * 8 + F.wid) * 4; row0 < S_; row0 += F.G * 8 * 4) {
        f32x4 xa[4][4];
#pragma unroll
        for (int rr = 0; rr < 4; ++rr)
#pragma unroll
            for (int j = 0; j < 4; ++j) xa[rr][j] = *(const f32x4*)(xin + (size_t)(row0 + rr) * 1024 + F.lane * 4 + 256 * j);
#pragma unroll
        for (int rr = 0; rr < 4; ++rr) {
        const int row = row0 + rr; f32x4 xv[4]; float ss = 0.f;
#pragma unroll
        for (int j = 0; j < 4; ++j) { xv[j] = xa[rr][j]; ss += xv[j][0] * xv[j][0] + xv[j][1] * xv[j][1] + xv[j][2] * xv[j][2] + xv[j][3] * xv[j][3]; }
        ss = wave_sum(ss); const float rstd = rsqrtf(ss * (1.0f / 1024.0f) + EPS);
        float gp[8];
        if (GATES) {
#pragma unroll
            for (int k = 0; k < 8; ++k) gp[k] = 0.f; }
#pragma unroll
        for (int j = 0; j < 4; ++j) { f32x4 hv;
#pragma unroll
            for (int e = 0; e < 4; ++e) hv[e] = xv[j][e] * rstd * gv[j][e] * (1.0f + scv[j][e]) + shv[j][e];
            u32x2 w; w.x = cvt_pk_bf16(hv[0], hv[1]); w.y = cvt_pk_bf16(hv[2], hv[3]);
            *(u32x2*)(H + (size_t)row * 1024 + F.lane * 4 + 256 * j) = w;
            if (GATES) {
#pragma unroll
                for (int e = 0; e < 4; ++e) { const LAS float* wr_ = wg + (F.lane * 4 + 256 * j + e) * 8;
#pragma unroll
                    for (int k = 0; k < 8; ++k) gp[k] += hv[e] * wr_[k]; } } }
        if (GATES) {
#pragma unroll
            for (int k = 0; k < 8; ++k) gp[k] = wave_sum(gp[k]);
            if (F.lane == 0) {
#pragma unroll
                for (int k = 0; k < 4; ++k) { LI[(size_t)row * 4 + k] = gp[k] + p.ml_bg[k]; const float v = gp[4 + k] + p.ml_bg[4 + k]; LF[(size_t)row * 4 + k] = fminf(v, 0.f) - log1pf(expf(-fabsf(v))); } } }
        }
    }
}

__device__ __forceinline__ void prep_a(const Frame& F, const Params& p) {
    const float* LI = (const float*)(p.ws + OFF_SM + SM_LI); const float* LF = (const float*)(p.ws + OFF_SM + SM_LF);
    float* GG = (float*)(p.ws + OFF_SM + SM_GG); float* CB = (float*)(p.ws + OFF_SM + SM_CB); float* PM = (float*)(p.ws + OFF_SM + SM_PM); float* WK = (float*)(p.ws + OFF_SM + SM_WK);
    float* GL = (float*)(p.ws + OFF_SM + SM_GL); float* ML = (float*)(p.ws + OFF_SM + SM_ML);
    for (int u = F.bid; u < 256 && F.wid == 0; u += F.G) {
        const int h = u >> 6, ch = u & 63, t0 = ch * 256 + F.lane * 4;
        float g[4], cb[4], pm[4]; float run = 0.f;
#pragma unroll
        for (int e = 0; e < 4; ++e) { run += LF[(size_t)(t0 + e) * 4 + h]; g[e] = run; }
        float incl = run;
        for (int o = 1; o < 64; o <<= 1) { const float v = __shfl_up(incl, o); if (F.lane >= o) incl += v; }
        const float excl = incl - run;
        float lm = -INFINITY;
#pragma unroll
        for (int e = 0; e < 4; ++e) { g[e] += excl; cb[e] = LI[(size_t)(t0 + e) * 4 + h] - g[e]; lm = fmaxf(lm, cb[e]); pm[e] = lm; }
        float im = lm;
        for (int o = 1; o < 64; o <<= 1) { const float v = __shfl_up(im, o); if (F.lane >= o) im = fmaxf(im, v); }
        float em = __shfl_up(im, 1); if (F.lane == 0) em = -INFINITY;
#pragma unroll
        for (int e = 0; e < 4; ++e) pm[e] = fmaxf(pm[e], em);
        const float gL = __shfl(g[3], 63), pml = __shfl(pm[3], 63);
#pragma unroll
        for (int e = 0; e < 4; ++e) { const size_t o = (size_t)h * S_ + t0 + e; GG[o] = g[e]; CB[o] = cb[e]; PM[o] = pm[e]; WK[o] = expf(cb[e] - pml); }
        if (F.lane == 0) { GL[u] = gL; ML[u] = gL + pml; }
    }
}
__device__ __forceinline__ void prep_b(const Frame& F, const Params& p) {
    const float* GG = (const float*)(p.ws + OFF_SM + SM_GG); const float* PM = (const float*)(p.ws + OFF_SM + SM_PM);
    const float* GL = (const float*)(p.ws + OFF_SM + SM_GL); const float* ML = (const float*)(p.ws + OFF_SM + SM_ML);
    float* RB = (float*)(p.ws + OFF_SM + SM_RB); float* XS = (float*)(p.ws + OFF_SM + SM_XS); float* EM = (float*)(p.ws + OFF_SM + SM_EM);
    float* SCP = (float*)(p.ws + OFF_SM + SM_SCP); float* SCN = (float*)(p.ws + OFF_SM + SM_SCN);
    for (int u = F.bid; u < 256 && F.wid == 0; u += F.G) {
        const int h = u >> 6, ch = u & 63;
        const float glv = GL[h * 64 + F.lane], mlv = ML[h * 64 + F.lane];
        float m = 0.f;
#pragma unroll 8
        for (int c2 = 0; c2 < 64; ++c2) { const float gl = __shfl(glv, c2), ml = __shfl(mlv, c2); if (c2 < ch) m = fmaxf(gl + m, ml); }
#pragma unroll
        for (int e = 0; e < 4; ++e) { const size_t o = (size_t)h * S_ + ch * 256 + F.lane * 4 + e; const float mx = fmaxf(m, PM[o]); RB[o] = -mx; XS[o] = expf(m - mx); EM[o] = expf(-(GG[o] + mx)); }
        if (F.lane == 0) { const float mn = fmaxf(GL[u] + m, ML[u]); SCP[u] = expf(GL[u] + m - mn); SCN[u] = expf(ML[u] - mn); }
    }
}

template <int KIND> __device__ __forceinline__ void r3_pass(const Frame& F, const Params& p, int pair) {
    bf16_t* Qb = (bf16_t*)(p.ws + OFF_Q); bf16_t* Kb = (bf16_t*)(p.ws + OFF_K); bf16_t* KWT = (bf16_t*)(p.ws + OFF_KWT);
    const bf16_t* QKH = (const bf16_t*)(p.ws + OFF_SM + SM_QKH); const float* WK = (const float*)(p.ws + OFF_SM + SM_WK); float* NLOC = (float*)(p.ws + OFF_SM + SM_NLOC);
    LAS bf16_t* T = (LAS bf16_t*)F.lds;
    const int tr = F.tid >> 3, tc = (F.tid & 7) * 8;
    for (int u = F.bid; u < 1024; u += F.G) {
        const int ch = u >> 4, pc0 = (u & 15) * 64; const bool isk = pc0 >= 512;
        if (KIND == 0 && !isk) continue;
        const int bc0 = pc0 & 511, h2 = bc0 >> 8, h = 2 * pair + h2;
        bf16_t* buf = (isk ? Kb : Qb) + (size_t)h2 * S_ * 256 + (bc0 & 255) + tc;
        float cw[4][8], cbias[8];
        if (KIND == 1) { const int gc = (isk ? 1024 : 0) + pair * 512 + bc0 + tc;
#pragma unroll
            for (int j = 0; j < 4; ++j) { const f32x4 a = *(const f32x4*)(p.ml_cw + j * 2048 + gc), b = *(const f32x4*)(p.ml_cw + j * 2048 + gc + 4);
#pragma unroll
                for (int e = 0; e < 4; ++e) { cw[j][e] = a[e]; cw[j][4 + e] = b[e]; } }
            const f32x4 a = *(const f32x4*)(p.ml_cb + gc), b = *(const f32x4*)(p.ml_cb + gc + 4);
#pragma unroll
            for (int e = 0; e < 4; ++e) { cbias[e] = a[e]; cbias[4 + e] = b[e]; } }
        float nsum = 0.f;
        u32x4 nx[4]; float wkn = 0.f;
#define R3_LOAD(dst, s_) do { const int t_ = ch * 256 + (s_) * 64 + tr; dst[0] = *(const u32x4*)(buf + (size_t)t_ * 256); \
            if (KIND == 1) { _Pragma("unroll") for (int d = 1; d <= 3; ++d) { const int tt = t_ - d; u32x4 w_ = {0u, 0u, 0u, 0u}; \
                if (tr - d >= 0) w_ = *(const u32x4*)(buf + (size_t)tt * 256); \
                else if (tt >= 0) w_ = *(const u32x4*)(QKH + ((size_t)(tt >> 6) * 3 + ((tt & 63) - 61)) * 1024 + pc0 + tc); \
                dst[d] = w_; } } } while (0)
        R3_LOAD(nx, 0); if (isk) wkn = WK[(size_t)h * S_ + ch * 256 + tr];
        for (int s = 0; s < 4; ++s) {
            const int t = ch * 256 + s * 64 + tr;
            u32x4 cu[4];
#pragma unroll
            for (int d = 0; d < 4; ++d) cu[d] = nx[d];
            const float wk = wkn;
            if (s < 3) { R3_LOAD(nx, s + 1); if (isk) wkn = WK[(size_t)h * S_ + t + 64]; }
            float v[8]; unpack8(cu[0], v);
            if (KIND == 1) {
                float o[8];
#pragma unroll
                for (int e = 0; e < 8; ++e) o[e] = cbias[e] + cw[3][e] * v[e];
#pragma unroll
                for (int d = 1; d <= 3; ++d) { float x[8]; unpack8(cu[d], x);
#pragma unroll
                    for (int e = 0; e < 8; ++e) o[e] += cw[3 - d][e] * x[e]; }
#pragma unroll
                for (int e = 0; e < 8; ++e) { v[e] = siluf(o[e]); if (isk) v[e] *= 0.0625f; }
                __syncthreads();
                u32x4 w; w.x = cvt_pk_bf16(v[0], v[1]); w.y = cvt_pk_bf16(v[2], v[3]); w.z = cvt_pk_bf16(v[4], v[5]); w.w = cvt_pk_bf16(v[6], v[7]);
                *(u32x4*)(buf + (size_t)t * 256) = w;
            }
            if (isk) {
#pragma unroll
                for (int e = 0; e < 8; e += 2) { const unsigned w = cvt_pk_bf16(v[e] * wk, v[e + 1] * wk); T[(tc + e) * 72 + tr] = (bf16_t)(w & 0xffffu); T[(tc + e + 1) * 72 + tr] = (bf16_t)(w >> 16); }
                __syncthreads();
                const int col = F.tid >> 3, seg = F.tid & 7;
                const u32x4 w = *(const LAS u32x4*)(T + col * 72 + seg * 8);
                *(u32x4*)(KWT + ((size_t)(h2 * 64 + ch) * 256 + (bc0 & 255) + col) * 256 + s * 64 + seg * 8) = w;
                float x[8]; unpack8(w, x); nsum += ((x[0] + x[1]) + (x[2] + x[3])) + ((x[4] + x[5]) + (x[6] + x[7]));
                __syncthreads();
            }
        }
#undef R3_LOAD
        if (KIND == 1 && isk) { nsum += __shfl_xor(nsum, 1); nsum += __shfl_xor(nsum, 2); nsum += __shfl_xor(nsum, 4);
            if ((F.tid & 7) == 0) NLOC[((size_t)h * 64 + ch) * 256 + (bc0 & 255) + (F.tid >> 3)] = nsum; }
    }
}

template <int KIND> __device__ __forceinline__ void scan_phase(const Frame& F, const Params& p, int pair) {
    unsigned* KV = (unsigned*)(p.ws + OFF_KVT);
    const float* SCP = (const float*)(p.ws + OFF_SM + SM_SCP); const float* SCN = (const float*)(p.ws + OFF_SM + SM_SCN);
    for (int e0 = F.bid * 512; e0 < 131072; e0 += F.G * 512) {
        const int h2 = e0 >> 16, h = 2 * pair + h2; unsigned* base = KV + (size_t)h2 * 64 * 65536 + (e0 & 65535) + F.tid;
        float s0 = 0.f, s1 = 0.f;
#pragma unroll 1
        for (int cb = 0; cb < 64; cb += 64) {
            unsigned v[64];
#pragma unroll
            for (int c = 0; c < 64; ++c) v[c] = base[(size_t)(cb + c) * 65536];
#pragma unroll
            for (int c = 0; c < 64; ++c) { base[(size_t)(cb + c) * 65536] = cvt_pk_bf16(s0, s1); const float a = SCP[h * 64 + cb + c], b = SCN[h * 64 + cb + c]; s0 = a * s0 + b * bf_lo(v[c]); s1 = a * s1 + b * bf_hi(v[c]); }
        }
    }
    if (KIND == 1) {
        const float* NLOC = (const float*)(p.ws + OFF_SM + SM_NLOC); const bf16_t* Qb = (const bf16_t*)(p.ws + OFF_Q); float* DC = (float*)(p.ws + OFF_SM + SM_DC);
        LAS float* nv = (LAS float*)F.lds;
        for (int u = F.bid; u < 256; u += F.G) {
            const int h2 = u & 1, hv = (u >> 1) & 1, ch = u >> 2, h = 2 * pair + h2;
            __syncthreads();
            if (F.tid < 256) { float n = 0.f;
#pragma unroll 1
                for (int cb = 0; cb < 64; cb += 16) { if (cb >= ch) break; float x[16];
#pragma unroll
                    for (int c = 0; c < 16; ++c) x[c] = (cb + c < ch) ? NLOC[((size_t)h * 64 + cb + c) * 256 + F.tid] : 0.f;
#pragma unroll
                    for (int c = 0; c < 16; ++c) if (cb + c < ch) n = SCP[h * 64 + cb + c] * n + SCN[h * 64 + cb + c] * x[c]; }
                nv[F.tid] = n; }
            __syncthreads();
            const f32x4 nn = *(const LAS f32x4*)(nv + F.lane * 4);
#pragma unroll 1
            for (int r0 = 0; r0 < 16; r0 += 8) { const int t0 = ch * 256 + hv * 128 + F.wid * 16 + r0; u32x2 w[8];
#pragma unroll
                for (int r = 0; r < 8; ++r) w[r] = *(const u32x2*)(Qb + ((size_t)h2 * S_ + t0 + r) * 256 + F.lane * 4);
#pragma unroll
                for (int r = 0; r < 8; ++r) { float d = bf_lo(w[r].x) * nn[0] + bf_hi(w[r].x) * nn[1] + bf_lo(w[r].y) * nn[2] + bf_hi(w[r].y) * nn[3];
                    d = wave_sum(d); if (F.lane == 0) DC[(size_t)(t0 + r) * 4 + h] = d; } }
        }
    }
}

__device__ __forceinline__ void gn_pass(const Frame& F, const Params& p) {
    bf16_t* Z = (bf16_t*)(p.ws + OFF_Z); const float* ST = (const float*)(p.ws + OFF_SM + SM_ST);
    for (int u0 = (F.bid * 8 + F.wid) * 4; u0 < S_ * 4; u0 += F.G * 8 * 4) {
        f32x4 st[4][4]; u32x4 zz[4]; f32x4 g0[4], g1[4];
#pragma unroll
        for (int j = 0; j < 4; ++j) { const int u = u0 + j; const f32x4* sp = (const f32x4*)(ST + (size_t)u * 16);
            st[j][0] = sp[0]; st[j][1] = sp[1]; st[j][2] = sp[2]; st[j][3] = sp[3];
            zz[j] = *(const u32x4*)(Z + (size_t)(u >> 2) * 2048 + (u & 3) * 512 + F.lane * 8);
            g0[j] = *(const f32x4*)(p.ml_gn + (u & 3) * 512 + F.lane * 8); g1[j] = *(const f32x4*)(p.ml_gn + (u & 3) * 512 + F.lane * 8 + 4); }
#pragma unroll
        for (int j = 0; j < 4; ++j) { const int u = u0 + j; const f32x4 a = st[j][0], b = st[j][1], c = st[j][2], d = st[j][3];
            const float s = (a[0] + a[2]) + (b[0] + b[2]) + (c[0] + c[2]) + (d[0] + d[2]), q = (a[1] + a[3]) + (b[1] + b[3]) + (c[1] + c[3]) + (d[1] + d[3]);
            const float mu = s * (1.0f / 512.0f), rstd = rsqrtf(fmaxf(q * (1.0f / 512.0f) - mu * mu, 0.f) + EPS);
            float y[8]; unpack8(zz[j], y); f32x4 o0, o1;
#pragma unroll
            for (int e = 0; e < 4; ++e) { o0[e] = (y[e] - mu) * rstd * g0[j][e]; o1[e] = (y[4 + e] - mu) * rstd * g1[j][e]; }
            *(u32x4*)(Z + (size_t)(u >> 2) * 2048 + (u & 3) * 512 + F.lane * 8) = pack8(o0, o1); }
    }
}

__device__ __forceinline__ void ffn_fix_panel(const Frame& F, const Params& p, int layer, int pm) {
    const bf16_t* FH = (const bf16_t*)(p.ws + OFF_FH); bf16_t* ACT = (bf16_t*)(p.ws + OFF_ACT);
    const float* cw = p.fcw + (size_t)layer * 3 * 5632; const float* cb = p.fcb + (size_t)layer * 5632;
    if (F.tid < 352) {
        const int chn = F.tid * 8, pn = chn >> 7, cc = chn & 127;
        f32x4 bq[2][2], a0[2][2], a1[2][2], a2[2][2];
#pragma unroll
        for (int bj = 0; bj < 2; ++bj)
#pragma unroll
            for (int v = 0; v < 2; ++v) { const int wch = bj * DFF + chn + 4 * v;
                bq[bj][v] = *(const f32x4*)(cb + wch); a0[bj][v] = *(const f32x4*)(cw + wch); a1[bj][v] = *(const f32x4*)(cw + 5632 + wch); a2[bj][v] = *(const f32x4*)(cw + 2 * 5632 + wch); }
#pragma unroll 1
        for (int gb = 0; gb < 2; ++gb) {
            u32x4 h[2][2][4];
#pragma unroll
            for (int gi = 0; gi < 2; ++gi) { const int gq = pm * 4 + gb * 2 + gi;
#pragma unroll
                for (int bj = 0; bj < 2; ++bj) { const int col = pn * 256 + bj * 128 + cc; const u32x4 z = {0u, 0u, 0u, 0u};
                    h[gi][bj][0] = gq > 0 ? *(const u32x4*)(FH + ((size_t)(gq - 1) * 4 + 0) * 5632 + col) : z;
                    h[gi][bj][1] = gq > 0 ? *(const u32x4*)(FH + ((size_t)(gq - 1) * 4 + 1) * 5632 + col) : z;
                    h[gi][bj][2] = *(const u32x4*)(FH + ((size_t)gq * 4 + 2) * 5632 + col);
                    h[gi][bj][3] = *(const u32x4*)(FH + ((size_t)gq * 4 + 3) * 5632 + col); } }
#pragma unroll
            for (int gi = 0; gi < 2; ++gi) { const int gq = pm * 4 + gb * 2 + gi;
#pragma unroll
                for (int r = 0; r < 2; ++r) {
                    float ua[8], ub[8];
#pragma unroll
                    for (int bj = 0; bj < 2; ++bj) { float* uo = bj ? ub : ua; float x0[8], x1[8], x2[8];
                        unpack8(h[gi][bj][r], x0); unpack8(h[gi][bj][r + 1], x1); unpack8(h[gi][bj][r + 2], x2);
#pragma unroll
                        for (int v = 0; v < 2; ++v)
#pragma unroll
                            for (int e = 0; e < 4; ++e) uo[4 * v + e] = bq[bj][v][e] + a0[bj][v][e] * x0[4 * v + e] + a1[bj][v][e] * x1[4 * v + e] + a2[bj][v][e] * x2[4 * v + e]; }
                    f32x4 o0, o1;
#pragma unroll
                    for (int e = 0; e < 4; ++e) { o0[e] = siluf(ua[e]) * ub[e]; o1[e] = siluf(ua[4 + e]) * ub[4 + e]; }
                    *(u32x4*)(ACT + (size_t)(gq * 64 + r) * DFF + chn) = pack8(o0, o1); } }
        }
    }
}

__device__ __forceinline__ void final_norm(const Frame& F, const Params& p) {
    f32x4 g[4];
#pragma unroll
    for (int j = 0; j < 4; ++j) g[j] = *(const f32x4*)(p.fin_g + F.lane * 4 + 256 * j);
    for (int row0 = (F.bid * 8 + F.wid) * 8; row0 < S_; row0 += F.G * 8 * 8) {
        f32x4 xa[8][4];
#pragma unroll
        for (int rr = 0; rr < 8; ++rr)
#pragma unroll
            for (int j = 0; j < 4; ++j) xa[rr][j] = *(const f32x4*)(p.out + (size_t)(row0 + rr) * 1024 + F.lane * 4 + 256 * j);
#pragma unroll
        for (int rr = 0; rr < 8; ++rr) { float ss = 0.f;
#pragma unroll
            for (int j = 0; j < 4; ++j) ss += xa[rr][j][0] * xa[rr][j][0] + xa[rr][j][1] * xa[rr][j][1] + xa[rr][j][2] * xa[rr][j][2] + xa[rr][j][3] * xa[rr][j][3];
            ss = wave_sum(ss); const float rstd = rsqrtf(ss * (1.0f / 1024.0f) + EPS);
#pragma unroll
            for (int j = 0; j < 4; ++j) *(f32x4*)(p.out + (size_t)(row0 + rr) * 1024 + F.lane * 4 + 256 * j) = xa[rr][j] * rstd * g[j]; }
    }
}

#define XB_TMO      128
#define XB_XCNT(j)  (256  + 64 * (j))
#define XB_XSUB(j)  (1280 + 64 * (j))
#define XB_XGEN(j)  (2304 + 64 * (j))
#define XB_TOP      3328
#define XB_TOPGEN   3392
#define XCD_BAR_WORDS 3456
#define XB_SPIN_CAP (1u << 18)
__device__ __forceinline__ unsigned xb_ld(unsigned* p)              { return __hip_atomic_load(p, __ATOMIC_RELAXED, __HIP_MEMORY_SCOPE_AGENT); }
__device__ __forceinline__ unsigned xb_add(unsigned* p, unsigned v) { return __hip_atomic_fetch_add(p, v, __ATOMIC_RELAXED, __HIP_MEMORY_SCOPE_AGENT); }
__device__ __forceinline__ unsigned xb_xcc_id() { return (unsigned)__builtin_amdgcn_s_getreg((3 << 11) | 20) & 0xFu; }
#define XB_SPIN(cond, bar) do { unsigned _sp = 0; while (cond) { __builtin_amdgcn_s_sleep(1); \
    if ((++_sp & 255u) == 0u) { if (xb_ld(&(bar)[XB_TMO])) break; if (_sp > XB_SPIN_CAP) { atomicAdd(&(bar)[XB_TMO], 1u); break; } } } } while (0)
struct XcdBarrier { unsigned* bar; unsigned x; volatile LAS unsigned* st; };
__device__ __forceinline__ XcdBarrier xcd_barrier_post(unsigned* bar, volatile LAS unsigned* st) {
    XcdBarrier b; b.bar = bar; b.x = xb_xcc_id(); b.st = st;
    if (threadIdx.x == 0) (void)xb_add(&bar[XB_XCNT(b.x)], 1u);
    return b;
}
__device__ __forceinline__ void xcd_barrier_complete(unsigned* bar, unsigned x, unsigned& nloc, unsigned& nx) {
    const unsigned G = gridDim.x * gridDim.y * gridDim.z;
    unsigned sum, cnt, mine, sp = 0u;
    for (;;) {
        sum = 0u; cnt = 0u; mine = 0u;
#pragma unroll
        for (unsigned j = 0; j < 16; ++j) { const unsigned c = xb_ld(&bar[XB_XCNT(j)]); sum += c; cnt += (c > 0u) ? 1u : 0u; mine = (j == x) ? c : mine; }
        if (sum == G) break;
        __builtin_amdgcn_s_sleep(1);
        if ((++sp & 255u) == 0u) { if (xb_ld(&bar[XB_TMO])) break; if (sp > XB_SPIN_CAP) { atomicAdd(&bar[XB_TMO], 1u); break; } }
    }
    nloc = mine > 0u ? mine : 1u; nx = cnt > 0u ? cnt : 1u;
}
__device__ __forceinline__ void xcd_barrier(const XcdBarrier& b) {
    asm volatile("s_waitcnt vmcnt(0)" ::: "memory");
    __syncthreads();
    if (threadIdx.x == 0) {
        unsigned* bar = b.bar;
        __builtin_amdgcn_s_waitcnt(0);
        unsigned nloc = b.st[0], nx = b.st[1];
        if (nloc == 0u) { xcd_barrier_complete(bar, b.x, nloc, nx); b.st[0] = nloc; b.st[1] = nx; }
        const unsigned old = xb_add(&bar[XB_XSUB(b.x)], 1u);
        const unsigned gen = old / nloc;
        if (old + 1u == (gen + 1u) * nloc) {
            __builtin_amdgcn_fence(__ATOMIC_RELEASE, "agent");
            asm volatile("s_waitcnt vmcnt(0)" ::: "memory");
            const unsigned og = xb_add(&bar[XB_TOP], 1u);
            const unsigned tg = og / nx;
            if (og + 1u == (tg + 1u) * nx) xb_add(&bar[XB_TOPGEN], 1u);
            else XB_SPIN(xb_ld(&bar[XB_TOPGEN]) == tg, bar);
            __builtin_amdgcn_fence(__ATOMIC_ACQUIRE, "agent");
            asm volatile("s_waitcnt vmcnt(0)" ::: "memory");
        } else {
            XB_SPIN(xb_ld(&bar[XB_TOPGEN]) == gen, bar);
            __builtin_amdgcn_fence(__ATOMIC_ACQUIRE, "agent");
            asm volatile("s_waitcnt vmcnt(0)" ::: "memory");
        }
    }
    __syncthreads();
}

constexpr int N_PHASES = 33;
#ifdef ONLY_PH
#define PH_ON(k) ((k) == ONLY_PH)
#else
#define PH_ON(k) (p.ph_lo <= (k) && (k) < p.ph_hi)
#endif
#ifndef PROBE_CAT
#define PROBE_CAT 0
#endif
#if PROBE_CAT
#define RT() __builtin_amdgcn_s_memrealtime()
#define PH_END(k) do { if ((k) + 1 < p.ph_hi) { __syncthreads(); const unsigned long long t0_ = RT(); xcd_barrier(xbar); if (PROBE_CAT == 2) tprobe += RT() - t0_; } } while (0)
#define GT0 const unsigned long long tg0_ = RT();
#define GT1(c) if (PROBE_CAT == 1 || PROBE_CAT == (c)) tprobe += RT() - tg0_;
#else
#define PH_END(k) do { if ((k) + 1 < p.ph_hi) xcd_barrier(xbar); } while (0)
#define GT0
#define GT1(c)
#endif

typedef gm::SchedPlain SP;
template <int KIND> __device__ __forceinline__ SP sched_qk(const Frame& F, const Params& p, int pair) {
    const char* H = (const char*)(p.ws + OFF_H); const char* WIN = (const char*)(p.ws + OFF_WIN);
    return SP{H, WIN + (size_t)(pair * 512) * 2048, WIN + (size_t)(1024 + pair * 512) * 2048, 64, 4, 2, F.G, F.bid, (size_t)256 * 2048, (size_t)256 * 2048, 256, 0}; }
__device__ __forceinline__ SP sched_vt(const Frame& F, const Params& p, int pair) {
    const char* H = (const char*)(p.ws + OFF_H); const char* WIN = (const char*)(p.ws + OFF_WIN);
    return SP{WIN + (size_t)(2048 + pair * 1024) * 2048, H, H, 4, 64, 64, F.G, F.bid, (size_t)256 * 2048, (size_t)256 * 2048, 256, 1}; }
__device__ __forceinline__ SP sched_g(const Frame& F, const Params& p, int pair) {
    const char* H = (const char*)(p.ws + OFF_H); const char* WIN = (const char*)(p.ws + OFF_WIN);
    return SP{H, WIN + (size_t)(4096 + pair * 1024) * 2048, WIN, 64, 4, 4, F.G, F.bid, (size_t)256 * 2048, (size_t)256 * 2048, 2048, 0}; }
template <int KIND> __device__ __forceinline__ EpiQK<KIND> epi_qk(const Params& p, int pair) {
    return EpiQK<KIND>{(bf16_t*)(p.ws + OFF_Q), (bf16_t*)(p.ws + OFF_K), p.pos, (const float*)(p.ws + OFF_SM + SM_IFQ), (bf16_t*)(p.ws + OFF_SM + SM_QKH), (bf16_t*)(p.ws + OFF_KWT), (const float*)(p.ws + OFF_SM + SM_WK), pair}; }
template <int KIND> __device__ __forceinline__ EpiG<KIND> epi_g(const Params& p, int pair) {
    return EpiG<KIND>{(bf16_t*)(p.ws + OFF_Z), (float*)(p.ws + OFF_SM + SM_ST), KIND == 0 ? p.ret_gn : p.ml_gn, (const float*)(p.ws + OFF_SM + SM_PS), (const float*)(p.ws + OFF_SM + SM_XS),
                      (const float*)(p.ws + OFF_SM + SM_DC), (const float*)(p.ws + OFF_SM + SM_EM), pair}; }

template <int KIND, int PAIR> __device__ __forceinline__ void pair_core(const Frame& F0, const Params& p, const XcdBarrier& xbar, int base, unsigned long long& tprobe) {
    unsigned char* ws = p.ws; constexpr int pair = PAIR; constexpr int R = (KIND == 1) ? 1 : 0;
    if (KIND == 1) { if (PH_ON(base + 0)) { const Frame F = fresh(F0);
        if (pair == 0) prep_b(F, p);
        { GT0 r3_pass<KIND>(F, p, pair); GT1(9) }
        PH_END(base + 0); } }
    if (PH_ON(base + R)) { const Frame F = fresh(F0);
        { SchedKV S{(const char*)(ws + OFF_VT), (const char*)(ws + OFF_KWT), F.G, F.bid}; EpiPlain E{(bf16_t*)(ws + OFF_KVT), 256};
          { GT0 gm::gemm_phase<EpiPlain, SchedKV, false>(F.lds, gm::GP{256, 256, 4, 4}, S, E); GT1(5) } }
        { SchedS S{(const char*)(ws + OFF_Q), (const char*)(ws + OFF_K), F.G, (F.bid + 128) % F.G};
          EpiS<KIND == 1> E{(bf16_t*)(ws + OFF_P), (const float*)(ws + OFF_SM + SM_RB), (const float*)(ws + OFF_SM + SM_CB), (float*)(ws + OFF_SM + SM_PS), pair};
          { GT0 gm::gemm_phase<EpiS<KIND == 1>, SchedS, false>(F.lds, gm::GP{256, 256, 4, 4}, S, E); GT1(5) } }
        PH_END(base + R); }
    if (PH_ON(base + R + 1)) { const Frame F = fresh(F0); { GT0 scan_phase<KIND>(F, p, pair); GT1(10) } PH_END(base + R + 1); }
    if (PH_ON(base + R + 2)) { const Frame F = fresh(F0);
        SchedO S{(const char*)(ws + OFF_Q), (const char*)(ws + OFF_KVT), (const char*)(ws + OFF_P), (const char*)(ws + OFF_VT), F.G, F.bid};
        EpiO<KIND == 0> E{(bf16_t*)(ws + OFF_Z), (const float*)(ws + OFF_SM + SM_XS), (float*)(ws + OFF_SM + SM_ST), pair};
        { GT0 gm::gemm_phase<EpiO<KIND == 0>, SchedO, true>(F.lds, gm::GP{256, 256, 4, 8}, S, E); GT1(5) }
        PH_END(base + R + 2); }
}

template <int KIND> __device__ __forceinline__ void layer_program(const Frame& F0, const Params& p, const XcdBarrier& xbar, int base, unsigned long long& tprobe) {
    constexpr int layer = KIND;
    unsigned char* ws = p.ws; const float* MOD = (const float*)(ws + OFF_SM + SM_MOD) + layer * 6144;
    const char* H = (const char*)(ws + OFF_H);
    if (PH_ON(base)) { const Frame F = fresh(F0);
        { GT0 convert_mixer_weights(F, p, layer, layer == 0 ? 2 : 1); GT1(7) }
        { GT0 norm_phase<KIND == 1>(F, p, layer == 0 ? p.x : p.out, p.ntg + layer * 1024, MOD, MOD + 1024); GT1(8) }
        PH_END(base); }
    if (PH_ON(base + 1)) { const Frame F = fresh(F0);
        gm::SchedMulti S{sched_qk<KIND>(F, p, 0), sched_vt(F, p, 0), sched_vt(F, p, 0), 256, 256, 0, F.G, F.bid};
        EpiMulti<EpiQK<KIND>, EpiPlain, EpiPlain> E{epi_qk<KIND>(p, 0), EpiPlain{(bf16_t*)(ws + OFF_VT), 256}, EpiPlain{(bf16_t*)(ws + OFF_VT), 256}};
        { GT0 gm::gemm_phase<EpiMulti<EpiQK<KIND>, EpiPlain, EpiPlain>, gm::SchedMulti, false>(F.lds, gm::GP{1024, 1024, 16, 16}, S, E); GT1(4) }
        if (KIND == 1) prep_a(F, p);
        PH_END(base + 1); }
    constexpr int PC = (KIND == 1) ? 4 : 3;
    pair_core<KIND, 0>(F0, p, xbar, base + 2, tprobe);
    if (PH_ON(base + 2 + PC)) { const Frame F = fresh(F0);
        gm::SchedMulti S{sched_g(F, p, 0), sched_qk<KIND>(F, p, 1), sched_vt(F, p, 1), 256, 256, 256, F.G, F.bid};
        EpiMulti<EpiG<KIND>, EpiQK<KIND>, EpiPlain> E{epi_g<KIND>(p, 0), epi_qk<KIND>(p, 1), EpiPlain{(bf16_t*)(ws + OFF_VT), 256}};
        { GT0 gm::gemm_phase<EpiMulti<EpiG<KIND>, EpiQK<KIND>, EpiPlain>, gm::SchedMulti, false>(F.lds, gm::GP{1024, 1024, 16, 16}, S, E); GT1(4) }
        PH_END(base + 2 + PC); }
    pair_core<KIND, 1>(F0, p, xbar, base + 3 + PC, tprobe);
    if (PH_ON(base + 3 + 2 * PC)) { const Frame F = fresh(F0);
        SP S = sched_g(F, p, 1); EpiG<KIND> E = epi_g<KIND>(p, 1);
        { GT0 gm::gemm_phase<EpiG<KIND>, SP, false>(F.lds, gm::GP{1024, 1024, 16, 16}, S, E); GT1(4) }
        PH_END(base + 3 + 2 * PC); }
    int k = base + 4 + 2 * PC;
    if (KIND == 1) { if (PH_ON(k)) { const Frame F = fresh(F0); { GT0 gn_pass(F, p); GT1(11) } PH_END(k); } ++k; }
    if (PH_ON(k)) { const Frame F = fresh(F0);
        SP S{(const char*)(ws + OFF_Z), (const char*)(ws + OFF_WOUT), (const char*)(ws + OFF_WOUT), 64, 4, 4, F.G, F.bid, (size_t)256 * 4096, (size_t)256 * 4096, 1024, 0};
        EpiRes E{layer == 0 ? p.x : p.out, p.out, MOD + 2048};
        { GT0 gm::gemm_phase<EpiRes, SP, false>(F.lds, gm::GP{2048, 2048, 32, 32}, S, E); GT1(6) }
        { GT0 convert_ffn_weights(F, p, layer, 0); GT1(7) }
        PH_END(k); }
    ++k;
    if (PH_ON(k)) { const Frame F = fresh(F0); { GT0 convert_ffn_weights(F, p, layer, 1); GT1(7) } { GT0 norm_phase<false>(F, p, p.out, p.nfg + layer * 1024, MOD + 3072, MOD + 4096); GT1(8) } PH_END(k); }
    ++k;
    if (PH_ON(k)) { const Frame F = fresh(F0);
        SP S{H, (const char*)(ws + OFF_WUP), (const char*)(ws + OFF_WUP), 64, 22, 22, F.G, F.bid, (size_t)256 * 2048, (size_t)256 * 2048, DFF, 0};
        EpiUp E{(bf16_t*)(ws + OFF_ACT), (bf16_t*)(ws + OFF_FH), p.fcw + (size_t)layer * 3 * 5632, p.fcb + (size_t)layer * 5632};
        { GT0 gm::gemm_phase<EpiUp, SP, false>(F.lds, gm::GP{1024, 1024, 16, 16}, S, E); GT1(3) }
        PH_END(k); }
    ++k;
    if (PH_ON(k)) { const Frame F = fresh(F0);
        SP S{(const char*)(ws + OFF_ACT), (const char*)(ws + OFF_WDN), (const char*)(ws + OFF_WDN), 64, 4, 4, F.G, F.bid, (size_t)256 * DFF * 2, (size_t)256 * DFF * 2, 1024, 0};
        { GT0 gm::U u; for (int i = 0; S.next(i, u); ++i) ffn_fix_panel(F, p, layer, u.i0);
          asm volatile("s_waitcnt vmcnt(0)" ::: "memory"); __syncthreads(); GT1(11) }
        EpiRes E{p.out, p.out, MOD + 5120};
        { GT0 gm::gemm_phase<EpiRes, SP, false>(F.lds, gm::GP{DFF, DFF, 44, 44}, S, E); GT1(6) }
        if (layer == 0) { GT0 convert_mixer_weights(F, p, 1, 0); GT1(7) }
        PH_END(k); }
}

__global__ void __launch_bounds__(512, 2) fwd_kernel(Params p) {
    extern __shared__ __attribute__((aligned(16))) unsigned char smem[];
    Frame F0; F0.lds = (LAS unsigned char*)smem; F0.G = gridDim.x; F0.bid = blockIdx.x; F0.tid = threadIdx.x; F0.wid = 0; F0.lane = 0;
    cg::grid_group grid = cg::this_grid();
    if (p.ph_hi < 0) grid.sync();
    unsigned long long tprobe = 0;
    volatile LAS unsigned* xst = (volatile LAS unsigned*)(smem + gm::STAGE_BYTES);
    if (threadIdx.x < 4) xst[threadIdx.x] = 0u;
    __syncthreads();
    const XcdBarrier xbar = xcd_barrier_post((unsigned*)(p.ws + OFF_SM + SM_BAR), xst);
    if (PH_ON(0)) { const Frame F = fresh(F0); { GT0 prologue_phase(F, p); GT1(11) } PH_END(0); }
    layer_program<0>(F0, p, xbar, 1, tprobe);
    layer_program<1>(F0, p, xbar, 15, tprobe);
    if (PH_ON(32)) { const Frame F = fresh(F0); { GT0 final_norm(F, p); GT1(11) } }
#if PROBE_CAT
    if (blockIdx.x == 0) { const unsigned long long t0 = RT(); while (RT() - t0 < tprobe) __builtin_amdgcn_s_sleep(8); }
#endif
}

extern "C" void kernel_launch(void* const* d_in, const int* in_sizes, int n_in, void* d_out, int out_size, void* d_ws, size_t ws_size, hipStream_t stream) {
    static int grid_blocks = 0;
    constexpr int LDS_BYTES = gm::STAGE_BYTES + 16;
    if (!grid_blocks) {
        int dev = 0, cus = 0, per_cu = 0;
        (void)hipGetDevice(&dev); (void)hipDeviceGetAttribute(&cus, hipDeviceAttributeMultiprocessorCount, dev);
        (void)hipFuncSetAttribute((const void*)fwd_kernel, hipFuncAttributeMaxDynamicSharedMemorySize, LDS_BYTES);
        (void)hipOccupancyMaxActiveBlocksPerMultiprocessor(&per_cu, (const void*)fwd_kernel, 512, LDS_BYTES);
        if (per_cu < 1) per_cu = 1;
        grid_blocks = cus;
        if (ws_size < WS_END) fprintf(stderr, "kernel_launch: workspace too small: %zu < %zu\n", ws_size, (size_t)WS_END);
        (void)hipGetLastError();
    }
    Params p{};
    p.x = (const float*)d_in[0]; p.c = (const float*)d_in[1]; p.pos = (const int*)d_in[2]; p.ada_w = (const float*)d_in[3]; p.ada_b = (const float*)d_in[4];
    p.ntg = (const float*)d_in[5]; p.nfg = (const float*)d_in[6]; p.ret_w_in = (const float*)d_in[7]; p.ret_gn = (const float*)d_in[8]; p.ret_w_out = (const float*)d_in[9];
    p.ml_w_in = (const float*)d_in[10]; p.ml_bg = (const float*)d_in[11]; p.ml_cw = (const float*)d_in[12]; p.ml_cb = (const float*)d_in[13]; p.ml_gn = (const float*)d_in[14];
    p.ml_w_out = (const float*)d_in[15]; p.up_w = (const float*)d_in[16]; p.fcw = (const float*)d_in[17]; p.fcb = (const float*)d_in[18]; p.dn_w = (const float*)d_in[19];
    p.fin_g = (const float*)d_in[20]; p.out = (float*)d_out; p.ws = (unsigned char*)d_ws;
#if MULTI_LAUNCH
    for (int ph = 0; ph < N_PHASES; ++ph) { p.ph_lo = ph; p.ph_hi = ph + 1; hipLaunchKernelGGL(fwd_kernel, dim3(grid_blocks), dim3(512), LDS_BYTES, stream, p); }
#else
    p.ph_lo = 0; p.ph_hi = N_PHASES;
    (void)hipMemsetAsync((unsigned char*)d_ws + OFF_SM + SM_BAR, 0, XCD_BAR_WORDS * 4, stream);
    void* args[] = {&p};
    hipError_t e = hipLaunchCooperativeKernel((void*)fwd_kernel, dim3(grid_blocks), dim3(512), args, LDS_BYTES, stream);
    if (e != hipSuccess) fprintf(stderr, "cooperative launch failed: %s (grid %d)\n", hipGetErrorString(e), grid_blocks);
#endif
}
```
